# Optimizing an MI355X kernel written in HIP

```python
import math
import jax, jax.numpy as jnp
from jax import lax
import numpy as np

D_MODEL = 2048
BATCH = 4
SEQ = 8192
DEPTH = 1
DEC_BATCH = 4
DEC_SEQ = 2048
PAST_LEN = 128

N_HEADS = 8
HEAD_DIM = 64
ATTN_W = N_HEADS * 2 * HEAD_DIM
SSM_W = D_MODEL // 2
GROUP_SIZE = 16
N_GROUPS = SSM_W // GROUP_SIZE
STATE = 64
IN_COLS = 3 * ATTN_W + SSM_W + 2 * D_MODEL
D_FF = 4 * D_MODEL
N_MEM = 256
X_HEADS = 4
X_HEAD_DIM = D_MODEL // X_HEADS
Q_BLOCK = 128
ROPE_THETA = 10000.0
EPS = 1e-6

kernel_name = "hybrid_diffattn_s5_encoder"


def rms_norm(x, g):
    xf = x.astype(jnp.float32)
    y = xf * lax.rsqrt(jnp.mean(xf * xf, axis=-1, keepdims=True) + EPS)
    return (y * g.astype(jnp.float32)).astype(x.dtype)


def rope(t):
    L = t.shape[1]
    half = HEAD_DIM // 2
    inv = ROPE_THETA ** (-jnp.arange(0, HEAD_DIM, 2, dtype=jnp.float32) / HEAD_DIM)
    ang = jnp.arange(L, dtype=jnp.float32)[:, None] * inv[None, :]
    cos = jnp.cos(ang)[None, :, None, None, :].astype(t.dtype)
    sin = jnp.sin(ang)[None, :, None, None, :].astype(t.dtype)
    t1, t2 = t[..., :half], t[..., half:]
    return jnp.concatenate([t1 * cos - t2 * sin, t2 * cos + t1 * sin], axis=-1)


def diff_attention(q, k, v, lam):
    B_, L = q.shape[0], q.shape[1]
    nblk = L // Q_BLOCK
    qb = q.reshape(B_, nblk, Q_BLOCK, N_HEADS, 2, HEAD_DIM).transpose(1, 0, 2, 3, 4, 5)

    def block(qi):
        s = jnp.einsum('bqhmd,bkhmd->bhmqk', qi, k, preferred_element_type=jnp.float32)
        p = jax.nn.softmax(s, axis=-1)
        p_diff = (p[:, :, 0] - lam * p[:, :, 1]).astype(v.dtype)
        return jnp.einsum('bhqk,bkhe->bqhe', p_diff, v)

    out = lax.map(block, qb)
    return out.transpose(1, 0, 2, 3, 4).reshape(B_, L, N_HEADS, 2 * HEAD_DIM)


def _combine(e_i, e_j):
    ai_re, ai_im, bi_re, bi_im = e_i
    aj_re, aj_im, bj_re, bj_im = e_j
    a_re = aj_re * ai_re - aj_im * ai_im
    a_im = aj_re * ai_im + aj_im * ai_re
    b_re = aj_re * bi_re - aj_im * bi_im + bj_re
    b_im = aj_re * bi_im + aj_im * bi_re + bj_im
    return (a_re, a_im, b_re, b_im)


def s5_bidirectional(u, lam_re, lam_im, log_dt, b_re, b_im, c_re, c_im, d_skip):
    B_, L, _ = u.shape
    uf = u.astype(jnp.float32).reshape(B_, L, N_GROUPS, GROUP_SIZE)
    y = d_skip.astype(jnp.float32).reshape(N_GROUPS, GROUP_SIZE) * uf
    for direction in range(2):
        lr = lam_re[direction].astype(jnp.float32)
        li = lam_im[direction].astype(jnp.float32)
        dt = jnp.exp(log_dt[direction].astype(jnp.float32))[:, None]
        mag = jnp.exp(lr * dt)
        ab_re = mag * jnp.cos(li * dt)
        ab_im = mag * jnp.sin(li * dt)
        den = lr * lr + li * li
        n_re, n_im = ab_re - 1.0, ab_im
        k_re = (n_re * lr + n_im * li) / den
        k_im = (n_im * lr - n_re * li) / den
        br = b_re[direction].astype(jnp.float32)
        bi = b_im[direction].astype(jnp.float32)
        bb_re = k_re[..., None] * br - k_im[..., None] * bi
        bb_im = k_re[..., None] * bi + k_im[..., None] * br
        bu_re = jnp.einsum('blgc,gpc->lbgp', uf, bb_re)
        bu_im = jnp.einsum('blgc,gpc->lbgp', uf, bb_im)
        if direction == 1:
            bu_re = jnp.flip(bu_re, axis=0)
            bu_im = jnp.flip(bu_im, axis=0)
        a_re = jnp.broadcast_to(ab_re[None, None], (L, 1, N_GROUPS, STATE))
        a_im = jnp.broadcast_to(ab_im[None, None], (L, 1, N_GROUPS, STATE))
        _, _, x_re, x_im = lax.associative_scan(_combine, (a_re, a_im, bu_re, bu_im), axis=0)
        if direction == 1:
            x_re = jnp.flip(x_re, axis=0)
            x_im = jnp.flip(x_im, axis=0)
        y = y + jnp.einsum('lbgp,gcp->blgc', x_re, c_re[direction].astype(jnp.float32)) \
              - jnp.einsum('lbgp,gcp->blgc', x_im, c_im[direction].astype(jnp.float32))
    return y.reshape(B_, L, SSM_W).astype(u.dtype)


def encode(x, mem, w):
    (norm_mix, w_in, diff_lambda, subln, w_attn_proj,
     ssm_lambda_re, ssm_lambda_im, ssm_log_dt, ssm_b_re, ssm_b_im, ssm_c_re, ssm_c_im, ssm_d,
     w_glu_a, w_glu_b, w_mix_out,
     norm_cross, norm_mem, w_q_cross, w_kv_cross, w_o_cross,
     norm_mlp, w_mlp_up, w_mlp_down, norm_final) = w
    B_, L, _ = x.shape
    M = mem.shape[1]
    for layer in range(DEPTH):
        xn = rms_norm(x, norm_mix[layer])
        proj = xn @ w_in[layer]
        q, k, v, u, gates = jnp.split(
            proj, [ATTN_W, 2 * ATTN_W, 3 * ATTN_W, 3 * ATTN_W + SSM_W], axis=-1)
        q = rope(q.reshape(B_, L, N_HEADS, 2, HEAD_DIM)) * (HEAD_DIM ** -0.5)
        k = rope(k.reshape(B_, L, N_HEADS, 2, HEAD_DIM))
        v = v.reshape(B_, L, N_HEADS, 2 * HEAD_DIM)
        lam_init = 0.8 - 0.6 * math.exp(-0.3 * layer)
        dl = diff_lambda[layer].astype(jnp.float32)
        lam = jnp.exp(jnp.sum(dl[0] * dl[1])) - jnp.exp(jnp.sum(dl[2] * dl[3])) + lam_init
        attn = diff_attention(q, k, v, lam)
        attn = rms_norm(attn, subln[layer]) * (1.0 - lam_init)
        y_attn = attn.reshape(B_, L, ATTN_W) @ w_attn_proj[layer]

        s = s5_bidirectional(u, ssm_lambda_re[layer], ssm_lambda_im[layer], ssm_log_dt[layer],
                             ssm_b_re[layer], ssm_b_im[layer], ssm_c_re[layer], ssm_c_im[layer],
                             ssm_d[layer])
        z = jax.nn.gelu(s)
        y_ssm = (z @ w_glu_a[layer]) * jax.nn.sigmoid(z @ w_glu_b[layer])

        g = jax.nn.sigmoid(gates)
        g_attn, g_ssm = g[..., :D_MODEL], g[..., D_MODEL:]
        x = x + (g_attn * y_attn + g_ssm * y_ssm) @ w_mix_out[layer]

        hn = rms_norm(x, norm_cross[layer])
        mn = rms_norm(mem, norm_mem[layer])
        qc = (hn @ w_q_cross[layer]).reshape(B_, L, X_HEADS, X_HEAD_DIM) * (X_HEAD_DIM ** -0.5)
        kv = (mn @ w_kv_cross[layer]).reshape(B_, M, 2, X_HEADS, X_HEAD_DIM)
        sc = jnp.einsum('bqhd,bkhd->bhqk', qc, kv[:, :, 0], preferred_element_type=jnp.float32)
        pc = jax.nn.softmax(sc, axis=-1).astype(x.dtype)
        oc = jnp.einsum('bhqk,bkhd->bqhd', pc, kv[:, :, 1]).reshape(B_, L, D_MODEL)
        x = x + oc @ w_o_cross[layer]

        hm = rms_norm(x, norm_mlp[layer])
        x = x + jnp.square(jax.nn.relu(hm @ w_mlp_up[layer])) @ w_mlp_down[layer]
    return rms_norm(x, norm_final)


def setup_inputs(seed: int = 0) -> dict:
    key = jax.random.key(seed)
    ks = iter(jax.random.split(key, 40))
    f32 = jnp.float32

    def nrm(shape, scale):
        return jax.random.normal(next(ks), shape, f32) * scale

    def gain(shape):
        return 1.0 + 0.02 * jax.random.normal(next(ks), shape, f32)

    Dd = DEPTH
    P, G, GS = STATE, N_GROUPS, GROUP_SIZE
    inp = {}
    inp["x_prompt"] = nrm((BATCH, SEQ, D_MODEL), 1.0)
    inp["x_sample"] = nrm((DEC_BATCH, DEC_SEQ, D_MODEL), 1.0)
    inp["mem_prompt"] = nrm((BATCH, N_MEM, D_MODEL), 1.0)
    inp["mem_sample"] = nrm((DEC_BATCH, N_MEM, D_MODEL), 1.0)
    inp["norm_mix"] = gain((Dd, D_MODEL))
    inp["w_in"] = nrm((Dd, D_MODEL, IN_COLS), D_MODEL ** -0.5)
    inp["diff_lambda"] = nrm((Dd, 4, HEAD_DIM), 0.1)
    inp["subln"] = gain((Dd, 2 * HEAD_DIM))
    inp["w_attn_proj"] = nrm((Dd, ATTN_W, D_MODEL), ATTN_W ** -0.5)
    inp["ssm_lambda_re"] = -0.5 + nrm((Dd, 2, G, P), 0.01)
    inp["ssm_lambda_im"] = math.pi * jnp.arange(P, dtype=f32) + nrm((Dd, 2, G, P), 0.01)
    inp["ssm_log_dt"] = jax.random.uniform(next(ks), (Dd, 2, G), f32,
                                           math.log(0.001), math.log(0.1))
    inp["ssm_b_re"] = nrm((Dd, 2, G, P, GS), (2.0 * GS) ** -0.5)
    inp["ssm_b_im"] = nrm((Dd, 2, G, P, GS), (2.0 * GS) ** -0.5)
    inp["ssm_c_re"] = nrm((Dd, 2, G, GS, P), (2.0 * P) ** -0.5)
    inp["ssm_c_im"] = nrm((Dd, 2, G, GS, P), (2.0 * P) ** -0.5)
    inp["ssm_d"] = nrm((Dd, SSM_W), 1.0)
    inp["w_glu_a"] = nrm((Dd, SSM_W, D_MODEL), SSM_W ** -0.5)
    inp["w_glu_b"] = nrm((Dd, SSM_W, D_MODEL), SSM_W ** -0.5)
    inp["w_mix_out"] = nrm((Dd, D_MODEL, D_MODEL), D_MODEL ** -0.5)
    inp["norm_cross"] = gain((Dd, D_MODEL))
    inp["norm_mem"] = gain((Dd, D_MODEL))
    inp["w_q_cross"] = nrm((Dd, D_MODEL, D_MODEL), D_MODEL ** -0.5)
    inp["w_kv_cross"] = nrm((Dd, D_MODEL, 2 * D_MODEL), D_MODEL ** -0.5)
    inp["w_o_cross"] = nrm((Dd, D_MODEL, D_MODEL), D_MODEL ** -0.5)
    inp["norm_mlp"] = gain((Dd, D_MODEL))
    inp["w_mlp_up"] = nrm((Dd, D_MODEL, D_FF), D_MODEL ** -0.5)
    inp["w_mlp_down"] = nrm((Dd, D_FF, D_MODEL), D_FF ** -0.5)
    inp["norm_final"] = gain((D_MODEL,))
    return inp


def reference(x_prompt, x_sample, mem_prompt, mem_sample,
              norm_mix, w_in, diff_lambda, subln, w_attn_proj,
              ssm_lambda_re, ssm_lambda_im, ssm_log_dt, ssm_b_re, ssm_b_im,
              ssm_c_re, ssm_c_im, ssm_d, w_glu_a, w_glu_b, w_mix_out,
              norm_cross, norm_mem, w_q_cross, w_kv_cross, w_o_cross,
              norm_mlp, w_mlp_up, w_mlp_down, norm_final):
    w = (norm_mix, w_in, diff_lambda, subln, w_attn_proj,
         ssm_lambda_re, ssm_lambda_im, ssm_log_dt, ssm_b_re, ssm_b_im, ssm_c_re, ssm_c_im, ssm_d,
         w_glu_a, w_glu_b, w_mix_out,
         norm_cross, norm_mem, w_q_cross, w_kv_cross, w_o_cross,
         norm_mlp, w_mlp_up, w_mlp_down, norm_final)
    y_prompt = encode(x_prompt, mem_prompt, w)
    y_sample = encode(x_sample, mem_sample, w)
    return (y_prompt, y_sample)
```

```cpp
#include <hip/hip_runtime.h>
#include <hip/hip_bf16.h>
#include <cstdio>
#include <cstdint>
#include <cmath>

#define LAS __attribute__((address_space(3)))
#define GAS __attribute__((address_space(1)))
typedef unsigned short bf16_t;
typedef short bf16x8 __attribute__((ext_vector_type(8)));
typedef short s16x4 __attribute__((ext_vector_type(4)));
typedef float f32x4 __attribute__((ext_vector_type(4)));
typedef float f32x2 __attribute__((ext_vector_type(2)));
typedef float f32x16 __attribute__((ext_vector_type(16)));
typedef unsigned u32x4 __attribute__((ext_vector_type(4)));
typedef unsigned u32x2 __attribute__((ext_vector_type(2)));

constexpr int DM = 2048, NTOK = 40960, NPROMPT = 32768, LPR = 8192, LSA = 2048;
constexpr int INC = 8192, AW = 1024, SW = 1024, DFF = 8192, NMEMROWS = 2048;
constexpr float EPS = 1e-6f;

typedef __bf16 bf16x2_t __attribute__((ext_vector_type(2)));
__device__ __forceinline__ unsigned cvt_pk_bf16(float lo, float hi) { f32x2 v = {lo, hi}; bf16x2_t b = __builtin_convertvector(v, bf16x2_t); return __builtin_bit_cast(unsigned, b); }
__device__ __forceinline__ float bf_lo(unsigned w) { return __uint_as_float(w << 16); }
__device__ __forceinline__ float bf_hi(unsigned w) { return __uint_as_float(w & 0xffff0000u); }
__device__ __forceinline__ float sigmoidf_(float x) { return __builtin_amdgcn_rcpf(1.0f + __expf(-x)); }
template <int CTRL> __device__ __forceinline__ float dppf(float v) { return __int_as_float(__builtin_amdgcn_update_dpp(0, __float_as_int(v), CTRL, 0xF, 0xF, true)); }
__device__ __forceinline__ float sum4(float v) { v += dppf<0xB1>(v); v += dppf<0x4E>(v); return v; }
__device__ __forceinline__ float sum8(float v) { v = sum4(v); v += dppf<0x141>(v); return v; }
__device__ __forceinline__ float sum16(float v) { v = sum4(v); v += dppf<0x124>(v); v += dppf<0x128>(v); return v; }
__device__ __forceinline__ float max16(float v) { v = fmaxf(v, dppf<0xB1>(v)); v = fmaxf(v, dppf<0x4E>(v)); v = fmaxf(v, dppf<0x124>(v)); v = fmaxf(v, dppf<0x128>(v)); return v; }
__device__ __forceinline__ float wave_sum(float v) {
    v = sum16(v);
    { auto r = __builtin_amdgcn_permlane16_swap(__float_as_uint(v), __float_as_uint(v), false, false); v = __uint_as_float(r[0]) + __uint_as_float(r[1]); }
    { auto r = __builtin_amdgcn_permlane32_swap(__float_as_uint(v), __float_as_uint(v), false, false); v = __uint_as_float(r[0]) + __uint_as_float(r[1]); }
    return v;
}

namespace pg8 {
constexpr int BM = 256, BK = 64, HALF = 128, HTB = HALF * BK * 2, STAGE_BYTES = 8 * HTB, NXCD = 8;
__host__ __device__ __forceinline__ int lds_byte(int r, int c) { const int st = (r >> 4) * 2 + (c >> 5), rr = r & 15, cc = c & 31, ob = rr * 64 + cc * 2; return st * 1024 + (ob ^ (((ob >> 9) & 1) << 5)); }
__host__ __device__ __forceinline__ void stage_rc(int b, int& R, int& C) { const int st = b / 1024, sb = b % 1024, swz = sb ^ (((sb >> 9) & 1) << 5); R = (st >> 1) * 16 + swz / 64; C = (st & 1) * 32 + (swz % 64) / 2; }
__host__ __device__ __forceinline__ int perm32(int rho) { const int n = rho >> 4, i = rho & 15; return 8 * (i >> 2) + 4 * n + (i & 3); }

struct Unit { const char* a; const char* b; int pm, pn; };
struct Gemm { int lda, ldb, K; };

struct TileOrder {
    const char* A; const char* B; size_t ta, tb; int nM, nN, nwg, G, c, wgm;
    __device__ void init(const void* A_, int lda, const void* B_, int ldb, int M, int N, int G_, int c_, int WGM = 4) { A = (const char*)A_; B = (const char*)B_; ta = (size_t)BM * lda * 2; tb = (size_t)BM * ldb * 2; nM = M / BM; nN = N / BM; nwg = nM * nN; G = G_; c = c_; wgm = WGM; }
    __device__ bool next(int i, Unit& u) const {
        const long L = (long)i * G + c; if (L >= nwg) return false;
        int wgid = (int)L; { const int q = nwg / NXCD, r = nwg % NXCD, xcd = wgid % NXCD, off = wgid / NXCD; wgid = (xcd < r ? xcd * (q + 1) : r * (q + 1) + (xcd - r) * q) + off; }
        const int nig = wgm * nN, gid = wgid / nig, fm = gid * wgm, gsz = (nM - fm) < wgm ? (nM - fm) : wgm;
        u.pm = fm + ((wgid % nig) % gsz); u.pn = (wgid % nig) / gsz; u.a = A + (size_t)u.pm * ta; u.b = B + (size_t)u.pn * tb; return true;
    }
};

template <class Epi, class Sched>
__device__ __forceinline__ void gemm_phase(LAS unsigned char* lds, const Gemm g, const Sched& S, const Epi& E) {
    int tid_ = threadIdx.x; asm volatile("" : "+v"(tid_));
    const int tid = tid_, wid = __builtin_amdgcn_readfirstlane(tid >> 6), lane = tid & 63, wr = wid >> 2, wc = wid & 3, fr = lane & 15, fq = lane >> 4;
    int K_ = g.K; asm volatile("" : "+s"(K_));
    const int K = K_, nt = K / BK;
    unsigned voffA[2], voffB[2];
#pragma unroll
    for (int i = 0; i < 2; ++i) { int R, C; stage_rc(tid * 16 + i * 8192, R, C); const int Rb = Epi::PERM ? ((R & ~31) + perm32(R & 31)) : R;
        voffA[i] = (unsigned)(R * g.lda + C) * 2u; voffB[i] = (unsigned)(Rb * g.ldb + C) * 2u; }
    const size_t kstep = (size_t)(BK * 2);
    const size_t hsA = (size_t)HALF * g.lda * 2, hsB = (size_t)HALF * g.ldb * 2;
    const unsigned ldsw = (unsigned)wid * 1024u;
    const int aoff = lds_byte(wr * 64 + fr, fq * 8), boff = lds_byte(wc * 32 + fr, fq * 8);
#define PG8_SA(b, h) (((b) * 2 + (h)) * HTB)
#define PG8_SB(b, h) ((4 + (b) * 2 + (h)) * HTB)
#define PG8_STAGE(bufoff, gbase, voff) do { _Pragma("unroll") for (int _i = 0; _i < 2; ++_i) \
        __builtin_amdgcn_global_load_lds((const unsigned*)((const char*)(gbase) + (voff)[_i]), (LAS unsigned*)(lds + (bufoff) + ldsw + _i * 8192), 16, 0, 0); } while (0)
#define PG8_LDA(dst, b, h) do { _Pragma("unroll") for (int m = 0; m < 4; ++m) _Pragma("unroll") for (int k = 0; k < 2; ++k) dst[m][k] = *(const LAS bf16x8*)(lds + PG8_SA(b, h) + aoff + m * 2048 + k * 1024); } while (0)
#define PG8_LDB(dst, b, h) do { _Pragma("unroll") for (int n = 0; n < 2; ++n) _Pragma("unroll") for (int k = 0; k < 2; ++k) dst[n][k] = *(const LAS bf16x8*)(lds + PG8_SB(b, h) + boff + n * 2048 + k * 1024); } while (0)
#define PG8_MMA(ai, bj, At, Bt) do { __builtin_amdgcn_s_setprio(1); _Pragma("unroll") for (int m = 0; m < 4; ++m) _Pragma("unroll") for (int n = 0; n < 2; ++n) _Pragma("unroll") for (int k = 0; k < 2; ++k) \
        acc[ai][bj][m][n] = __builtin_amdgcn_mfma_f32_16x16x32_bf16(Bt[n][k], At[m][k], acc[ai][bj][m][n], 0, 0, 0); __builtin_amdgcn_s_setprio(0); } while (0)
#define PG8_WAIT_V(n) asm volatile("s_waitcnt vmcnt(" #n ")" ::: "memory")
#define PG8_WAIT_L(n) asm volatile("s_waitcnt lgkmcnt(" #n ")" ::: "memory")
#define PG8_BAR __builtin_amdgcn_s_barrier()
#define PG8_SCHED __builtin_amdgcn_sched_barrier(0)
    Unit cur, nxt; int ui = 0;
    if (!S.next(0, cur)) return;
    f32x4 acc[2][2][4][2];
#pragma unroll
    for (int a = 0; a < 2; ++a)
#pragma unroll
        for (int b = 0; b < 2; ++b)
#pragma unroll
            for (int m = 0; m < 4; ++m)
#pragma unroll
                for (int n = 0; n < 2; ++n) acc[a][b][m][n] = (f32x4){0.f, 0.f, 0.f, 0.f};
    bf16x8 At[4][2], B0[2][2], B1[2][2];
    const char* cA = cur.a; const char* cB = cur.b;
    PG8_STAGE(PG8_SB(0, 0), cB, voffB); PG8_STAGE(PG8_SB(0, 1), cB + hsB, voffB); PG8_STAGE(PG8_SA(0, 0), cA, voffA); PG8_STAGE(PG8_SA(0, 1), cA + hsA, voffA);
    if (wr == 1) PG8_BAR;
    PG8_WAIT_V(2); PG8_BAR;
    PG8_STAGE(PG8_SB(1, 0), cB + kstep, voffB); PG8_STAGE(PG8_SA(1, 0), cA + kstep, voffA); PG8_STAGE(PG8_SB(1, 1), cB + hsB + kstep, voffB);
    PG8_WAIT_V(6); PG8_BAR;
    for (;;) {
        const bool has_next = S.next(ui + 1, nxt);
        const char* nA = has_next ? nxt.a : cA; const char* nB = has_next ? nxt.b : cB;
        for (int t = 0; t < nt; t += 2) {
            const bool last = (t == nt - 2);
            const char* a1 = cA + (size_t)(t + 1) * kstep;
            const char* a2 = last ? nA : cA + (size_t)(t + 2) * kstep; const char* b2 = last ? nB : cB + (size_t)(t + 2) * kstep;
            const char* a3 = a2 + kstep; const char* b3 = b2 + kstep;
            PG8_LDB(B0, 0, 0); PG8_LDB(B1, 0, 1); PG8_SCHED; PG8_LDA(At, 0, 0); PG8_STAGE(PG8_SA(1, 1), a1 + hsA, voffA);
            PG8_WAIT_V(8); PG8_WAIT_L(0); PG8_BAR; PG8_MMA(0, 0, At, B0); PG8_MMA(0, 1, At, B1); PG8_BAR; PG8_SCHED;
            PG8_LDA(At, 0, 1); PG8_STAGE(PG8_SB(0, 0), b2, voffB); PG8_STAGE(PG8_SB(0, 1), b2 + hsB, voffB); PG8_STAGE(PG8_SA(0, 0), a2, voffA);
            PG8_WAIT_V(8); PG8_WAIT_L(0); PG8_BAR; PG8_MMA(1, 0, At, B0); PG8_MMA(1, 1, At, B1); PG8_BAR; PG8_SCHED;
            PG8_LDB(B0, 1, 0); PG8_LDB(B1, 1, 1); PG8_SCHED; PG8_LDA(At, 1, 0); PG8_STAGE(PG8_SA(0, 1), a2 + hsA, voffA);
            PG8_WAIT_V(8); PG8_WAIT_L(0); PG8_BAR; PG8_MMA(0, 0, At, B0); PG8_MMA(0, 1, At, B1); PG8_BAR; PG8_SCHED;
            PG8_LDA(At, 1, 1); PG8_STAGE(PG8_SB(1, 0), b3, voffB); PG8_STAGE(PG8_SB(1, 1), b3 + hsB, voffB); PG8_STAGE(PG8_SA(1, 0), a3, voffA);
            PG8_WAIT_V(8); PG8_WAIT_L(0); PG8_BAR; PG8_MMA(1, 0, At, B0); PG8_MMA(1, 1, At, B1); PG8_BAR; PG8_SCHED;
        }
        if (wr == 0) PG8_BAR;
        E(acc, cur, wr, wc, fr, fq);
        if (!has_next) break;
#pragma unroll
        for (int a = 0; a < 2; ++a)
#pragma unroll
            for (int b = 0; b < 2; ++b)
#pragma unroll
                for (int m = 0; m < 4; ++m)
#pragma unroll
                    for (int n = 0; n < 2; ++n) acc[a][b][m][n] = (f32x4){0.f, 0.f, 0.f, 0.f};
        cur = nxt; cA = nA; cB = nB; ++ui;
        if (wr == 1) PG8_BAR;
    }
    PG8_WAIT_V(0);
    PG8_BAR;
#undef PG8_SA
#undef PG8_SB
#undef PG8_STAGE
#undef PG8_LDA
#undef PG8_LDB
#undef PG8_MMA
#undef PG8_WAIT_V
#undef PG8_WAIT_L
#undef PG8_BAR
#undef PG8_SCHED
}
}
__device__ __forceinline__ float gelu_tanh(float x) {
    const float y2 = 1.5957691216057308f * (x + 0.044715f * x * x * x);
    return x * sigmoidf_(y2);
}
namespace pg8 {
__device__ __forceinline__ u32x4 pack8(const f32x4 v0, const f32x4 v1) { u32x4 w; w.x = cvt_pk_bf16(v0[0], v0[1]); w.y = cvt_pk_bf16(v0[2], v0[3]); w.z = cvt_pk_bf16(v1[0], v1[1]); w.w = cvt_pk_bf16(v1[2], v1[3]); return w; }
__device__ __forceinline__ u32x2 pack4(const f32x4 v) { u32x2 w; w.x = cvt_pk_bf16(v[0], v[1]); w.y = cvt_pk_bf16(v[2], v[3]); return w; }

template <int ACT> struct EpiBf16 {
    static constexpr bool PERM = true;
    bf16_t* O; int ldc; float scale;
    __device__ __forceinline__ void operator()(const f32x4 (&acc)[2][2][4][2], const Unit& u, int wr, int wc, int fr, int fq) const {
        const int row0 = u.pm * BM + wr * 64 + fr, col0 = u.pn * BM + wc * 32 + 8 * fq;
#pragma unroll
        for (int ai = 0; ai < 2; ++ai)
#pragma unroll
            for (int m = 0; m < 4; ++m) { bf16_t* rowp = O + (size_t)(row0 + ai * HALF + m * 16) * ldc + col0;
#pragma unroll
                for (int bj = 0; bj < 2; ++bj) { f32x4 v0 = acc[ai][bj][m][0], v1 = acc[ai][bj][m][1];
                    if (ACT == 2) {
#pragma unroll
                        for (int e = 0; e < 4; ++e) { const float a = fmaxf(v0[e], 0.f), b = fmaxf(v1[e], 0.f); v0[e] = a * a; v1[e] = b * b; } }
                    v0 = v0 * scale; v1 = v1 * scale;
                    *(u32x4*)(rowp + bj * HALF) = pack8(v0, v1); } }
    }
};
template <int ACT> struct EpiBf16Rs {
    static constexpr bool PERM = true;
    bf16_t* O; int ldc; float scale; const float* SS; int grow0;
    __device__ __forceinline__ void operator()(const f32x4 (&acc)[2][2][4][2], const Unit& u, int wr, int wc, int fr, int fq) const {
        const int row0 = u.pm * BM + wr * 64 + fr, col0 = u.pn * BM + wc * 32 + 8 * fq;
#pragma unroll
        for (int ai = 0; ai < 2; ++ai)
#pragma unroll
            for (int m = 0; m < 4; ++m) { const int rl = row0 + ai * HALF + m * 16; bf16_t* rowp = O + (size_t)rl * ldc + col0;
                float r = 1.0f / sqrtf(SS[grow0 + rl] * (1.f / DM) + EPS); if (ACT == 2) r = r * r; r *= scale;
#pragma unroll
                for (int bj = 0; bj < 2; ++bj) { f32x4 v0 = acc[ai][bj][m][0], v1 = acc[ai][bj][m][1];
                    if (ACT == 2) {
#pragma unroll
                        for (int e = 0; e < 4; ++e) { const float a = fmaxf(v0[e], 0.f), b = fmaxf(v1[e], 0.f); v0[e] = a * a; v1[e] = b * b; } }
                    v0 = v0 * r; v1 = v1 * r;
                    *(u32x4*)(rowp + bj * HALF) = pack8(v0, v1); } }
    }
};
struct EpiF32 {
    static constexpr bool PERM = false;
    float* O; int ldc;
    __device__ __forceinline__ void operator()(const f32x4 (&acc)[2][2][4][2], const Unit& u, int wr, int wc, int fr, int fq) const {
        const int row0 = u.pm * BM + wr * 64 + fr, col0 = u.pn * BM + wc * 32 + 4 * fq;
#pragma unroll
        for (int ai = 0; ai < 2; ++ai)
#pragma unroll
            for (int m = 0; m < 4; ++m) { float* rowp = O + (size_t)(row0 + ai * HALF + m * 16) * ldc + col0;
#pragma unroll
                for (int bj = 0; bj < 2; ++bj)
#pragma unroll
                    for (int n = 0; n < 2; ++n) *(f32x4*)(rowp + bj * HALF + n * 16) = acc[ai][bj][m][n]; }
    }
};
struct EpiF32Rs {
    static constexpr bool PERM = false;
    float* O; int ldc; const float* SS; int grow0;
    __device__ __forceinline__ void operator()(const f32x4 (&acc)[2][2][4][2], const Unit& u, int wr, int wc, int fr, int fq) const {
        const int row0 = u.pm * BM + wr * 64 + fr, col0 = u.pn * BM + wc * 32 + 4 * fq;
#pragma unroll
        for (int ai = 0; ai < 2; ++ai)
#pragma unroll
            for (int m = 0; m < 4; ++m) { const int rl = row0 + ai * HALF + m * 16; float* rowp = O + (size_t)rl * ldc + col0; const float r = 1.0f / sqrtf(SS[grow0 + rl] * (1.f / DM) + EPS);
#pragma unroll
                for (int bj = 0; bj < 2; ++bj)
#pragma unroll
                    for (int n = 0; n < 2; ++n) *(f32x4*)(rowp + bj * HALF + n * 16) = acc[ai][bj][m][n] * r; }
    }
};
struct EpiResid {
    static constexpr bool PERM = false;
    const float* xp; const float* xs; float* out; int grow0; int from_x;
    __device__ __forceinline__ void operator()(const f32x4 (&acc)[2][2][4][2], const Unit& u, int wr, int wc, int fr, int fq) const {
        const int row0 = grow0 + u.pm * BM + wr * 64 + fr, col0 = u.pn * BM + wc * 32 + 4 * fq;
#pragma unroll
        for (int ai = 0; ai < 2; ++ai)
#pragma unroll
            for (int m = 0; m < 4; ++m) { const int gr = row0 + ai * HALF + m * 16;
                float* op = out + (size_t)gr * DM + col0;
                const float* bp = from_x ? (gr < NPROMPT ? xp + (size_t)gr * DM : xs + (size_t)(gr - NPROMPT) * DM) + col0 : op;
#pragma unroll
                for (int bj = 0; bj < 2; ++bj)
#pragma unroll
                    for (int n = 0; n < 2; ++n) { const f32x4 b = *(const f32x4*)(bp + bj * HALF + n * 16); *(f32x4*)(op + bj * HALF + n * 16) = b + acc[ai][bj][m][n]; } }
    }
};
struct EpiResidSS {
    static constexpr bool PERM = false;
    const float* xp; const float* xs; float* out; int grow0; int from_x; float* SSo; bf16_t* XN; const float* gain;
    __device__ __forceinline__ void operator()(const f32x4 (&acc)[2][2][4][2], const Unit& u, int wr, int wc, int fr, int fq) const {
        const int rowl0 = u.pm * BM + wr * 64 + fr, col0 = u.pn * BM + wc * 32 + 4 * fq;
        f32x4 gv[2][2];
        if (XN) {
#pragma unroll
            for (int bj = 0; bj < 2; ++bj)
#pragma unroll
                for (int n = 0; n < 2; ++n) gv[bj][n] = *(const f32x4*)(gain + col0 + bj * HALF + n * 16); }
#pragma unroll
        for (int ai = 0; ai < 2; ++ai)
#pragma unroll
            for (int m = 0; m < 4; ++m) { const int rl = rowl0 + ai * HALF + m * 16, gr = grow0 + rl;
                float* op = out + (size_t)gr * DM + col0;
                const float* bp = from_x ? (gr < NPROMPT ? xp + (size_t)gr * DM : xs + (size_t)(gr - NPROMPT) * DM) + col0 : op;
                float ss = 0.f;
#pragma unroll
                for (int bj = 0; bj < 2; ++bj)
#pragma unroll
                    for (int n = 0; n < 2; ++n) { const f32x4 b = *(const f32x4*)(bp + bj * HALF + n * 16); const f32x4 v = b + acc[ai][bj][m][n]; *(f32x4*)(op + bj * HALF + n * 16) = v;
                        ss += (v[0] * v[0] + v[1] * v[1]) + (v[2] * v[2] + v[3] * v[3]);
                        if (XN) *(u32x2*)(XN + (size_t)rl * DM + col0 + bj * HALF + n * 16) = pack4(v * gv[bj][n]); }
                { auto r = __builtin_amdgcn_permlane16_swap(__float_as_uint(ss), __float_as_uint(ss), false, false); ss = __uint_as_float(r[0]) + __uint_as_float(r[1]); }
                { auto r = __builtin_amdgcn_permlane32_swap(__float_as_uint(ss), __float_as_uint(ss), false, false); ss = __uint_as_float(r[0]) + __uint_as_float(r[1]); }
                if (fq == 0) (void)__hip_atomic_fetch_add(SSo + gr, ss, __ATOMIC_RELAXED, __HIP_MEMORY_SCOPE_AGENT); }
    }
};
struct EpiWin {
    static constexpr bool PERM = true;
    bf16_t* QKVU; bf16_t* GATES; const float* rope; int grow0; bf16_t* A3;
    __device__ __forceinline__ void operator()(const f32x4 (&acc)[2][2][4][2], const Unit& u, int wr, int wc, int fr, int fq) const {
        const int rowl0 = u.pm * BM + wr * 64 + fr, pn = u.pn;
        if (pn < 8) {
            const float sc = pn < 4 ? 0.125f * 1.4426950408889634f : 1.0f  ; const int g8 = 4 * (wc & 1) + fq;
#pragma unroll
            for (int ai = 0; ai < 2; ++ai)
#pragma unroll
                for (int m = 0; m < 4; ++m) { const int rl = rowl0 + ai * HALF + m * 16, gr = grow0 + rl, pos = gr < NPROMPT ? (gr & (LPR - 1)) : (gr & (LSA - 1));
                    const f32x4 cs = *(const f32x4*)(rope + pos * 64 + 4 * g8) * sc, sn = *(const f32x4*)(rope + pos * 64 + 32 + 4 * g8) * sc;
#pragma unroll
                    for (int bj = 0; bj < 2; ++bj) { const f32x4 v0 = acc[ai][bj][m][0], v1 = acc[ai][bj][m][1];
                        const f32x4 o1 = v0 * cs - v1 * sn, o2 = v1 * cs + v0 * sn;
                        bf16_t* p = QKVU + (size_t)rl * 4096 + (4 * pn + 2 * bj + (wc >> 1)) * 64 + 4 * g8;
                        *(u32x2*)p = pack4(o1); *(u32x2*)(p + 32) = pack4(o2); } }
        } else if (pn >= 12 && pn < 16) {
            const int ucol = (pn - 12) * BM + wc * 32 + 8 * fq;
#pragma unroll
            for (int ai = 0; ai < 2; ++ai)
#pragma unroll
                for (int m = 0; m < 4; ++m) { const int rl = rowl0 + ai * HALF + m * 16;
#pragma unroll
                    for (int bj = 0; bj < 2; ++bj) { const int uc = ucol + bj * HALF;
                        *(u32x4*)(A3 + ((size_t)((uc >> 4) * 512 + (rl >> 5)) * 768 + (rl & 31) * 16 + (uc & 15))) = pack8(acc[ai][bj][m][0], acc[ai][bj][m][1]); } }
        } else if (pn < 12) {
            const int col0 = pn * BM + wc * 32 + 8 * fq;
#pragma unroll
            for (int ai = 0; ai < 2; ++ai)
#pragma unroll
                for (int m = 0; m < 4; ++m) { bf16_t* rowp = QKVU + (size_t)(rowl0 + ai * HALF + m * 16) * 4096 + col0;
#pragma unroll
                    for (int bj = 0; bj < 2; ++bj) *(u32x4*)(rowp + bj * HALF) = pack8(acc[ai][bj][m][0], acc[ai][bj][m][1]); }
        } else {
            const int col0 = (pn - 16) * BM + wc * 32 + 8 * fq;
#pragma unroll
            for (int ai = 0; ai < 2; ++ai)
#pragma unroll
                for (int m = 0; m < 4; ++m) { bf16_t* rowp = GATES + (size_t)(rowl0 + ai * HALF + m * 16) * 4096 + col0;
#pragma unroll
                    for (int bj = 0; bj < 2; ++bj) { f32x4 v0 = acc[ai][bj][m][0], v1 = acc[ai][bj][m][1];
#pragma unroll
                        for (int e = 0; e < 4; ++e) { v0[e] = sigmoidf_(v0[e]); v1[e] = sigmoidf_(v1[e]); }
                        *(u32x4*)(rowp + bj * HALF) = pack8(v0, v1); } }
        }
    }
};
struct EpiAttnProj {
    static constexpr bool PERM = true;
    const bf16_t* GATES; bf16_t* MIX;
    __device__ __forceinline__ void operator()(const f32x4 (&acc)[2][2][4][2], const Unit& u, int wr, int wc, int fr, int fq) const {
        const int row0 = u.pm * BM + wr * 64 + fr, col0 = u.pn * BM + wc * 32 + 8 * fq;
#pragma unroll
        for (int ai = 0; ai < 2; ++ai)
#pragma unroll
            for (int m = 0; m < 4; ++m) { const int r = row0 + ai * HALF + m * 16;
#pragma unroll
                for (int bj = 0; bj < 2; ++bj) { const u32x4 gw = *(const u32x4*)(GATES + (size_t)r * 4096 + col0 + bj * HALF);
                    f32x4 v0 = acc[ai][bj][m][0], v1 = acc[ai][bj][m][1];
                    v0[0] *= bf_lo(gw.x); v0[1] *= bf_hi(gw.x); v0[2] *= bf_lo(gw.y); v0[3] *= bf_hi(gw.y);
                    v1[0] *= bf_lo(gw.z); v1[1] *= bf_hi(gw.z); v1[2] *= bf_lo(gw.w); v1[3] *= bf_hi(gw.w);
                    *(u32x4*)(MIX + (size_t)r * DM + col0 + bj * HALF) = pack8(v0, v1); } }
    }
};
struct EpiGlu {
    static constexpr bool PERM = true;
    const bf16_t* GATES; bf16_t* MIX;
    __device__ __forceinline__ void operator()(const f32x4 (&acc)[2][2][4][2], const Unit& u, int wr, int wc, int fr, int fq) const {
        const int row0 = u.pm * BM + wr * 64 + fr, j0 = u.pn * 128 + wc * 16 + 4 * fq;
#pragma unroll
        for (int ai = 0; ai < 2; ++ai)
#pragma unroll
            for (int m = 0; m < 4; ++m) { const int r = row0 + ai * HALF + m * 16;
#pragma unroll
                for (int bj = 0; bj < 2; ++bj) { const int j = j0 + bj * 64;
                    const u32x2 gw = *(const u32x2*)(GATES + (size_t)r * 4096 + DM + j); bf16_t* mp = MIX + (size_t)r * DM + j; const u32x2 mw = *(const u32x2*)mp;
                    const f32x4 a = acc[ai][bj][m][0], b = acc[ai][bj][m][1]; f32x4 o;
                    o[0] = a[0] * sigmoidf_(b[0]) * bf_lo(gw.x) + bf_lo(mw.x); o[1] = a[1] * sigmoidf_(b[1]) * bf_hi(gw.x) + bf_hi(mw.x);
                    o[2] = a[2] * sigmoidf_(b[2]) * bf_lo(gw.y) + bf_lo(mw.y); o[3] = a[3] * sigmoidf_(b[3]) * bf_hi(gw.y) + bf_hi(mw.y);
                    *(u32x2*)mp = pack4(o); } }
    }
};
struct EpiSsmOut {
    static constexpr bool PERM = true;
    bf16_t* Z;
    __device__ __forceinline__ void operator()(const f32x4 (&acc)[2][2][4][2], const Unit& u, int wr, int wc, int fr, int fq) const {
        const int row0 = u.pm * BM + wr * 64 + fr, n00 = u.pn * BM + wc * 32 + 8 * fq;
#pragma unroll
        for (int ai = 0; ai < 2; ++ai)
#pragma unroll
            for (int m = 0; m < 4; ++m) { const int row = row0 + ai * HALF + m * 16, g = row >> 9, chunk = row & 511;
#pragma unroll
                for (int bj = 0; bj < 2; ++bj) { const int n0 = n00 + bj * HALF, j = n0 >> 4, ch0 = n0 & 15;
                    f32x4 v0 = acc[ai][bj][m][0], v1 = acc[ai][bj][m][1];
#pragma unroll
                    for (int e = 0; e < 4; ++e) { v0[e] = gelu_tanh(v0[e]); v1[e] = gelu_tanh(v1[e]); }
                    *(u32x4*)(Z + ((size_t)(chunk * 32 + j) * 1024 + g * 16 + ch0)) = pack8(v0, v1); } }
    }
};
}
namespace attn3 {
constexpr int KVBLK = 64, LDQ = 4096, LDK = 4096, TILE_B = 64 * 128 * 2;
constexpr float THR = 8.f;
typedef short v4i16_t __attribute__((ext_vector_type(4)));
#define SBAR() __builtin_amdgcn_sched_barrier(0)
__device__ __forceinline__ s16x4 vtr(const LAS char* p) { return __builtin_bit_cast(s16x4, __builtin_amdgcn_ds_read_tr16_b64_v4i16((LAS v4i16_t*)p)); }
__device__ __forceinline__ int offK(int row, int ch16) { return 256 * row + 16 * (ch16 ^ (row & 15)); }
__device__ __forceinline__ int offV(int row, int ch16) { return 256 * row + 32 * ((ch16 >> 1) ^ (row & 7)) + 16 * (ch16 & 1); }
__device__ __forceinline__ float xmax4(float v) {
    { auto r = __builtin_amdgcn_permlane16_swap(__float_as_uint(v), __float_as_uint(v), false, false); v = fmaxf(__uint_as_float(r[0]), __uint_as_float(r[1])); }
    { auto r = __builtin_amdgcn_permlane32_swap(__float_as_uint(v), __float_as_uint(v), false, false); v = fmaxf(__uint_as_float(r[0]), __uint_as_float(r[1])); }
    return v; }
__device__ __forceinline__ float xsum4(float v) {
    { auto r = __builtin_amdgcn_permlane16_swap(__float_as_uint(v), __float_as_uint(v), false, false); v = __uint_as_float(r[0]) + __uint_as_float(r[1]); }
    { auto r = __builtin_amdgcn_permlane32_swap(__float_as_uint(v), __float_as_uint(v), false, false); v = __uint_as_float(r[0]) + __uint_as_float(r[1]); }
    return v; }

__device__ __forceinline__ void attn_unit3(const bf16_t* __restrict__ Qb, const bf16_t* __restrict__ Kh, const bf16_t* __restrict__ Vh, bf16_t* __restrict__ An, const float* __restrict__ subln, float lam, int seq, LAS char* lds) {
  int tid_ = threadIdx.x; asm volatile("" : "+v"(tid_));
  const int tid = tid_, wid = __builtin_amdgcn_readfirstlane(tid >> 6), lane = tid & 63, i16 = lane & 15, g = lane >> 4, half = wid >> 2;
  LAS char* V_lds = lds; LAS char* K_lds = lds + 2 * TILE_B;
  LAS float* ws = (LAS float*)(lds + 4 * TILE_B) + wid * 64;
  bf16x8 qf[2][2];
  { const bf16_t* Qw = Qb + (long)(wid * 16 + i16) * LDQ + 8 * g;
#pragma unroll
    for (int m = 0; m < 2; ++m)
#pragma unroll
      for (int ks = 0; ks < 2; ++ks) qf[m][ks] = *reinterpret_cast<const bf16x8*>(Qw + 64 * m + 32 * ks); }
  f32x4 o[2][8];
#pragma unroll
  for (int m = 0; m < 2; ++m)
#pragma unroll
    for (int cb = 0; cb < 8; ++cb) o[m][cb] = (f32x4){0.f, 0.f, 0.f, 0.f};
  float l_reg[2] = {0.f, 0.f}, negm[2] = {0.f, 0.f};
  const int sr = tid >> 4, sc16 = tid & 15;
  const int kst0 = offK(sr, sc16), kst1 = offK(32 + sr, sc16), vst0 = offV(sr, sc16), vst1 = offV(32 + sr, sc16);
  const int tq = i16 >> 2, tp = i16 & 3;
  const int NT = seq / KVBLK;
  bf16x8 gk0, gk1, gv0, gv1;
#define LOADK(t) do { gk0 = *reinterpret_cast<const bf16x8*>(&Kh[(long)((t) * KVBLK + sr) * LDK + sc16 * 8]); gk1 = *reinterpret_cast<const bf16x8*>(&Kh[(long)((t) * KVBLK + 32 + sr) * LDK + sc16 * 8]); } while (0)
#define LOADV(t) do { gv0 = *reinterpret_cast<const bf16x8*>(&Vh[(long)((t) * KVBLK + sr) * LDK + sc16 * 8]); gv1 = *reinterpret_cast<const bf16x8*>(&Vh[(long)((t) * KVBLK + 32 + sr) * LDK + sc16 * 8]); } while (0)
#define WRITEK(t) do { LAS char* kb_ = K_lds + ((t) & 1) * TILE_B; *(LAS bf16x8*)(kb_ + kst0) = gk0; *(LAS bf16x8*)(kb_ + kst1) = gk1; } while (0)
#define WRITEV(t) do { LAS char* vb_ = V_lds + ((t) & 1) * TILE_B; *(LAS bf16x8*)(vb_ + vst0) = gv0; *(LAS bf16x8*)(vb_ + vst1) = gv1; } while (0)
  f32x4 s[2][4]; bf16x8 pa[2][2];
#define KRD(KF, kbase, kb0) do { _Pragma("unroll") for (int b = 0; b < 2; ++b) _Pragma("unroll") for (int m = 0; m < 2; ++m) _Pragma("unroll") for (int ks = 0; ks < 2; ++ks) \
      KF[b][m][ks] = *(const LAS bf16x8*)((kbase) + offK(16 * ((kb0) + b) + i16, 8 * m + 4 * ks + g)); } while (0)
#define QKM(KF, kb0) do { _Pragma("unroll") for (int b = 0; b < 2; ++b) _Pragma("unroll") for (int m = 0; m < 2; ++m) { \
      f32x4 c_ = (f32x4){negm[m], negm[m], negm[m], negm[m]}; \
      c_ = __builtin_amdgcn_mfma_f32_16x16x32_bf16(KF[b][m][0], qf[m][0], c_, 0, 0, 0); \
      s[m][(kb0) + b] = __builtin_amdgcn_mfma_f32_16x16x32_bf16(KF[b][m][1], qf[m][1], c_, 0, 0, 0); } } while (0)
#define VRD(VF, vbase, t) do { _Pragma("unroll") for (int cb = 0; cb < 8; ++cb) { \
      const int r0_ = 32 * (t) + 4 * g + tq, r1_ = r0_ + 16; \
      VF[cb][0] = vtr((vbase) + 256 * r0_ + 32 * (cb ^ (r0_ & 7)) + 8 * tp); VF[cb][1] = vtr((vbase) + 256 * r1_ + 32 * (cb ^ (r1_ & 7)) + 8 * tp); } } while (0)
#define PVB(VF, t) do { _Pragma("unroll") for (int cb = 0; cb < 8; ++cb) { const bf16x8 vf_ = (bf16x8){VF[cb][0][0], VF[cb][0][1], VF[cb][0][2], VF[cb][0][3], VF[cb][1][0], VF[cb][1][1], VF[cb][1][2], VF[cb][1][3]}; \
      o[0][cb] = __builtin_amdgcn_mfma_f32_16x16x32_bf16(pa[0][t], vf_, o[0][cb], 0, 0, 0); \
      o[1][cb] = __builtin_amdgcn_mfma_f32_16x16x32_bf16(pa[1][t], vf_, o[1][cb], 0, 0, 0); } } while (0)
#define MSEG(tqi, tv, DO_QK) do { const LAS char* vbp_ = V_lds + ((tv) & 1) * TILE_B; const LAS char* kbp_ = K_lds + ((tqi) & 1) * TILE_B; \
    s16x4 va[8][2], vb[8][2]; bf16x8 ka[2][2][2], kc[2][2][2]; \
    VRD(va, vbp_, 0); SBAR(); \
    VRD(vb, vbp_, 1); PVB(va, 0); SBAR(); \
    if (DO_QK) KRD(ka, kbp_, 0); PVB(vb, 1); SBAR(); \
    if (DO_QK) { KRD(kc, kbp_, 2); QKM(ka, 0); SBAR(); QKM(kc, 2); } } while (0)
#define SMSEG(FIRST) do { \
    _Pragma("unroll") for (int m = 0; m < 2; ++m) { asm volatile("" : "+v"(s[m][0]), "+v"(s[m][1]), "+v"(s[m][2]), "+v"(s[m][3])); \
      float mx = fmaxf(fmaxf(s[m][0][0], s[m][0][1]), fmaxf(s[m][0][2], s[m][0][3])); \
      _Pragma("unroll") for (int kb = 1; kb < 4; ++kb) mx = fmaxf(mx, fmaxf(fmaxf(s[m][kb][0], s[m][kb][1]), fmaxf(s[m][kb][2], s[m][kb][3]))); \
      mx = xmax4(mx); \
      if ((FIRST) || __builtin_expect(__any(mx > THR), 0)) { const float dl = (FIRST) ? mx : fmaxf(mx, 0.f); \
        _Pragma("unroll") for (int kb = 0; kb < 4; ++kb) s[m][kb] = s[m][kb] - dl; \
        negm[m] -= dl; \
        if (!(FIRST)) { const float al = __builtin_amdgcn_exp2f(-dl); l_reg[m] *= al; if (g == 0) ws[16 * m + i16] = al; \
          const f32x4 a4 = *(const LAS f32x4*)(ws + 16 * m + 4 * g); \
          _Pragma("unroll") for (int cb = 0; cb < 8; ++cb) o[m][cb] = o[m][cb] * a4; } } \
      float ps = 0.f; \
      _Pragma("unroll") for (int kb = 0; kb < 4; ++kb) { _Pragma("unroll") for (int r = 0; r < 4; ++r) { s[m][kb][r] = __builtin_amdgcn_exp2f(s[m][kb][r]); ps += s[m][kb][r]; } } \
      l_reg[m] += xsum4(ps); \
      _Pragma("unroll") for (int t = 0; t < 2; ++t) { u32x4 w_; w_.x = cvt_pk_bf16(s[m][2 * t][0], s[m][2 * t][1]); w_.y = cvt_pk_bf16(s[m][2 * t][2], s[m][2 * t][3]); \
        w_.z = cvt_pk_bf16(s[m][2 * t + 1][0], s[m][2 * t + 1][1]); w_.w = cvt_pk_bf16(s[m][2 * t + 1][2], s[m][2 * t + 1][3]); pa[m][t] = __builtin_bit_cast(bf16x8, w_); } } } while (0)
#define BAR() __syncthreads()
  LOADK(0); LOADV(0); WRITEK(0); WRITEV(0); LOADK(1); WRITEK(1);
  if (2 < NT) LOADK(2); LOADV(1);
  BAR();
  { bf16x8 ka[2][2][2], kc[2][2][2]; KRD(ka, K_lds, 0); KRD(kc, K_lds, 2); QKM(ka, 0); QKM(kc, 2); } SMSEG(true);
  BAR();
  if (half == 0) {
    for (int n = 0; n + 1 < NT; ++n) {
      SBAR(); MSEG(n + 1, n, true); SBAR(); BAR();
      SMSEG(false); if (n + 2 < NT) WRITEK(n + 2); WRITEV(n + 1); if (n + 3 < NT) LOADK(n + 3); if (n + 2 < NT) LOADV(n + 2); SBAR(); BAR();
    }
    MSEG(0, NT - 1, false); BAR(); BAR();
  } else {
    if (2 < NT) WRITEK(2); WRITEV(1); if (3 < NT) LOADK(3); if (2 < NT) LOADV(2); BAR();
    for (int n = 0; n + 1 < NT; ++n) {
      SBAR(); MSEG(n + 1, n, true); SBAR(); BAR();
      SMSEG(false); if (n + 3 < NT) WRITEK(n + 3); if (n + 2 < NT) WRITEV(n + 2); if (n + 4 < NT) LOADK(n + 4); if (n + 3 < NT) LOADV(n + 3); SBAR(); BAR();
    }
    MSEG(0, NT - 1, false); BAR();
  }
  if (g == 0) { ws[i16] = __builtin_amdgcn_rcpf(l_reg[0]); ws[16 + i16] = lam * __builtin_amdgcn_rcpf(l_reg[1]); }
  const f32x4 il0 = *(const LAS f32x4*)(ws + 4 * g), il1 = *(const LAS f32x4*)(ws + 16 + 4 * g);
  f32x4 ss = (f32x4){0.f, 0.f, 0.f, 0.f};
#pragma unroll
  for (int cb = 0; cb < 8; ++cb) { o[0][cb] = o[0][cb] * il0 - o[1][cb] * il1; ss = ss + o[0][cb] * o[0][cb]; }
  f32x4 rs;
#pragma unroll
  for (int r = 0; r < 4; ++r) rs[r] = 0.8f / sqrtf(sum16(ss[r]) * (1.f / 128.f) + EPS);
  bf16_t* Aw = An + (long)(wid * 16 + 4 * g) * 1024 + i16;
#pragma unroll
  for (int cb = 0; cb < 8; ++cb) { const float gn = subln[16 * cb + i16];
#pragma unroll
    for (int r = 0; r < 4; ++r) Aw[(long)r * 1024 + 16 * cb] = (bf16_t)(cvt_pk_bf16(o[0][cb][r] * rs[r] * gn, 0.f) & 0xffffu); }
  BAR();
#undef LOADK
#undef LOADV
#undef WRITEK
#undef WRITEV
#undef KRD
#undef QKM
#undef VRD
#undef PVB
#undef MSEG
#undef SMSEG
#undef BAR
}
#undef SBAR
}
__device__ __forceinline__ void dsincos(double x, double& s, double& c) {
    const double k = __builtin_rint(x * 0.15915494309189535);
    double r = __builtin_fma(-k, 6.283185307179586, x); r = __builtin_fma(-k, 2.4492935982947064e-16, r);
    const double r2 = r * r;
    double ps = 1.1309962886447718e-31;
    ps = ps * r2 - 9.183689863795546e-29;
    ps = ps * r2 + 6.446950284384474e-26;
    ps = ps * r2 - 3.8681701706306835e-23;
    ps = ps * r2 + 1.9572941063391263e-20;
    ps = ps * r2 - 8.22063524662433e-18;
    ps = ps * r2 + 2.8114572543455206e-15;
    ps = ps * r2 - 7.647163731819816e-13;
    ps = ps * r2 + 1.6059043836821613e-10;
    ps = ps * r2 - 2.505210838544172e-08;
    ps = ps * r2 + 2.7557319223985893e-06;
    ps = ps * r2 - 0.0001984126984126984;
    ps = ps * r2 + 0.008333333333333333;
    ps = ps * r2 - 0.16666666666666666;
    s = r + r * r2 * ps;
    double pc = -3.7699876288159054e-33;
    pc = pc * r2 + 3.279889237069838e-30;
    pc = pc * r2 - 2.4795962632247972e-27;
    pc = pc * r2 + 1.6117375710961184e-24;
    pc = pc * r2 - 8.896791392450574e-22;
    pc = pc * r2 + 4.110317623312165e-19;
    pc = pc * r2 - 1.5619206968586225e-16;
    pc = pc * r2 + 4.779477332387385e-14;
    pc = pc * r2 - 1.1470745597729725e-11;
    pc = pc * r2 + 2.08767569878681e-09;
    pc = pc * r2 - 2.755731922398589e-07;
    pc = pc * r2 + 2.48015873015873e-05;
    pc = pc * r2 - 0.001388888888888889;
    pc = pc * r2 + 0.041666666666666664;
    pc = pc * r2 - 0.5;
    c = 1.0 + r2 * pc;
}
__device__ __forceinline__ double dexp(double x) {
    const double k = __builtin_rint(x * 1.4426950408889634);
    double r = __builtin_fma(-k, 0.6931471805599453, x); r = __builtin_fma(-k, 2.3190468138462996e-17, r);
    double p = 1.6059043836821613e-10;
    p = p * r + 2.08767569878681e-09; p = p * r + 2.505210838544172e-08; p = p * r + 2.755731922398589e-07; p = p * r + 2.7557319223985893e-06; p = p * r + 2.48015873015873e-05;
    p = p * r + 0.0001984126984126984; p = p * r + 0.001388888888888889; p = p * r + 0.008333333333333333; p = p * r + 0.041666666666666664; p = p * r + 0.16666666666666666; p = p * r + 0.5; p = p * r + 1.0; p = p * r + 1.0;
    const long long bits = ((long long)k + 1023LL) << 52;
    return p * __builtin_bit_cast(double, bits);
}

__device__ __forceinline__ void rms_row_bf16(const float* xrow, const float* gain, bf16_t* orow, int lane) {
    const f32x4* xr = (const f32x4*)xrow + lane; const f32x4* gr = (const f32x4*)gain + lane;
    f32x4 v[8]; float s = 0.f;
#pragma unroll
    for (int j = 0; j < 8; ++j) { v[j] = xr[64 * j]; s += (v[j].x * v[j].x + v[j].y * v[j].y) + (v[j].z * v[j].z + v[j].w * v[j].w); }
    const float rs = 1.0f / sqrtf(wave_sum(s) * (1.f / DM) + EPS);
    u32x2* o8 = (u32x2*)orow + lane;
#pragma unroll
    for (int j = 0; j < 8; ++j) { const f32x4 g = gr[64 * j]; u32x2 w; w.x = cvt_pk_bf16(v[j].x * rs * g.x, v[j].y * rs * g.y); w.y = cvt_pk_bf16(v[j].z * rs * g.z, v[j].w * rs * g.w); o8[64 * j] = w; }
}
__device__ __forceinline__ void rms_row_f32_inplace(float* xrow, const float* gain, int lane) {
    f32x4* xr = (f32x4*)xrow + lane; const f32x4* gr = (const f32x4*)gain + lane;
    f32x4 v[8]; float s = 0.f;
#pragma unroll
    for (int j = 0; j < 8; ++j) { v[j] = xr[64 * j]; s += (v[j].x * v[j].x + v[j].y * v[j].y) + (v[j].z * v[j].z + v[j].w * v[j].w); }
    const float rs = 1.0f / sqrtf(wave_sum(s) * (1.f / DM) + EPS);
#pragma unroll
    for (int j = 0; j < 8; ++j) { const f32x4 g = gr[64 * j]; xr[64 * j] = v[j] * rs * g; }
}
__device__ __forceinline__ void rms_row_f32_ss(float* xrow, const float* gain, float ss, int lane) {
    f32x4* xr = (f32x4*)xrow + lane; const f32x4* gr = (const f32x4*)gain + lane;
    const float rs = 1.0f / sqrtf(ss * (1.f / DM) + EPS);
#pragma unroll
    for (int j = 0; j < 8; ++j) { const f32x4 g = gr[64 * j]; xr[64 * j] = xr[64 * j] * rs * g; }
}
__device__ __forceinline__ void attn_combine_row(const bf16_t* od, const float* subln, float lam, bf16_t* an, int lane) {
    const u32x4* p0 = (const u32x4*)(od + lane * 16); const u32x4* p1 = (const u32x4*)(od + 1024 + lane * 16);
    const u32x4 a0 = p0[0], a1 = p0[1], b0 = p1[0], b1 = p1[1];
    float d[16];
    const unsigned aw[8] = {a0.x, a0.y, a0.z, a0.w, a1.x, a1.y, a1.z, a1.w}, bw[8] = {b0.x, b0.y, b0.z, b0.w, b1.x, b1.y, b1.z, b1.w};
    float ss = 0.f;
#pragma unroll
    for (int i = 0; i < 8; ++i) { d[2 * i] = bf_lo(aw[i]) - lam * bf_lo(bw[i]); d[2 * i + 1] = bf_hi(aw[i]) - lam * bf_hi(bw[i]); ss += d[2 * i] * d[2 * i] + d[2 * i + 1] * d[2 * i + 1]; }
    ss = sum8(ss);
    const float rs = 0.8f / sqrtf(ss * (1.f / 128.f) + EPS);
    const float* g = subln + (lane & 7) * 16;
    u32x4 w0, w1;
    w0.x = cvt_pk_bf16(d[0] * rs * g[0], d[1] * rs * g[1]); w0.y = cvt_pk_bf16(d[2] * rs * g[2], d[3] * rs * g[3]); w0.z = cvt_pk_bf16(d[4] * rs * g[4], d[5] * rs * g[5]); w0.w = cvt_pk_bf16(d[6] * rs * g[6], d[7] * rs * g[7]);
    w1.x = cvt_pk_bf16(d[8] * rs * g[8], d[9] * rs * g[9]); w1.y = cvt_pk_bf16(d[10] * rs * g[10], d[11] * rs * g[11]); w1.z = cvt_pk_bf16(d[12] * rs * g[12], d[13] * rs * g[13]); w1.w = cvt_pk_bf16(d[14] * rs * g[14], d[15] * rs * g[15]);
    u32x4* o = (u32x4*)(an + lane * 16); o[0] = w0; o[1] = w1;
}
__device__ __forceinline__ void xsoftmax_head(const float* sc, bf16_t* prow, int l16) {
    const f32x4* sp = (const f32x4*)(sc + l16 * 16); f32x4 v[4]; float mx = -3.0e38f;
#pragma unroll
    for (int q = 0; q < 4; ++q) { v[q] = sp[q]; mx = fmaxf(mx, fmaxf(fmaxf(v[q].x, v[q].y), fmaxf(v[q].z, v[q].w))); }
    mx = max16(mx);
    float s = 0.f;
#pragma unroll
    for (int q = 0; q < 4; ++q) { v[q].x = __expf(v[q].x - mx); v[q].y = __expf(v[q].y - mx); v[q].z = __expf(v[q].z - mx); v[q].w = __expf(v[q].w - mx); s += (v[q].x + v[q].y) + (v[q].z + v[q].w); }
    s = sum16(s);
    const float inv = 1.0f / s;
    u32x4 w0, w1;
    w0.x = cvt_pk_bf16(v[0].x * inv, v[0].y * inv); w0.y = cvt_pk_bf16(v[0].z * inv, v[0].w * inv); w0.z = cvt_pk_bf16(v[1].x * inv, v[1].y * inv); w0.w = cvt_pk_bf16(v[1].z * inv, v[1].w * inv);
    w1.x = cvt_pk_bf16(v[2].x * inv, v[2].y * inv); w1.y = cvt_pk_bf16(v[2].z * inv, v[2].w * inv); w1.z = cvt_pk_bf16(v[3].x * inv, v[3].y * inv); w1.w = cvt_pk_bf16(v[3].z * inv, v[3].w * inv);
    u32x4* o = (u32x4*)(prow + l16 * 16); o[0] = w0; o[1] = w1;
}
__device__ __forceinline__ void xsoftmax_row(const float* sc, bf16_t* prow, int lane) {
    const f32x4* sp = (const f32x4*)(sc + lane * 16); f32x4 v[4]; float mx = -3.0e38f;
#pragma unroll
    for (int q = 0; q < 4; ++q) { v[q] = sp[q]; mx = fmaxf(mx, fmaxf(fmaxf(v[q].x, v[q].y), fmaxf(v[q].z, v[q].w))); }
    mx = max16(mx);
    float s = 0.f;
#pragma unroll
    for (int q = 0; q < 4; ++q) { v[q].x = __expf(v[q].x - mx); v[q].y = __expf(v[q].y - mx); v[q].z = __expf(v[q].z - mx); v[q].w = __expf(v[q].w - mx); s += (v[q].x + v[q].y) + (v[q].z + v[q].w); }
    s = sum16(s);
    const float inv = 1.0f / s;
    u32x4 w0, w1;
    w0.x = cvt_pk_bf16(v[0].x * inv, v[0].y * inv); w0.y = cvt_pk_bf16(v[0].z * inv, v[0].w * inv); w0.z = cvt_pk_bf16(v[1].x * inv, v[1].y * inv); w0.w = cvt_pk_bf16(v[1].z * inv, v[1].w * inv);
    w1.x = cvt_pk_bf16(v[2].x * inv, v[2].y * inv); w1.y = cvt_pk_bf16(v[2].z * inv, v[2].w * inv); w1.z = cvt_pk_bf16(v[3].x * inv, v[3].y * inv); w1.w = cvt_pk_bf16(v[3].z * inv, v[3].w * inv);
    u32x4* o = (u32x4*)(prow + lane * 16); o[0] = w0; o[1] = w1;
}

constexpr int SSM_T = 32, NCH = 512;
struct SsmParams { const float *lre, *lim, *ldt, *bre, *bim, *cre, *cim; };
__device__ __forceinline__ void ssm_discretise(const SsmParams& P, int idx, float* SBB, float* APOW) {
    const int dg = idx >> 6;
    const double lr = (double)P.lre[idx], li = (double)P.lim[idx];
    const double dt = dexp((double)P.ldt[dg]);
    const double mag = dexp(lr * dt); double sn, cs; dsincos(li * dt, sn, cs);
    const double abr = mag * cs, abi = mag * sn, den = lr * lr + li * li, nr = abr - 1.0, ni = abi;
    const double kr = (nr * lr + ni * li) / den, ki = (ni * lr - nr * li) / den;
#pragma unroll
    for (int c = 0; c < 16; ++c) { const double br = (double)P.bre[idx * 16 + c], bi = (double)P.bim[idx * 16 + c];
        SBB[(idx * 16 + c) * 2] = (float)(kr * br - ki * bi); SBB[(idx * 16 + c) * 2 + 1] = (float)(kr * bi + ki * br); }
    double pr = 1.0, pi = 0.0;
    for (int t = 0; t <= SSM_T; ++t) { APOW[(idx * 33 + t) * 2] = (float)pr; APOW[(idx * 33 + t) * 2 + 1] = (float)pi; const double nr2 = pr * abr - pi * abi, ni2 = pr * abi + pi * abr; pr = nr2; pi = ni2; }
}
__device__ __forceinline__ void ssm_w1_item(int item, const float* SBB, const float* APOW, bf16_t* W1) {
    const int k8 = item & 63, n = (item >> 6) & 255, g = item >> 14, d = n >> 7, q = n & 127, p = q & 63, isim = q >> 6, j = k8 >> 1, c0 = (k8 & 1) * 8;
    const int idx = (d * 64 + g) * 64 + p, e = d ? j : (SSM_T - 1 - j);
    const float ar = APOW[(idx * 33 + e) * 2], ai = APOW[(idx * 33 + e) * 2 + 1];
    float v[8];
#pragma unroll
    for (int c = 0; c < 8; ++c) { const float br = SBB[(idx * 16 + c0 + c) * 2], bi = SBB[(idx * 16 + c0 + c) * 2 + 1]; v[c] = isim ? (ar * bi + ai * br) : (ar * br - ai * bi); }
    u32x4 w; w.x = cvt_pk_bf16(v[0], v[1]); w.y = cvt_pk_bf16(v[2], v[3]); w.z = cvt_pk_bf16(v[4], v[5]); w.w = cvt_pk_bf16(v[6], v[7]);
    *(u32x4*)(W1 + ((size_t)(g * 256 + n) * 512 + k8 * 8)) = w;
}
__device__ __forceinline__ void ssm_kfb_item(int item, const float* SBB, const float* APOW, const float* cre, const float* cim, float* KFB) {
    const int c = item & 15, ch = (item >> 4) & 15, tau = (item >> 8) & 31, d = (item >> 13) & 1, g = item >> 14;
    float acc = 0.f;
    for (int p = 0; p < 64; ++p) { const int idx = (d * 64 + g) * 64 + p;
        const float ar = APOW[(idx * 33 + tau) * 2], ai = APOW[(idx * 33 + tau) * 2 + 1], br = SBB[(idx * 16 + c) * 2], bi = SBB[(idx * 16 + c) * 2 + 1];
        const float tr = ar * br - ai * bi, ti = ar * bi + ai * br;
        acc += cre[((d * 64 + g) * 16 + ch) * 64 + p] * tr - cim[((d * 64 + g) * 16 + ch) * 64 + p] * ti; }
    KFB[item] = acc;
}
__device__ __forceinline__ void ssm_w3_item(int item, const float* APOW, const float* KFB, const float* cre, const float* cim, const float* dsk, bf16_t* W3) {
    const int k8 = item % 96, n = (item / 96) & 511, g = item / (96 * 512), j = n >> 4, ch = n & 15;
    float v[8];
    if (k8 < 64) { const int i = k8 >> 1, c0 = (k8 & 1) * 8;
#pragma unroll
        for (int c = 0; c < 8; ++c) v[c] = 0.f;
        if (i <= j) { const float* kf = KFB + (((g * 2 + 0) * 32 + (j - i)) * 256 + ch * 16 + c0);
#pragma unroll
            for (int c = 0; c < 8; ++c) v[c] += kf[c]; }
        if (i >= j) { const float* kb = KFB + (((g * 2 + 1) * 32 + (i - j)) * 256 + ch * 16 + c0);
#pragma unroll
            for (int c = 0; c < 8; ++c) v[c] += kb[c]; }
        if (i == j && (ch >> 3) == (c0 >> 3)) {
#pragma unroll
            for (int c = 0; c < 8; ++c) v[c] += (c0 + c == ch) ? dsk[g * 16 + ch] : 0.f; }
    } else { const int kk = (k8 - 64) * 8, d = kk >> 7, q0 = kk & 127, isim = q0 >> 6, p0 = q0 & 63, pw = d ? (SSM_T - j) : (j + 1);
#pragma unroll
        for (int c = 0; c < 8; ++c) { const int p = p0 + c, idx = (d * 64 + g) * 64 + p;
            const float ar = APOW[(idx * 33 + pw) * 2], ai = APOW[(idx * 33 + pw) * 2 + 1], cr = cre[((d * 64 + g) * 16 + ch) * 64 + p], ci = cim[((d * 64 + g) * 16 + ch) * 64 + p];
            v[c] = isim ? -(cr * ai + ci * ar) : (cr * ar - ci * ai); } }
    u32x4 w; w.x = cvt_pk_bf16(v[0], v[1]); w.y = cvt_pk_bf16(v[2], v[3]); w.z = cvt_pk_bf16(v[4], v[5]); w.w = cvt_pk_bf16(v[6], v[7]);
    *(u32x4*)(W3 + ((size_t)(g * 512 + n) * 768 + k8 * 8)) = w;
}
__device__ __forceinline__ void ssm_carry_wave(const float* APOW, const float* CS, bf16_t* A3, int d, int g, int chunk0, int ncs, int lane) {
    const int p = lane, idx = (d * 64 + g) * 64 + p;
    const float atr = APOW[(idx * 33 + SSM_T) * 2], ati = APOW[(idx * 33 + SSM_T) * 2 + 1];
    float xr = 0.f, xi = 0.f;
    const float* cs = CS + ((size_t)(g * NCH + chunk0) * 256 + d * 128 + p);
    bf16_t* a3 = A3 + ((size_t)(g * NCH + chunk0) * 768 + 512 + d * 128 + p);
    for (int cc = 0; cc < ncs; cc += 8) {
        float sr[8], si[8];
#pragma unroll
        for (int e = 0; e < 8; ++e) { const int c = d ? (ncs - 1 - (cc + e)) : (cc + e); sr[e] = cs[(size_t)c * 256]; si[e] = cs[(size_t)c * 256 + 64]; }
#pragma unroll
        for (int e = 0; e < 8; ++e) { const int c = d ? (ncs - 1 - (cc + e)) : (cc + e);
            a3[(size_t)c * 768] = (bf16_t)(cvt_pk_bf16(xr, 0.f) & 0xffffu); a3[(size_t)c * 768 + 64] = (bf16_t)(cvt_pk_bf16(xi, 0.f) & 0xffffu);
            const float nr = atr * xr - ati * xi + sr[e], ni = atr * xi + ati * xr + si[e]; xr = nr; xi = ni; }
    }
}
constexpr int NWAVES = 8;
#ifndef WGM_WIDE
#define WGM_WIDE 4
#endif
#ifndef MK_PER_PHASE
#define MK_PER_PHASE 0
#endif
constexpr int NG = 3;
constexpr int MAXG = 16384;
constexpr int NPH_G = 9, NPH0 = 1, NPH = NPH0 + NG * NPH_G + 1;

constexpr size_t MiB = 1u << 20;
constexpr size_t WS_CTL = 0, CTL_ZERO_BYTES = 1 * MiB;
constexpr size_t WS_ROPE = 1 * MiB;
constexpr size_t WS_SBB = 4 * MiB;
constexpr size_t WS_WIN = 5 * MiB;
constexpr size_t WS_WAP = WS_WIN + 32 * MiB;
constexpr size_t WS_WGLU = WS_WAP + 4 * MiB;
constexpr size_t WS_WMO = WS_WGLU + 8 * MiB;
constexpr size_t WS_WQC = WS_WMO + 8 * MiB;
constexpr size_t WS_WKV = WS_WQC + 8 * MiB;
constexpr size_t WS_WOC = WS_WKV + 16 * MiB;
constexpr size_t WS_WUP = WS_WOC + 8 * MiB;
constexpr size_t WS_WDN = WS_WUP + 32 * MiB;
constexpr size_t WS_MN = WS_WDN + 32 * MiB;
constexpr size_t WS_KVM = WS_MN + 8 * MiB;
constexpr size_t WS_XN = WS_KVM + 16 * MiB;
constexpr size_t WS_QKVU = WS_XN + 64 * MiB;
constexpr size_t WS_GATES = WS_QKVU + 128 * MiB;
constexpr size_t WS_H = WS_QKVU;
constexpr size_t WS_OD = WS_GATES + 128 * MiB;
constexpr size_t WS_OC = WS_OD;
constexpr size_t WS_AN = WS_OD + 64 * MiB;
constexpr size_t WS_Z = WS_AN + 32 * MiB;
constexpr size_t WS_MIX = WS_Z + 32 * MiB;
constexpr size_t WS_TQ = WS_MIX + 64 * MiB;
constexpr size_t WS_TVT = WS_TQ + 32 * MiB;
constexpr size_t WS_QC = WS_TQ;
constexpr size_t WS_SC = WS_QC + 64 * MiB;
constexpr size_t WS_P = WS_SC + 64 * MiB;
constexpr size_t WS_A3 = WS_P + 32 * MiB;
constexpr size_t WS_CS = WS_A3 + 48 * MiB;
constexpr size_t WS_W1 = WS_CS + 32 * MiB;
constexpr size_t WS_W3 = WS_W1 + 16 * MiB;
constexpr size_t WS_KFB = WS_W3 + 48 * MiB;
constexpr size_t WS_APOW = WS_KFB + 4 * MiB;
constexpr size_t WS_END = WS_APOW + 3 * MiB;
static_assert(WS_END <= 1024 * MiB, "workspace map");
constexpr int CW_BAR = 4096;

constexpr int RING_BYTES = 131072, LDSCTL_OFF = RING_BYTES, MISC_OFF = LDSCTL_OFF + 320, LDS_BYTES = 147456;

typedef GAS unsigned gu32;
#define RLX_AGENT __ATOMIC_RELAXED, __HIP_MEMORY_SCOPE_AGENT
#define LDS_WAIT() asm volatile("s_waitcnt lgkmcnt(0)" ::: "memory")

#define XB_TMO      128
#define XB_XCNT(j)  (256  + 64 * (j))
#define XB_XSUB(j)  (1280 + 64 * (j))
#define XB_XGEN(j)  (2304 + 64 * (j))
#define XB_TOP      3328
#define XB_TOPGEN   3392
#define XCD_BAR_WORDS 3456
#define XB_SPIN_CAP (1u << 22)
__device__ __forceinline__ unsigned xb_ld(gu32* p)              { return __hip_atomic_load(p, __ATOMIC_RELAXED, __HIP_MEMORY_SCOPE_AGENT); }
__device__ __forceinline__ unsigned xb_add(gu32* p, unsigned v) { return __hip_atomic_fetch_add(p, v, __ATOMIC_RELAXED, __HIP_MEMORY_SCOPE_AGENT); }
__device__ __forceinline__ unsigned xb_xcc_id() { return (unsigned)__builtin_amdgcn_s_getreg((3 << 11) | 20) & 0xFu; }
#define XB_SPIN(cond, bar) do { unsigned _sp = 0; while (cond) { __builtin_amdgcn_s_sleep(1); \
    if ((++_sp & 255u) == 0u) { if (xb_ld(&(bar)[XB_TMO])) break; if (_sp > XB_SPIN_CAP) { (void)xb_add(&(bar)[XB_TMO], 1u); break; } } } } while (0)
struct XcdBarrier { gu32* bar; unsigned x; volatile LAS unsigned* st; };
__device__ __forceinline__ XcdBarrier xcd_barrier_post(gu32* bar, volatile LAS unsigned* st) {
    XcdBarrier b; b.bar = bar; b.x = xb_xcc_id(); b.st = st;
    if (threadIdx.x == 0) (void)xb_add(&bar[XB_XCNT(b.x)], 1u);
    return b;
}
__device__ __forceinline__ void xcd_barrier_complete(gu32* bar, unsigned x, unsigned& nloc, unsigned& nx) {
    const unsigned G = gridDim.x * gridDim.y * gridDim.z;
    unsigned sum, cnt, mine, sp = 0u;
    for (;;) {
        sum = 0u; cnt = 0u; mine = 0u;
#pragma unroll
        for (unsigned j = 0; j < 16; ++j) { const unsigned c = xb_ld(&bar[XB_XCNT(j)]); sum += c; cnt += (c > 0u) ? 1u : 0u; mine = (j == x) ? c : mine; }
        if (sum == G) break;
        __builtin_amdgcn_s_sleep(1);
        if ((++sp & 255u) == 0u) { if (xb_ld(&bar[XB_TMO])) break; if (sp > XB_SPIN_CAP) { (void)xb_add(&bar[XB_TMO], 1u); break; } }
    }
    nloc = mine > 0u ? mine : 1u; nx = cnt > 0u ? cnt : 1u;
}
__device__ __forceinline__ void xcd_barrier(const XcdBarrier& b) {
    asm volatile("s_waitcnt vmcnt(0)" ::: "memory");
    __syncthreads();
    if (threadIdx.x == 0) {
        gu32* bar = b.bar; unsigned bx_ = b.x; asm volatile("" : "+s"(bar), "+s"(bx_));
        __builtin_amdgcn_s_waitcnt(0);
        unsigned nloc = b.st[0], nx = b.st[1];
        if (nloc == 0u) { xcd_barrier_complete(bar, bx_, nloc, nx); b.st[0] = nloc; b.st[1] = nx; }
        const unsigned old = xb_add(&bar[XB_XSUB(bx_)], 1u);
        const unsigned gen = old / nloc;
        if (old + 1u == (gen + 1u) * nloc) {
            __builtin_amdgcn_fence(__ATOMIC_RELEASE, "agent");
            asm volatile("s_waitcnt vmcnt(0)" ::: "memory");
            const unsigned og = xb_add(&bar[XB_TOP], 1u);
            const unsigned tg = og / nx;
            if (og + 1u == (tg + 1u) * nx) xb_add(&bar[XB_TOPGEN], 1u);
            else XB_SPIN(xb_ld(&bar[XB_TOPGEN]) == tg, bar);
            __builtin_amdgcn_fence(__ATOMIC_ACQUIRE, "agent");
            xb_add(&bar[XB_XGEN(bx_)], 1u);
            asm volatile("s_waitcnt vmcnt(0)" ::: "memory");
        } else {
            XB_SPIN(xb_ld(&bar[XB_XGEN(bx_)]) == gen, bar);
            __builtin_amdgcn_fence(__ATOMIC_ACQUIRE, "agent");
            asm volatile("s_waitcnt vmcnt(0)" ::: "memory");
        }
    }
    __syncthreads();
}

__device__ __forceinline__ unsigned f2bf(float f) { unsigned u = __builtin_bit_cast(unsigned, f); return (u + 0x7fffu + ((u >> 16) & 1u)) >> 16; }
__device__ __forceinline__ unsigned pk2(float lo, float hi) { return f2bf(lo) | (f2bf(hi) << 16); }
template <int MODE>
__device__ __forceinline__ void p0_transpose_tile(const float* W, int K, int N, bf16_t* WT, int which, LAS float* T, int item, int tid) {
    const int nblk = N / 128, kb = item / nblk, nb = item - kb * nblk, k0 = 128 * kb, n0 = 128 * nb;
    { const int r = tid >> 5, c4 = tid & 31; f32x4 v[8];
#pragma unroll
      for (int p = 0; p < 8; ++p) v[p] = *(const f32x4*)(W + (size_t)(k0 + 16 * p + r) * N + n0 + 4 * c4);
#pragma unroll
      for (int p = 0; p < 8; ++p) { LAS float* d = T + (16 * p + r) * 129 + 4 * c4; d[0] = v[p].x; d[1] = v[p].y; d[2] = v[p].z; d[3] = v[p].w; } }
    __syncthreads();
#pragma unroll
    for (int q = 0; q < 4; ++q) { const int cid = q * 512 + tid, n = cid >> 4, ch = cid & 15; const LAS float* sp = T + (8 * ch) * 129 + n;
        u32x4 o; o.x = pk2(sp[0 * 129], sp[1 * 129]); o.y = pk2(sp[2 * 129], sp[3 * 129]); o.z = pk2(sp[4 * 129], sp[5 * 129]); o.w = pk2(sp[6 * 129], sp[7 * 129]);
        const int nl = n0 + n; int prow;
        if (MODE == 0) prow = nl;
        else if (MODE == 1) { if (nl < 2048) { const int o64 = nl & 63; prow = (nl & ~63) + 8 * ((o64 & 31) >> 2) + 4 * (o64 >> 5) + (o64 & 3); } else prow = nl; }
        else prow = 8 * (nl >> 2) + 4 * which + (nl & 3);
        *(GAS u32x4*)(WT + (size_t)prow * K + k0 + 8 * ch) = o; }
    __syncthreads();
}

struct Args { const float* in[29]; float* out; unsigned char* ws; int ph_lo, ph_hi; };

__global__ void __launch_bounds__(NWAVES * 64, 2) fwd_kernel(Args args) {
    extern __shared__ __attribute__((aligned(16))) unsigned char lds[];
    LAS unsigned char* ldsl = (LAS unsigned char*)lds;
    volatile LAS unsigned* MISC = (volatile LAS unsigned*)(ldsl + MISC_OFF);
    const int tid = threadIdx.x, lane = tid & 63, wave = __builtin_amdgcn_readfirstlane(tid >> 6);
    const int G = gridDim.x, bx = blockIdx.x;
    const int vcu = (G % 8 == 0) ? (bx % 8) * (G / 8) + bx / 8 : bx;
    const int gw = vcu * NWAVES + wave, NGW = G * NWAVES;
    unsigned char* ws = args.ws;
    unsigned* ctl = (unsigned*)(ws + WS_CTL);
    for (int u = tid; u < (LDS_BYTES - LDSCTL_OFF) / 4; u += NWAVES * 64) ((LAS unsigned*)(ldsl + LDSCTL_OFF))[u] = 0u;
    __syncthreads();
    XcdBarrier bar; bar.bar = (gu32*)(ctl + CW_BAR); bar.x = 0; bar.st = nullptr;
    if (!MK_PER_PHASE) bar = xcd_barrier_post((gu32*)(ctl + CW_BAR), MISC + 8);
    const int lo = args.ph_lo, hi = args.ph_hi;
#ifndef DBG_ONLY
#define DBG_ONLY -1
#endif
#ifndef DBG_REPEAT_MASK
#define DBG_REPEAT_MASK 0u
#endif
#ifndef DBG_REPEAT_PRO
#define DBG_REPEAT_PRO 0u
#endif
#define IN(k) (lo <= (k) && (k) < hi)
#define PHASE(n) for (int rep_ = 0; rep_ < (((DBG_REPEAT_MASK >> (n)) & 1u) ? 2 : 1); ++rep_) if ((DBG_ONLY < 0 || DBG_ONLY == NPH0 + (n)) && IN(pb + (n)))
#define SEAM(k) do { if (!MK_PER_PHASE && IN(k) && IN((k) + 1)) xcd_barrier(bar); } while (0)

    const float* x_prompt = args.in[0]; const float* x_sample = args.in[1]; const float* mem_prompt = args.in[2]; const float* mem_sample = args.in[3];
    float* out = args.out;
    bf16_t* W_IN = (bf16_t*)(ws + WS_WIN); bf16_t* W_AP = (bf16_t*)(ws + WS_WAP); bf16_t* W_GLU = (bf16_t*)(ws + WS_WGLU); bf16_t* W_MO = (bf16_t*)(ws + WS_WMO);
    bf16_t* W_QC = (bf16_t*)(ws + WS_WQC); bf16_t* W_KV = (bf16_t*)(ws + WS_WKV); bf16_t* W_OC = (bf16_t*)(ws + WS_WOC); bf16_t* W_UP = (bf16_t*)(ws + WS_WUP); bf16_t* W_DN = (bf16_t*)(ws + WS_WDN);
    bf16_t* MN = (bf16_t*)(ws + WS_MN); bf16_t* KVM = (bf16_t*)(ws + WS_KVM); bf16_t* TQ = (bf16_t*)(ws + WS_TQ); bf16_t* TVT = (bf16_t*)(ws + WS_TVT);
    bf16_t* XN0 = (bf16_t*)(ws + WS_XN); bf16_t* XN1 = (bf16_t*)(ws + WS_OD); bf16_t* QKVU = (bf16_t*)(ws + WS_QKVU); bf16_t* GATES = (bf16_t*)(ws + WS_GATES); bf16_t* HB = (bf16_t*)(ws + WS_H);
    bf16_t* OD = (bf16_t*)(ws + WS_OD); bf16_t* OC = (bf16_t*)(ws + WS_OC); bf16_t* AN = (bf16_t*)(ws + WS_AN); bf16_t* ZB = (bf16_t*)(ws + WS_Z); bf16_t* MIX = (bf16_t*)(ws + WS_MIX);
    bf16_t* A3 = (bf16_t*)(ws + WS_A3); float* CS = (float*)(ws + WS_CS); bf16_t* W1 = (bf16_t*)(ws + WS_W1); bf16_t* W3 = (bf16_t*)(ws + WS_W3); float* KFB = (float*)(ws + WS_KFB); float* APOW = (float*)(ws + WS_APOW);
    float* SC = (float*)(ws + WS_SC); bf16_t* PB = (bf16_t*)(ws + WS_P);
    float* SS1 = (float*)(ws + WS_CTL + 65536); float* SS2 = SS1 + NTOK; float* SS3 = SS2 + NTOK;
    float* ROPE = (float*)(ws + WS_ROPE); float* SBB = (float*)(ws + WS_SBB);

    for (int rep_ = 0; rep_ < ((DBG_REPEAT_PRO & 1u) ? 2 : 1); ++rep_) if ((DBG_ONLY < 0 || DBG_ONLY == 0) && IN(0)) {
        { LAS float* T = (LAS float*)ldsl;
          constexpr int I_WIN = (DM / 128) * (INC / 128), I_AP = (AW / 128) * (DM / 128), I_GL = (SW / 128) * (DM / 128), I_SQ = (DM / 128) * (DM / 128), I_KV = (DM / 128) * (4096 / 128), I_UP = (DM / 128) * (DFF / 128), I_DN = (DFF / 128) * (DM / 128);
          constexpr int NITEMS = I_WIN + I_AP + 2 * I_GL + 2 * I_SQ + I_KV + I_UP + I_DN;
          for (int it = vcu; it < NITEMS; it += G) {
            int r = it;
            if (r < I_WIN) { p0_transpose_tile<1>(args.in[5], DM, INC, W_IN, 0, T, r, tid); continue; } r -= I_WIN;
            if (r < I_AP) { p0_transpose_tile<0>(args.in[8], AW, DM, W_AP, 0, T, r, tid); continue; } r -= I_AP;
            if (r < I_GL) { p0_transpose_tile<2>(args.in[17], SW, DM, W_GLU, 0, T, r, tid); continue; } r -= I_GL;
            if (r < I_GL) { p0_transpose_tile<2>(args.in[18], SW, DM, W_GLU, 1, T, r, tid); continue; } r -= I_GL;
            if (r < I_SQ) { p0_transpose_tile<0>(args.in[19], DM, DM, W_MO, 0, T, r, tid); continue; } r -= I_SQ;
            if (r < I_SQ) { p0_transpose_tile<0>(args.in[24], DM, DM, W_OC, 0, T, r, tid); continue; } r -= I_SQ;
            if (r < I_KV) { p0_transpose_tile<0>(args.in[23], DM, 4096, W_KV, 0, T, r, tid); continue; } r -= I_KV;
            if (r < I_UP) { p0_transpose_tile<0>(args.in[26], DM, DFF, W_UP, 0, T, r, tid); continue; } r -= I_UP;
            p0_transpose_tile<0>(args.in[27], DFF, DM, W_DN, 0, T, r, tid);
          } }
        for (int i = gw * 64 + lane; i < DM * DM / 8; i += NGW * 64) { const f32x4* p = (const f32x4*)(args.in[22] + (size_t)i * 8); const f32x4 a = p[0], b = p[1];
            u32x4 w; w.x = pk2(a.x, a.y); w.y = pk2(a.z, a.w); w.z = pk2(b.x, b.y); w.w = pk2(b.z, b.w); *(u32x4*)(W_QC + (size_t)i * 8) = w; }
        for (int i = gw * 64 + lane; i < LPR * 32; i += NGW * 64) { const int pos = i >> 5, f = i & 31;
            const float inv = (float)dexp(-(double)f * (9.210340371976184 / 32.0));
            const float ang = (float)pos * inv; double s, c; dsincos((double)ang, s, c);
            ROPE[pos * 64 + f] = (float)c; ROPE[pos * 64 + 32 + f] = (float)s; }
        { const SsmParams P{args.in[9], args.in[10], args.in[11], args.in[12], args.in[13], args.in[14], args.in[15]};
          for (int i = gw * 64 + lane; i < 8192; i += NGW * 64) ssm_discretise(P, i, SBB, APOW); }
        for (int m = gw; m < 16384; m += NGW) rms_row_bf16(x_prompt + (size_t)m * DM, args.in[4], XN0 + (size_t)m * DM, lane);
        for (int m = gw; m < NMEMROWS; m += NGW) { const float* src = m < 1024 ? mem_prompt + (size_t)m * DM : mem_sample + (size_t)(m - 1024) * DM; rms_row_bf16(src, args.in[21], MN + (size_t)m * DM, lane); }
    }
    SEAM(0);

    for (int gi = 0; gi < NG; ++gi) {
        const int pb = NPH0 + gi * NPH_G; if (pb >= hi || pb + NPH_G <= lo) continue;
        const int grow0 = gi * 16384, M = gi < 2 ? 16384 : 8192;
        const int L = grow0 < NPROMPT ? LPR : LSA, nseq = M / L, seq0 = grow0 < NPROMPT ? grow0 / LPR : 4 + (grow0 - NPROMPT) / LSA;
        bf16_t* XN = (gi & 1) ? XN1 : XN0; bf16_t* XNnext = (gi & 1) ? XN0 : XN1;
        PHASE(0) {
            if (gi > 0) { int tl_ = threadIdx.x; asm volatile("" : "+v"(tl_)); const int lane = tl_ & 63; const int gp = (gi - 1) * 16384, Mp = 16384;
                for (int m = gw; m < Mp; m += NGW) rms_row_f32_ss(out + (size_t)(gp + m) * DM, args.in[28], SS3[gp + m], lane); }
            { pg8::Gemm g{DM, DM, DM}; pg8::TileOrder S; S.init(XN, DM, W_IN, DM, M, INC, G, bx, WGM_WIDE); pg8::EpiWin E{QKVU, GATES, ROPE, grow0, A3}; pg8::gemm_phase(ldsl, g, S, E); }
            if (gi == 0) {
                struct MemOrder { const bf16_t* MN; const bf16_t* WKV; int G, c;
                    __device__ bool next(int i, pg8::Unit& u) const { const int id = i * G + c; if (id >= 128) return false; u.pm = id >> 4; u.pn = id & 15;
                        u.a = (const char*)(MN + (size_t)u.pm * 256 * DM); u.b = (const char*)(WKV + (size_t)u.pn * 256 * DM); return true; } };
                pg8::Gemm g{DM, DM, DM}; MemOrder S{MN, W_KV, G, G == 256 ? ((bx + 128) & 255) : bx}  ; pg8::EpiBf16<0> E{KVM, 4096, 1.0f}; pg8::gemm_phase(ldsl, g, S, E);
                int tl_ = threadIdx.x; asm volatile("" : "+v"(tl_)); const int lane = tl_ & 63;
                for (int it = gw * 64 + lane; it < 64 * 256 * 64; it += NGW * 64) ssm_w1_item(it, SBB, APOW, W1);
                for (int it = gw * 64 + lane; it < 64 * 2 * 32 * 256; it += NGW * 64) ssm_kfb_item(it, SBB, APOW, args.in[14], args.in[15], KFB);
            }
        }
        SEAM(pb + 0);
        PHASE(1) {
            int tl_ = threadIdx.x; asm volatile("" : "+v"(tl_)); const int lane = tl_ & 63;
            if (gi + 1 < NG) { const int g1 = (gi + 1) * 16384, M1 = gi + 1 < 2 ? 16384 : 8192, h0 = (G == 256) ? 128 : 0, nh = G - h0;
                if (bx >= h0) for (int m = (bx - h0) * NWAVES + wave; m < M1; m += nh * NWAVES) { const int gr = g1 + m; const float* src = gr < NPROMPT ? x_prompt + (size_t)gr * DM : x_sample + (size_t)(gr - NPROMPT) * DM; rms_row_bf16(src, args.in[4], XNnext + (size_t)m * DM, lane); } }
            float lam; { const float* dl = args.in[6]; float t0 = dl[lane] * dl[64 + lane], t1 = dl[128 + lane] * dl[192 + lane]; t0 = wave_sum(t0); t1 = wave_sum(t1); lam = __expf(t0) - __expf(t1) + 0.2f; }
            const int nqb = L / 128, NU = nseq * 8 * nqb;
            for (int i = 0;; ++i) {
                int un; if (G == 256 && NU % 256 == 0) { const int per = NU / 8; un = (vcu >> 5) * per + (vcu & 31) + 32 * i; if (32 * i + (vcu & 31) >= per) break; } else { un = bx + i * G; if (un >= NU) break; }
                const int qb = un % nqb, sh = un / nqb, h = sh & 7, s = sh >> 3; const size_t srow = (size_t)s * L;
                attn3::attn_unit3(QKVU + (srow + (size_t)qb * 128) * 4096 + h * 128, QKVU + srow * 4096 + 1024 + h * 128, QKVU + srow * 4096 + 2048 + h * 128, AN + (srow + (size_t)qb * 128) * 1024 + h * 128, args.in[7], lam, L, (LAS char*)ldsl);
            }
            struct S1Order { const bf16_t* A3; const bf16_t* W1; int nmb, G, c;
                __device__ bool next(int i, pg8::Unit& u) const { const int id = i * G + c; if (id >= 64 * nmb) return false; const int g = id / nmb, mb = id - g * nmb;
                    u.pm = g * (NCH / 256) + mb; u.pn = 0; u.a = (const char*)(A3 + (size_t)(g * NCH + mb * 256) * 768); u.b = (const char*)(W1 + (size_t)g * 256 * 512); return true; } };
            { pg8::Gemm g{768, 512, 512}; S1Order S{A3, W1, M / (32 * 256), G, bx}; pg8::EpiF32 E{CS, 256}; pg8::gemm_phase(ldsl, g, S, E); }
            { int tl2_ = threadIdx.x; asm volatile("" : "+v"(tl2_)); const int lane = tl2_ & 63; const int nmb = M / (32 * 256), ncs = L / 32, nsb = 256 / ncs;
              for (int id = bx; id < 64 * nmb; id += G) { const int g = id / nmb, mb = id - g * nmb, sb = wave >> 1, d = wave & 1;
                  if (sb < nsb) ssm_carry_wave(APOW, CS, A3, d, g, mb * 256 + sb * ncs, ncs, lane); } }
            if (gi == 0) {
                struct TqOrder { const bf16_t* KVM; const bf16_t* WQ; int G, c;
                    __device__ bool next(int i, pg8::Unit& u) const { const int id = i * G + c; if (id >= 256) return false; const int sq = id >> 5, hx = (id >> 3) & 3, nb = id & 7;
                        u.pm = sq * 4 + hx; u.pn = nb; u.a = (const char*)(KVM + (size_t)sq * 256 * 4096 + hx * 512); u.b = (const char*)(WQ + (size_t)nb * 256 * DM + hx * 512); return true; } };
                struct TvOrder { const bf16_t* WO; const bf16_t* KVM; int G, c;
                    __device__ bool next(int i, pg8::Unit& u) const { const int id = i * G + c; if (id >= 256) return false; const int sq = id >> 5, hx = (id >> 3) & 3, mb = id & 7;
                        u.pm = sq * 8 + mb; u.pn = hx; u.a = (const char*)(WO + (size_t)mb * 256 * DM + hx * 512); u.b = (const char*)(KVM + (size_t)sq * 256 * 4096 + 2048 + hx * 512); return true; } };
                { pg8::Gemm g{4096, DM, 512}; TqOrder S{KVM, W_QC, G, bx}; pg8::EpiBf16<0> E{TQ, DM, 0.044194173824159216f}; pg8::gemm_phase(ldsl, g, S, E); }
                { pg8::Gemm g{DM, 4096, 512}; TvOrder S{W_OC, KVM, G, bx}; pg8::EpiBf16<0> E{TVT, 1024, 1.0f}; pg8::gemm_phase(ldsl, g, S, E); }
                int tl3_ = threadIdx.x; asm volatile("" : "+v"(tl3_)); const int lane = tl3_ & 63;
                for (int it = gw * 64 + lane; it < 64 * 512 * 96; it += NGW * 64) ssm_w3_item(it, APOW, KFB, args.in[14], args.in[15], args.in[16], W3);
            }
        }
        SEAM(pb + 1);
        PHASE(2) {
            { pg8::Gemm g{AW, AW, AW}; pg8::TileOrder S; S.init(AN, AW, W_AP, AW, M, DM, G, bx); pg8::EpiAttnProj E{GATES, MIX}; pg8::gemm_phase(ldsl, g, S, E); }
            struct S3Order { const bf16_t* A3; const bf16_t* W3; int nmb, G, c;
                __device__ bool next(int i, pg8::Unit& u) const { const int id = i * G + c; if (id >= 128 * nmb) return false; const int nb = id & 1, gm = id >> 1, g = gm / nmb, mb = gm - g * nmb;
                    u.pm = g * (NCH / 256) + mb; u.pn = nb; u.a = (const char*)(A3 + (size_t)(g * NCH + mb * 256) * 768); u.b = (const char*)(W3 + (size_t)(g * 512 + nb * 256) * 768); return true; } };
            pg8::Gemm g{768, 768, 768}; S3Order S{A3, W3, M / (32 * 256), G, bx}; pg8::EpiSsmOut E{ZB}; pg8::gemm_phase(ldsl, g, S, E);
        }
        SEAM(pb + 2);
        PHASE(3) { pg8::Gemm g{SW, SW, SW}; pg8::TileOrder S; S.init(ZB, SW, W_GLU, SW, M, 4096, G, bx); pg8::EpiGlu E{GATES, MIX}; pg8::gemm_phase(ldsl, g, S, E); }
        SEAM(pb + 3);
        PHASE(4) { pg8::Gemm g{DM, DM, DM}; pg8::TileOrder S; S.init(MIX, DM, W_MO, DM, M, DM, G, bx); pg8::EpiResidSS E{x_prompt, x_sample, out, grow0, 1, SS1, XN, args.in[20]}; pg8::gemm_phase(ldsl, g, S, E); }
        SEAM(pb + 4);
        PHASE(5) {
            struct OneScore { const char* a; const char* b; int pm, pn;
                __device__ bool next(int i, pg8::Unit& u) const { if (i > 0) return false; u.a = a; u.b = b; u.pm = pm; u.pn = pn; return true; } };
            const int nrb = M / 256, rbsh = (L == LPR) ? 5 : 3;
            for (int id = vcu; id < nrb * 4; id += G) { const int hx = id & 3, rb = id >> 2, sq = seq0 + (rb >> rbsh);
                { pg8::Gemm g{DM, DM, DM}; OneScore S{(const char*)(XN + (size_t)rb * 256 * DM), (const char*)(TQ + ((size_t)sq * 1024 + hx * 256) * DM), rb, hx};
                  pg8::EpiF32Rs E{SC, 1024, SS1, grow0}; pg8::gemm_phase(ldsl, g, S, E); }
                for (int r4 = wave; r4 < 64; r4 += NWAVES) { const size_t row = (size_t)rb * 256 + r4 * 4 + (lane >> 4);
                    xsoftmax_head(SC + row * 1024 + hx * 256, PB + row * 1024 + hx * 256, lane & 15); }
            }
        }
        SEAM(pb + 5);
        PHASE(6) {
            struct XoOrder { pg8::TileOrder T; const bf16_t* TVT; int rbsh, seq0;
                __device__ bool next(int i, pg8::Unit& u) const { if (!T.next(i, u)) return false; u.b = (const char*)(TVT + ((size_t)(seq0 + (u.pm >> rbsh)) * 2048 + u.pn * 256) * 1024); return true; } };
            pg8::Gemm g{1024, 1024, 1024}; XoOrder S; S.T.init(PB, 1024, TVT, 1024, M, DM, G, bx); S.TVT = TVT; S.rbsh = (L == LPR) ? 5 : 3; S.seq0 = seq0;
            pg8::EpiResidSS E{x_prompt, x_sample, out, grow0, 0, SS2, XN, args.in[25]}; pg8::gemm_phase(ldsl, g, S, E);
        }
        SEAM(pb + 6);
        PHASE(7) { pg8::Gemm g{DM, DM, DM}; pg8::TileOrder S; S.init(XN, DM, W_UP, DM, M, DFF, G, bx, WGM_WIDE); pg8::EpiBf16Rs<2> E{HB, DFF, 1.0f, SS2, grow0}; pg8::gemm_phase(ldsl, g, S, E); }
        SEAM(pb + 7);
        PHASE(8) { pg8::Gemm g{DFF, DFF, DFF}; pg8::TileOrder S; S.init(HB, DFF, W_DN, DFF, M, DM, G, bx); pg8::EpiResidSS E{x_prompt, x_sample, out, grow0, 0, SS3, nullptr, nullptr}; pg8::gemm_phase(ldsl, g, S, E); }
        SEAM(pb + 8);
    }
    if ((DBG_ONLY < 0 || DBG_ONLY == NPH - 1) && IN(NPH - 1)) { int tl_ = threadIdx.x; asm volatile("" : "+v"(tl_)); const int lane = tl_ & 63; const int gp = (NG - 1) * 16384, Mp = 8192; for (int m = gw; m < Mp; m += NGW) rms_row_f32_ss(out + (size_t)(gp + m) * DM, args.in[28], SS3[gp + m], lane); }
#undef IN
#undef PHASE
#undef SEAM
}

#ifdef DBG_STOP
__global__ void dump_kernel(const unsigned char* ws, size_t off, size_t nelem, int is_f32, float* out, size_t nout) {
    for (size_t i = (size_t)blockIdx.x * blockDim.x + threadIdx.x; i < nout; i += (size_t)gridDim.x * blockDim.x) { const size_t idx = i % nelem;
        float v = is_f32 ? ((const float*)(ws + off))[idx] : __uint_as_float((unsigned)((const bf16_t*)(ws + off))[idx] << 16);
        if (!(v == v) || fabsf(v) > 1e30f) v = 12345.f; out[i] = v; }
}
#endif
extern "C" void kernel_launch(void* const* d_in, const int* in_sizes, int n_in, void* d_out, int out_size, void* d_ws, size_t ws_size, hipStream_t stream) {
    static int grid = 0;
    if (grid == 0) {
        if (n_in != 29 || out_size != NTOK * DM || ws_size < WS_END) { fprintf(stderr, "kernel_launch: unexpected shapes: n_in %d out %d ws %zu (need %zu)\n", n_in, out_size, ws_size, (size_t)WS_END); grid = -1; return; }
        int dev = 0, cus = 0, per_cu = 0;
        if (hipGetDevice(&dev) != hipSuccess || hipDeviceGetAttribute(&cus, hipDeviceAttributeMultiprocessorCount, dev) != hipSuccess) { grid = -1; return; }
        if (hipFuncSetAttribute((const void*)fwd_kernel, hipFuncAttributeMaxDynamicSharedMemorySize, LDS_BYTES) != hipSuccess) { fprintf(stderr, "kernel_launch: hipFuncSetAttribute failed\n"); grid = -1; return; }
        if (hipOccupancyMaxActiveBlocksPerMultiprocessor(&per_cu, (const void*)fwd_kernel, NWAVES * 64, LDS_BYTES) != hipSuccess || per_cu < 1) { fprintf(stderr, "kernel_launch: occupancy query says %d\n", per_cu); }
        (void)hipGetLastError();
        grid = cus;
    }
    if (grid < 0) return;
    (void)hipMemsetAsync((char*)d_ws + WS_CTL, 0, CTL_ZERO_BYTES, stream);
    Args a{};
    for (int i = 0; i < 29; ++i) a.in[i] = (const float*)d_in[i];
    a.out = (float*)d_out; a.ws = (unsigned char*)d_ws;
#if MK_PER_PHASE
#ifdef DBG_STOP
    for (int p = 0; p < DBG_STOP; ++p) { a.ph_lo = p; a.ph_hi = p + 1; hipLaunchKernelGGL(fwd_kernel, dim3(grid), dim3(NWAVES * 64), LDS_BYTES, stream, a); }
    hipLaunchKernelGGL(dump_kernel, dim3(2048), dim3(256), 0, stream, (const unsigned char*)d_ws, (size_t)DBG_OFF, (size_t)DBG_NELEM, (int)DBG_F32, (float*)d_out, (size_t)NTOK * DM);
#else
    for (int p = 0; p < NPH; ++p) { a.ph_lo = p; a.ph_hi = p + 1; hipLaunchKernelGGL(fwd_kernel, dim3(grid), dim3(NWAVES * 64), LDS_BYTES, stream, a); }
#endif
#else
    a.ph_lo = 0; a.ph_hi = NPH; hipLaunchKernelGGL(fwd_kernel, dim3(grid), dim3(NWAVES * 64), LDS_BYTES, stream, a);
#endif
}
```

```cpp
#include <hip/hip_runtime.h>
#include <hip/hip_bf16.h>
#include <cstdio>
#include <cstdint>
#include <cmath>

#define LAS __attribute__((address_space(3)))
#define GAS __attribute__((address_space(1)))
typedef unsigned short bf16_t;
typedef short bf16x8 __attribute__((ext_vector_type(8)));
typedef short s16x4 __attribute__((ext_vector_type(4)));
typedef float f32x4 __attribute__((ext_vector_type(4)));
typedef float f32x2 __attribute__((ext_vector_type(2)));
typedef float f32x16 __attribute__((ext_vector_type(16)));
typedef unsigned u32x4 __attribute__((ext_vector_type(4)));
typedef unsigned u32x2 __attribute__((ext_vector_type(2)));

constexpr int DM = 2048, NTOK = 40960, NPROMPT = 32768, LPR = 8192, LSA = 2048;
constexpr int INC = 8192, AW = 1024, SW = 1024, DFF = 8192, NMEMROWS = 2048;
constexpr float EPS = 1e-6f;

typedef __bf16 bf16x2_t __attribute__((ext_vector_type(2)));
__device__ __forceinline__ unsigned cvt_pk_bf16(float lo, float hi) { f32x2 v = {lo, hi}; bf16x2_t b = __builtin_convertvector(v, bf16x2_t); return __builtin_bit_cast(unsigned, b); }
__device__ __forceinline__ float bf_lo(unsigned w) { return __uint_as_float(w << 16); }
__device__ __forceinline__ float bf_hi(unsigned w) { return __uint_as_float(w & 0xffff0000u); }
__device__ __forceinline__ float sigmoidf_(float x) { return __builtin_amdgcn_rcpf(1.0f + __expf(-x)); }
template <int CTRL> __device__ __forceinline__ float dppf(float v) { return __int_as_float(__builtin_amdgcn_update_dpp(0, __float_as_int(v), CTRL, 0xF, 0xF, true)); }
__device__ __forceinline__ float sum4(float v) { v += dppf<0xB1>(v); v += dppf<0x4E>(v); return v; }
__device__ __forceinline__ float sum8(float v) { v = sum4(v); v += dppf<0x141>(v); return v; }
__device__ __forceinline__ float sum16(float v) { v = sum4(v); v += dppf<0x124>(v); v += dppf<0x128>(v); return v; }
__device__ __forceinline__ float max16(float v) { v = fmaxf(v, dppf<0xB1>(v)); v = fmaxf(v, dppf<0x4E>(v)); v = fmaxf(v, dppf<0x124>(v)); v = fmaxf(v, dppf<0x128>(v)); return v; }
__device__ __forceinline__ float wave_sum(float v) {
    v = sum16(v);
    { auto r = __builtin_amdgcn_permlane16_swap(__float_as_uint(v), __float_as_uint(v), false, false); v = __uint_as_float(r[0]) + __uint_as_float(r[1]); }
    { auto r = __builtin_amdgcn_permlane32_swap(__float_as_uint(v), __float_as_uint(v), false, false); v = __uint_as_float(r[0]) + __uint_as_float(r[1]); }
    return v;
}

namespace pg8 {
constexpr int BM = 256, BK = 64, HALF = 128, HTB = HALF * BK * 2, STAGE_BYTES = 8 * HTB, NXCD = 8;
__host__ __device__ __forceinline__ int lds_byte(int r, int c) { const int st = (r >> 4) * 2 + (c >> 5), rr = r & 15, cc = c & 31, ob = rr * 64 + cc * 2; return st * 1024 + (ob ^ (((ob >> 9) & 1) << 5)); }
__host__ __device__ __forceinline__ void stage_rc(int b, int& R, int& C) { const int st = b / 1024, sb = b % 1024, swz = sb ^ (((sb >> 9) & 1) << 5); R = (st >> 1) * 16 + swz / 64; C = (st & 1) * 32 + (swz % 64) / 2; }
__host__ __device__ __forceinline__ int perm32(int rho) { const int n = rho >> 4, i = rho & 15; return 8 * (i >> 2) + 4 * n + (i & 3); }

struct Unit { const char* a; const char* b; int pm, pn; };
struct Gemm { int lda, ldb, K; };

struct TileOrder {
    const char* A; const char* B; size_t ta, tb; int nM, nN, nwg, G, c, wgm;
    __device__ void init(const void* A_, int lda, const void* B_, int ldb, int M, int N, int G_, int c_, int WGM = 4) { A = (const char*)A_; B = (const char*)B_; ta = (size_t)BM * lda * 2; tb = (size_t)BM * ldb * 2; nM = M / BM; nN = N / BM; nwg = nM * nN; G = G_; c = c_; wgm = WGM; }
    __device__ bool next(int i, Unit& u) const {
        const long L = (long)i * G + c; if (L >= nwg) return false;
        int wgid = (int)L; { const int q = nwg / NXCD, r = nwg % NXCD, xcd = wgid % NXCD, off = wgid / NXCD; wgid = (xcd < r ? xcd * (q + 1) : r * (q + 1) + (xcd - r) * q) + off; }
        const int nig = wgm * nN, gid = wgid / nig, fm = gid * wgm, gsz = (nM - fm) < wgm ? (nM - fm) : wgm;
        u.pm = fm + ((wgid % nig) % gsz); u.pn = (wgid % nig) / gsz; u.a = A + (size_t)u.pm * ta; u.b = B + (size_t)u.pn * tb; return true;
    }
};

template <class Epi, class Sched>
__device__ __forceinline__ void gemm_phase(LAS unsigned char* lds, const Gemm g, const Sched& S, const Epi& E) {
    int tid_ = threadIdx.x; asm volatile("" : "+v"(tid_));
    const int tid = tid_, wid = __builtin_amdgcn_readfirstlane(tid >> 6), lane = tid & 63, wr = wid >> 2, wc = wid & 3, fr = lane & 15, fq = lane >> 4;
    int K_ = g.K; asm volatile("" : "+s"(K_));
    const int K = K_, nt = K / BK;
    unsigned voffA[2], voffB[2];
#pragma unroll
    for (int i = 0; i < 2; ++i) { int R, C; stage_rc(tid * 16 + i * 8192, R, C); const int Rb = Epi::PERM ? ((R & ~31) + perm32(R & 31)) : R;
        voffA[i] = (unsigned)(R * g.lda + C) * 2u; voffB[i] = (unsigned)(Rb * g.ldb + C) * 2u; }
    const size_t kstep = (size_t)(BK * 2);
    const size_t hsA = (size_t)HALF * g.lda * 2, hsB = (size_t)HALF * g.ldb * 2;
    const unsigned ldsw = (unsigned)wid * 1024u;
    const int aoff = lds_byte(wr * 64 + fr, fq * 8), boff = lds_byte(wc * 32 + fr, fq * 8);
#define PG8_SA(b, h) (((b) * 2 + (h)) * HTB)
#define PG8_SB(b, h) ((4 + (b) * 2 + (h)) * HTB)
#define PG8_STAGE(bufoff, gbase, voff) do { _Pragma("unroll") for (int _i = 0; _i < 2; ++_i) \
        __builtin_amdgcn_global_load_lds((const unsigned*)((const char*)(gbase) + (voff)[_i]), (LAS unsigned*)(lds + (bufoff) + ldsw + _i * 8192), 16, 0, 0); } while (0)
#define PG8_LDA(dst, b, h) do { _Pragma("unroll") for (int m = 0; m < 4; ++m) _Pragma("unroll") for (int k = 0; k < 2; ++k) dst[m][k] = *(const LAS bf16x8*)(lds + PG8_SA(b, h) + aoff + m * 2048 + k * 1024); } while (0)
#define PG8_LDB(dst, b, h) do { _Pragma("unroll") for (int n = 0; n < 2; ++n) _Pragma("unroll") for (int k = 0; k < 2; ++k) dst[n][k] = *(const LAS bf16x8*)(lds + PG8_SB(b, h) + boff + n * 2048 + k * 1024); } while (0)
#define PG8_MMA(ai, bj, At, Bt) do { __builtin_amdgcn_s_setprio(1); _Pragma("unroll") for (int m = 0; m < 4; ++m) _Pragma("unroll") for (int n = 0; n < 2; ++n) _Pragma("unroll") for (int k = 0; k < 2; ++k) \
        acc[ai][bj][m][n] = __builtin_amdgcn_mfma_f32_16x16x32_bf16(Bt[n][k], At[m][k], acc[ai][bj][m][n], 0, 0, 0); __builtin_amdgcn_s_setprio(0); } while (0)
#define PG8_WAIT_V(n) asm volatile("s_waitcnt vmcnt(" #n ")" ::: "memory")
#define PG8_WAIT_L(n) asm volatile("s_waitcnt lgkmcnt(" #n ")" ::: "memory")
#define PG8_BAR __builtin_amdgcn_s_barrier()
#define PG8_SCHED __builtin_amdgcn_sched_barrier(0)
    Unit cur, nxt; int ui = 0;
    if (!S.next(0, cur)) return;
    f32x4 acc[2][2][4][2];
#pragma unroll
    for (int a = 0; a < 2; ++a)
#pragma unroll
        for (int b = 0; b < 2; ++b)
#pragma unroll
            for (int m = 0; m < 4; ++m)
#pragma unroll
                for (int n = 0; n < 2; ++n) acc[a][b][m][n] = (f32x4){0.f, 0.f, 0.f, 0.f};
    bf16x8 At[4][2], B0[2][2], B1[2][2];
    const char* cA = cur.a; const char* cB = cur.b;
    PG8_STAGE(PG8_SB(0, 0), cB, voffB); PG8_STAGE(PG8_SB(0, 1), cB + hsB, voffB); PG8_STAGE(PG8_SA(0, 0), cA, voffA); PG8_STAGE(PG8_SA(0, 1), cA + hsA, voffA);
    if (wr == 1) PG8_BAR;
    PG8_WAIT_V(2); PG8_BAR;
    PG8_STAGE(PG8_SB(1, 0), cB + kstep, voffB); PG8_STAGE(PG8_SA(1, 0), cA + kstep, voffA); PG8_STAGE(PG8_SB(1, 1), cB + hsB + kstep, voffB);
    PG8_WAIT_V(6); PG8_BAR;
    for (;;) {
        const bool has_next = S.next(ui + 1, nxt);
        const char* nA = has_next ? nxt.a : cA; const char* nB = has_next ? nxt.b : cB;
        for (int t = 0; t < nt; t += 2) {
            const bool last = (t == nt - 2);
            const char* a1 = cA + (size_t)(t + 1) * kstep;
            const char* a2 = last ? nA : cA + (size_t)(t + 2) * kstep; const char* b2 = last ? nB : cB + (size_t)(t + 2) * kstep;
            const char* a3 = a2 + kstep; const char* b3 = b2 + kstep;
            PG8_LDB(B0, 0, 0); PG8_LDB(B1, 0, 1); PG8_SCHED; PG8_LDA(At, 0, 0); PG8_STAGE(PG8_SA(1, 1), a1 + hsA, voffA);
            PG8_WAIT_V(8); PG8_WAIT_L(0); PG8_BAR; PG8_MMA(0, 0, At, B0); PG8_MMA(0, 1, At, B1); PG8_BAR; PG8_SCHED;
            PG8_LDA(At, 0, 1); PG8_STAGE(PG8_SB(0, 0), b2, voffB); PG8_STAGE(PG8_SB(0, 1), b2 + hsB, voffB); PG8_STAGE(PG8_SA(0, 0), a2, voffA);
            PG8_WAIT_V(8); PG8_WAIT_L(0); PG8_BAR; PG8_MMA(1, 0, At, B0); PG8_MMA(1, 1, At, B1); PG8_BAR; PG8_SCHED;
            PG8_LDB(B0, 1, 0); PG8_LDB(B1, 1, 1); PG8_SCHED; PG8_LDA(At, 1, 0); PG8_STAGE(PG8_SA(0, 1), a2 + hsA, voffA);
            PG8_WAIT_V(8); PG8_WAIT_L(0); PG8_BAR; PG8_MMA(0, 0, At, B0); PG8_MMA(0, 1, At, B1); PG8_BAR; PG8_SCHED;
            PG8_LDA(At, 1, 1); PG8_STAGE(PG8_SB(1, 0), b3, voffB); PG8_STAGE(PG8_SB(1, 1), b3 + hsB, voffB); PG8_STAGE(PG8_SA(1, 0), a3, voffA);
            PG8_WAIT_V(8); PG8_WAIT_L(0); PG8_BAR; PG8_MMA(1, 0, At, B0); PG8_MMA(1, 1, At, B1); PG8_BAR; PG8_SCHED;
        }
        if (wr == 0) PG8_BAR;
        E(acc, cur, wr, wc, fr, fq);
        if (!has_next) break;
#pragma unroll
        for (int a = 0; a < 2; ++a)
#pragma unroll
            for (int b = 0; b < 2; ++b)
#pragma unroll
                for (int m = 0; m < 4; ++m)
#pragma unroll
                    for (int n = 0; n < 2; ++n) acc[a][b][m][n] = (f32x4){0.f, 0.f, 0.f, 0.f};
        cur = nxt; cA = nA; cB = nB; ++ui;
        if (wr == 1) PG8_BAR;
    }
    PG8_WAIT_V(0);
    PG8_BAR;
#undef PG8_SA
#undef PG8_SB
#undef PG8_STAGE
#undef PG8_LDA
#undef PG8_LDB
#undef PG8_MMA
#undef PG8_WAIT_V
#undef PG8_WAIT_L
#undef PG8_BAR
#undef PG8_SCHED
}
}
__device__ __forceinline__ float gelu_tanh(float x) {
    const float y2 = 1.5957691216057308f * (x + 0.044715f * x * x * x);
    return x * sigmoidf_(y2);
}
namespace pg8 {
__device__ __forceinline__ u32x4 pack8(const f32x4 v0, const f32x4 v1) { u32x4 w; w.x = cvt_pk_bf16(v0[0], v0[1]); w.y = cvt_pk_bf16(v0[2], v0[3]); w.z = cvt_pk_bf16(v1[0], v1[1]); w.w = cvt_pk_bf16(v1[2], v1[3]); return w; }
__device__ __forceinline__ u32x2 pack4(const f32x4 v) { u32x2 w; w.x = cvt_pk_bf16(v[0], v[1]); w.y = cvt_pk_bf16(v[2], v[3]); return w; }

template <int ACT> struct EpiBf16 {
    static constexpr bool PERM = true;
    bf16_t* O; int ldc; float scale;
    __device__ __forceinline__ void operator()(const f32x4 (&acc)[2][2][4][2], const Unit& u, int wr, int wc, int fr, int fq) const {
        const int row0 = u.pm * BM + wr * 64 + fr, col0 = u.pn * BM + wc * 32 + 8 * fq;
#pragma unroll
        for (int ai = 0; ai < 2; ++ai)
#pragma unroll
            for (int m = 0; m < 4; ++m) { bf16_t* rowp = O + (size_t)(row0 + ai * HALF + m * 16) * ldc + col0;
#pragma unroll
                for (int bj = 0; bj < 2; ++bj) { f32x4 v0 = acc[ai][bj][m][0], v1 = acc[ai][bj][m][1];
                    if (ACT == 2) {
#pragma unroll
                        for (int e = 0; e < 4; ++e) { const float a = fmaxf(v0[e], 0.f), b = fmaxf(v1[e], 0.f); v0[e] = a * a; v1[e] = b * b; } }
                    v0 = v0 * scale; v1 = v1 * scale;
                    *(u32x4*)(rowp + bj * HALF) = pack8(v0, v1); } }
    }
};
struct EpiBf16Col {
    static constexpr bool PERM = true;
    bf16_t* O; int ldc; float scale; const float* cg;
    __device__ __forceinline__ void operator()(const f32x4 (&acc)[2][2][4][2], const Unit& u, int wr, int wc, int fr, int fq) const {
        const int row0 = u.pm * BM + wr * 64 + fr, col0 = u.pn * BM + wc * 32 + 8 * fq;
        f32x4 gv[2][2];
#pragma unroll
        for (int bj = 0; bj < 2; ++bj) { gv[bj][0] = *(const f32x4*)(cg + col0 + bj * HALF) * scale; gv[bj][1] = *(const f32x4*)(cg + col0 + bj * HALF + 4) * scale; }
#pragma unroll
        for (int ai = 0; ai < 2; ++ai)
#pragma unroll
            for (int m = 0; m < 4; ++m) { bf16_t* rowp = O + (size_t)(row0 + ai * HALF + m * 16) * ldc + col0;
#pragma unroll
                for (int bj = 0; bj < 2; ++bj) *(u32x4*)(rowp + bj * HALF) = pack8(acc[ai][bj][m][0] * gv[bj][0], acc[ai][bj][m][1] * gv[bj][1]); }
    }
};
template <int ACT> struct EpiBf16Rs {
    static constexpr bool PERM = true;
    bf16_t* O; int ldc; float scale; const float* SS; int grow0;
    __device__ __forceinline__ void operator()(const f32x4 (&acc)[2][2][4][2], const Unit& u, int wr, int wc, int fr, int fq) const {
        const int row0 = u.pm * BM + wr * 64 + fr, col0 = u.pn * BM + wc * 32 + 8 * fq;
        float ssv[2][4];
#pragma unroll
        for (int ai = 0; ai < 2; ++ai)
#pragma unroll
            for (int m = 0; m < 4; ++m) ssv[ai][m] = SS[grow0 + row0 + ai * HALF + m * 16];
#pragma unroll
        for (int ai = 0; ai < 2; ++ai)
#pragma unroll
            for (int m = 0; m < 4; ++m) { const int rl = row0 + ai * HALF + m * 16; bf16_t* rowp = O + (size_t)rl * ldc + col0;
                float r = 1.0f / sqrtf(ssv[ai][m] * (1.f / DM) + EPS); if (ACT == 2) r = r * r; r *= scale;
#pragma unroll
                for (int bj = 0; bj < 2; ++bj) { f32x4 v0 = acc[ai][bj][m][0], v1 = acc[ai][bj][m][1];
                    if (ACT == 2) {
#pragma unroll
                        for (int e = 0; e < 4; ++e) { const float a = fmaxf(v0[e], 0.f), b = fmaxf(v1[e], 0.f); v0[e] = a * a; v1[e] = b * b; } }
                    v0 = v0 * r; v1 = v1 * r;
                    *(u32x4*)(rowp + bj * HALF) = pack8(v0, v1); } }
    }
};
struct EpiF32 {
    static constexpr bool PERM = false;
    float* O; int ldc;
    __device__ __forceinline__ void operator()(const f32x4 (&acc)[2][2][4][2], const Unit& u, int wr, int wc, int fr, int fq) const {
        const int row0 = u.pm * BM + wr * 64 + fr, col0 = u.pn * BM + wc * 32 + 4 * fq;
#pragma unroll
        for (int ai = 0; ai < 2; ++ai)
#pragma unroll
            for (int m = 0; m < 4; ++m) { float* rowp = O + (size_t)(row0 + ai * HALF + m * 16) * ldc + col0;
#pragma unroll
                for (int bj = 0; bj < 2; ++bj)
#pragma unroll
                    for (int n = 0; n < 2; ++n) *(f32x4*)(rowp + bj * HALF + n * 16) = acc[ai][bj][m][n]; }
    }
};
struct EpiF32Rs {
    static constexpr bool PERM = false;
    float* O; int ldc; const float* SS; int grow0;
    __device__ __forceinline__ void operator()(const f32x4 (&acc)[2][2][4][2], const Unit& u, int wr, int wc, int fr, int fq) const {
        const int row0 = u.pm * BM + wr * 64 + fr, col0 = u.pn * BM + wc * 32 + 4 * fq;
        float ssv[2][4];
#pragma unroll
        for (int ai = 0; ai < 2; ++ai)
#pragma unroll
            for (int m = 0; m < 4; ++m) ssv[ai][m] = SS[grow0 + row0 + ai * HALF + m * 16];
#pragma unroll
        for (int ai = 0; ai < 2; ++ai)
#pragma unroll
            for (int m = 0; m < 4; ++m) { const int rl = row0 + ai * HALF + m * 16; float* rowp = O + (size_t)rl * ldc + col0; const float r = 1.0f / sqrtf(ssv[ai][m] * (1.f / DM) + EPS);
#pragma unroll
                for (int bj = 0; bj < 2; ++bj)
#pragma unroll
                    for (int n = 0; n < 2; ++n) *(f32x4*)(rowp + bj * HALF + n * 16) = acc[ai][bj][m][n] * r; }
    }
};
struct EpiResid {
    static constexpr bool PERM = false;
    const float* xp; const float* xs; float* out; int grow0; int from_x;
    __device__ __forceinline__ void operator()(const f32x4 (&acc)[2][2][4][2], const Unit& u, int wr, int wc, int fr, int fq) const {
        const int row0 = grow0 + u.pm * BM + wr * 64 + fr, col0 = u.pn * BM + wc * 32 + 4 * fq;
#pragma unroll
        for (int ai = 0; ai < 2; ++ai)
#pragma unroll
            for (int m = 0; m < 4; ++m) { const int gr = row0 + ai * HALF + m * 16;
                float* op = out + (size_t)gr * DM + col0;
                const float* bp = from_x ? (gr < NPROMPT ? xp + (size_t)gr * DM : xs + (size_t)(gr - NPROMPT) * DM) + col0 : op;
#pragma unroll
                for (int bj = 0; bj < 2; ++bj)
#pragma unroll
                    for (int n = 0; n < 2; ++n) { const f32x4 b = *(const f32x4*)(bp + bj * HALF + n * 16); *(f32x4*)(op + bj * HALF + n * 16) = b + acc[ai][bj][m][n]; } }
    }
};
constexpr int XRS = 2 * DM;
__device__ __forceinline__ f32x4 unpack4(const u32x2 w) { f32x4 v; v[0] = bf_lo(w.x); v[1] = bf_hi(w.x); v[2] = bf_lo(w.y); v[3] = bf_hi(w.y); return v; }
struct EpiResidSS {
    static constexpr bool PERM = false;
    bf16_t* xr; int grow0; float* SSo; bf16_t* XN; const float* gain;
    __device__ __forceinline__ void operator()(const f32x4 (&acc)[2][2][4][2], const Unit& u, int wr, int wc, int fr, int fq) const {
        const int rowl0 = u.pm * BM + wr * 64 + fr, col0 = u.pn * BM + wc * 32 + 4 * fq;
        f32x4 gv[2][2];
        if (XN) {
#pragma unroll
            for (int bj = 0; bj < 2; ++bj)
#pragma unroll
                for (int n = 0; n < 2; ++n) gv[bj][n] = *(const f32x4*)(gain + col0 + bj * HALF + n * 16); }
        u32x2 bw[2][4][2][2];
#pragma unroll
        for (int ai = 0; ai < 2; ++ai)
#pragma unroll
            for (int m = 0; m < 4; ++m) { const bf16_t* bp = xr + (size_t)(grow0 + rowl0 + ai * HALF + m * 16) * XRS + col0;
#pragma unroll
                for (int bj = 0; bj < 2; ++bj)
#pragma unroll
                    for (int n = 0; n < 2; ++n) bw[ai][m][bj][n] = *(const u32x2*)(bp + bj * HALF + n * 16); }
#pragma unroll
        for (int ai = 0; ai < 2; ++ai) {
            f32x4 bv[4][2][2];
#pragma unroll
            for (int m = 0; m < 4; ++m)
#pragma unroll
                for (int bj = 0; bj < 2; ++bj)
#pragma unroll
                    for (int n = 0; n < 2; ++n) bv[m][bj][n] = unpack4(bw[ai][m][bj][n]);
#pragma unroll
            for (int m = 0; m < 4; ++m) { const int rl = rowl0 + ai * HALF + m * 16, gr = grow0 + rl;
                bf16_t* op = xr + (size_t)gr * XRS + col0;
                float ss = 0.f;
#pragma unroll
                for (int bj = 0; bj < 2; ++bj)
#pragma unroll
                    for (int n = 0; n < 2; ++n) { const f32x4 v = bv[m][bj][n] + acc[ai][bj][m][n]; *(u32x2*)(op + bj * HALF + n * 16) = pack4(v);
                        ss += (v[0] * v[0] + v[1] * v[1]) + (v[2] * v[2] + v[3] * v[3]);
                        if (XN) *(u32x2*)(XN + (size_t)rl * DM + col0 + bj * HALF + n * 16) = pack4(v * gv[bj][n]); }
                { auto r = __builtin_amdgcn_permlane16_swap(__float_as_uint(ss), __float_as_uint(ss), false, false); ss = __uint_as_float(r[0]) + __uint_as_float(r[1]); }
                { auto r = __builtin_amdgcn_permlane32_swap(__float_as_uint(ss), __float_as_uint(ss), false, false); ss = __uint_as_float(r[0]) + __uint_as_float(r[1]); }
                if (fq == 0) (void)__hip_atomic_fetch_add(SSo + gr, ss, __ATOMIC_RELAXED, __HIP_MEMORY_SCOPE_AGENT); } }
    }
};
struct EpiWin {
    static constexpr bool PERM = true;
    bf16_t* QKVU; bf16_t* GATES; const float* rope; int grow0; bf16_t* A3;
    __device__ __forceinline__ void operator()(const f32x4 (&acc)[2][2][4][2], const Unit& u, int wr, int wc, int fr, int fq) const {
        const int rowl0 = u.pm * BM + wr * 64 + fr, pn = u.pn;
        if (pn < 8) {
            const float sc = pn < 4 ? 0.125f * 1.4426950408889634f : 1.0f  ; const int g8 = 4 * (wc & 1) + fq;
#pragma unroll
            for (int ai = 0; ai < 2; ++ai) {
                f32x4 csv[4], snv[4];
#pragma unroll
                for (int m = 0; m < 4; ++m) { const int gr = grow0 + rowl0 + ai * HALF + m * 16, pos = gr < NPROMPT ? (gr & (LPR - 1)) : (gr & (LSA - 1));
                    csv[m] = *(const f32x4*)(rope + pos * 64 + 4 * g8); snv[m] = *(const f32x4*)(rope + pos * 64 + 32 + 4 * g8); }
#pragma unroll
                for (int m = 0; m < 4; ++m) { const int rl = rowl0 + ai * HALF + m * 16;
                    const f32x4 cs = csv[m] * sc, sn = snv[m] * sc;
#pragma unroll
                    for (int bj = 0; bj < 2; ++bj) { const f32x4 v0 = acc[ai][bj][m][0], v1 = acc[ai][bj][m][1];
                        const f32x4 o1 = v0 * cs - v1 * sn, o2 = v1 * cs + v0 * sn;
                        bf16_t* p = QKVU + (size_t)rl * 4096 + (4 * pn + 2 * bj + (wc >> 1)) * 64 + 4 * g8;
                        *(u32x2*)p = pack4(o1); *(u32x2*)(p + 32) = pack4(o2); } } }
        } else if (pn >= 12 && pn < 16) {
            const int ucol = (pn - 12) * BM + wc * 32 + 8 * fq;
#pragma unroll
            for (int ai = 0; ai < 2; ++ai)
#pragma unroll
                for (int m = 0; m < 4; ++m) { const int rl = rowl0 + ai * HALF + m * 16;
#pragma unroll
                    for (int bj = 0; bj < 2; ++bj) { const int uc = ucol + bj * HALF;
                        *(u32x4*)(A3 + ((size_t)((uc >> 4) * 512 + (rl >> 5)) * 768 + (rl & 31) * 16 + (uc & 15))) = pack8(acc[ai][bj][m][0], acc[ai][bj][m][1]); } }
        } else if (pn < 12) {
            const int col0 = pn * BM + wc * 32 + 8 * fq;
#pragma unroll
            for (int ai = 0; ai < 2; ++ai)
#pragma unroll
                for (int m = 0; m < 4; ++m) { bf16_t* rowp = QKVU + (size_t)(rowl0 + ai * HALF + m * 16) * 4096 + col0;
#pragma unroll
                    for (int bj = 0; bj < 2; ++bj) *(u32x4*)(rowp + bj * HALF) = pack8(acc[ai][bj][m][0], acc[ai][bj][m][1]); }
        } else {
            const int col0 = (pn - 16) * BM + wc * 32 + 8 * fq;
#pragma unroll
            for (int ai = 0; ai < 2; ++ai)
#pragma unroll
                for (int m = 0; m < 4; ++m) { bf16_t* rowp = GATES + (size_t)(rowl0 + ai * HALF + m * 16) * 4096 + col0;
#pragma unroll
                    for (int bj = 0; bj < 2; ++bj) { f32x4 v0 = acc[ai][bj][m][0], v1 = acc[ai][bj][m][1];
#pragma unroll
                        for (int e = 0; e < 4; ++e) { v0[e] = sigmoidf_(v0[e]); v1[e] = sigmoidf_(v1[e]); }
                        *(u32x4*)(rowp + bj * HALF) = pack8(v0, v1); } }
        }
    }
};
struct EpiAttnProj {
    static constexpr bool PERM = true;
    const bf16_t* GATES; bf16_t* MIX;
    __device__ __forceinline__ void operator()(const f32x4 (&acc)[2][2][4][2], const Unit& u, int wr, int wc, int fr, int fq) const {
        const int row0 = u.pm * BM + wr * 64 + fr, col0 = u.pn * BM + wc * 32 + 8 * fq;
        u32x4 gwv[2][4][2];
#pragma unroll
        for (int ai = 0; ai < 2; ++ai)
#pragma unroll
            for (int m = 0; m < 4; ++m)
#pragma unroll
                for (int bj = 0; bj < 2; ++bj) gwv[ai][m][bj] = *(const u32x4*)(GATES + (size_t)(row0 + ai * HALF + m * 16) * 4096 + col0 + bj * HALF);
#pragma unroll
        for (int ai = 0; ai < 2; ++ai) {
#pragma unroll
            for (int m = 0; m < 4; ++m) { const int r = row0 + ai * HALF + m * 16;
#pragma unroll
                for (int bj = 0; bj < 2; ++bj) { const u32x4 gw = gwv[ai][m][bj];
                    f32x4 v0 = acc[ai][bj][m][0], v1 = acc[ai][bj][m][1];
                    v0[0] *= bf_lo(gw.x); v0[1] *= bf_hi(gw.x); v0[2] *= bf_lo(gw.y); v0[3] *= bf_hi(gw.y);
                    v1[0] *= bf_lo(gw.z); v1[1] *= bf_hi(gw.z); v1[2] *= bf_lo(gw.w); v1[3] *= bf_hi(gw.w);
                    *(u32x4*)(MIX + (size_t)r * DM + col0 + bj * HALF) = pack8(v0, v1); } } }
    }
};
struct EpiGlu {
    static constexpr bool PERM = true;
    const bf16_t* GATES; bf16_t* MIX;
    __device__ __forceinline__ void operator()(const f32x4 (&acc)[2][2][4][2], const Unit& u, int wr, int wc, int fr, int fq) const {
        const int row0 = u.pm * BM + wr * 64 + fr, j0 = u.pn * 128 + wc * 16 + 4 * fq;
        u32x2 gwv[2][4][2], mwv[2][4][2];
#pragma unroll
        for (int ai = 0; ai < 2; ++ai)
#pragma unroll
            for (int m = 0; m < 4; ++m)
#pragma unroll
                for (int bj = 0; bj < 2; ++bj) { const int r = row0 + ai * HALF + m * 16, j = j0 + bj * 64;
                    gwv[ai][m][bj] = *(const u32x2*)(GATES + (size_t)r * 4096 + DM + j); mwv[ai][m][bj] = *(const u32x2*)(MIX + (size_t)r * DM + j); }
#pragma unroll
        for (int ai = 0; ai < 2; ++ai) {
#pragma unroll
            for (int m = 0; m < 4; ++m) { const int r = row0 + ai * HALF + m * 16;
#pragma unroll
                for (int bj = 0; bj < 2; ++bj) { const int j = j0 + bj * 64;
                    const u32x2 gw = gwv[ai][m][bj]; bf16_t* mp = MIX + (size_t)r * DM + j; const u32x2 mw = mwv[ai][m][bj];
                    const f32x4 a = acc[ai][bj][m][0], b = acc[ai][bj][m][1]; f32x4 o;
                    o[0] = a[0] * sigmoidf_(b[0]) * bf_lo(gw.x) + bf_lo(mw.x); o[1] = a[1] * sigmoidf_(b[1]) * bf_hi(gw.x) + bf_hi(mw.x);
                    o[2] = a[2] * sigmoidf_(b[2]) * bf_lo(gw.y) + bf_lo(mw.y); o[3] = a[3] * sigmoidf_(b[3]) * bf_hi(gw.y) + bf_hi(mw.y);
                    *(u32x2*)mp = pack4(o); } } }
    }
};
struct EpiSsmOut {
    static constexpr bool PERM = true;
    bf16_t* Z;
    __device__ __forceinline__ void operator()(const f32x4 (&acc)[2][2][4][2], const Unit& u, int wr, int wc, int fr, int fq) const {
        const int row0 = u.pm * BM + wr * 64 + fr, n00 = u.pn * BM + wc * 32 + 8 * fq;
#pragma unroll
        for (int ai = 0; ai < 2; ++ai)
#pragma unroll
            for (int m = 0; m < 4; ++m) { const int row = row0 + ai * HALF + m * 16, g = row >> 9, chunk = row & 511;
#pragma unroll
                for (int bj = 0; bj < 2; ++bj) { const int n0 = n00 + bj * HALF, j = n0 >> 4, ch0 = n0 & 15;
                    f32x4 v0 = acc[ai][bj][m][0], v1 = acc[ai][bj][m][1];
#pragma unroll
                    for (int e = 0; e < 4; ++e) { v0[e] = gelu_tanh(v0[e]); v1[e] = gelu_tanh(v1[e]); }
                    *(u32x4*)(Z + ((size_t)(chunk * 32 + j) * 1024 + g * 16 + ch0)) = pack8(v0, v1); } }
    }
};
}
namespace attn3 {
constexpr int KVBLK = 64, LDQ = 4096, LDK = 4096, TILE_B = 64 * 128 * 2;
constexpr float THR = 8.f;
typedef short v4i16_t __attribute__((ext_vector_type(4)));
#define SBAR() __builtin_amdgcn_sched_barrier(0)
__device__ __forceinline__ s16x4 vtr(const LAS char* p) { return __builtin_bit_cast(s16x4, __builtin_amdgcn_ds_read_tr16_b64_v4i16((LAS v4i16_t*)p)); }
__device__ __forceinline__ int offK(int row, int ch16) { return 256 * row + 16 * (ch16 ^ (row & 15)); }
__device__ __forceinline__ int offV(int row, int ch16) { return 256 * row + 32 * ((ch16 >> 1) ^ (row & 7)) + 16 * (ch16 & 1); }
__device__ __forceinline__ float xmax4(float v) {
    { auto r = __builtin_amdgcn_permlane16_swap(__float_as_uint(v), __float_as_uint(v), false, false); v = fmaxf(__uint_as_float(r[0]), __uint_as_float(r[1])); }
    { auto r = __builtin_amdgcn_permlane32_swap(__float_as_uint(v), __float_as_uint(v), false, false); v = fmaxf(__uint_as_float(r[0]), __uint_as_float(r[1])); }
    return v; }
__device__ __forceinline__ int xmaxi4(int v) {
    { auto r = __builtin_amdgcn_permlane16_swap((unsigned)v, (unsigned)v, false, false); v = max((int)r[0], (int)r[1]); }
    { auto r = __builtin_amdgcn_permlane32_swap((unsigned)v, (unsigned)v, false, false); v = max((int)r[0], (int)r[1]); }
    return v; }
__device__ __forceinline__ float xsum4(float v) {
    { auto r = __builtin_amdgcn_permlane16_swap(__float_as_uint(v), __float_as_uint(v), false, false); v = __uint_as_float(r[0]) + __uint_as_float(r[1]); }
    { auto r = __builtin_amdgcn_permlane32_swap(__float_as_uint(v), __float_as_uint(v), false, false); v = __uint_as_float(r[0]) + __uint_as_float(r[1]); }
    return v; }

__device__ __forceinline__ void attn_unit3(const bf16_t* __restrict__ Qb, const bf16_t* __restrict__ Kh, const bf16_t* __restrict__ Vh, bf16_t* __restrict__ An, const float* __restrict__ subln, float lam, int seq, LAS char* lds) {
  int tid_ = threadIdx.x; asm volatile("" : "+v"(tid_));
  const int tid = tid_, wid = __builtin_amdgcn_readfirstlane(tid >> 6), lane = tid & 63, i16 = lane & 15, g = lane >> 4, half = wid >> 2;
  LAS char* V_lds = lds; LAS char* K_lds = lds + 2 * TILE_B;
  LAS float* ws = (LAS float*)(lds + 4 * TILE_B) + wid * 64;
  bf16x8 qf[2][2];
  { const bf16_t* Qw = Qb + (long)(wid * 16 + i16) * LDQ + 8 * g;
#pragma unroll
    for (int m = 0; m < 2; ++m)
#pragma unroll
      for (int ks = 0; ks < 2; ++ks) qf[m][ks] = *reinterpret_cast<const bf16x8*>(Qw + 64 * m + 32 * ks); }
  f32x4 o[2][8];
#pragma unroll
  for (int m = 0; m < 2; ++m)
#pragma unroll
    for (int cb = 0; cb < 8; ++cb) o[m][cb] = (f32x4){0.f, 0.f, 0.f, 0.f};
  float l_reg[2] = {0.f, 0.f}, negm[2] = {0.f, 0.f};
  const int sr = tid >> 4, sc16 = tid & 15;
  const int kst0 = offK(sr, sc16), kst1 = offK(32 + sr, sc16), vst0 = offV(sr, sc16), vst1 = offV(32 + sr, sc16);
  const int tq = i16 >> 2, tp = i16 & 3;
  const int NT = seq / KVBLK;
  bf16x8 gk0, gk1, gv0, gv1;
#define LOADK(t) do { gk0 = *reinterpret_cast<const bf16x8*>(&Kh[(long)((t) * KVBLK + sr) * LDK + sc16 * 8]); gk1 = *reinterpret_cast<const bf16x8*>(&Kh[(long)((t) * KVBLK + 32 + sr) * LDK + sc16 * 8]); } while (0)
#define LOADV(t) do { gv0 = *reinterpret_cast<const bf16x8*>(&Vh[(long)((t) * KVBLK + sr) * LDK + sc16 * 8]); gv1 = *reinterpret_cast<const bf16x8*>(&Vh[(long)((t) * KVBLK + 32 + sr) * LDK + sc16 * 8]); } while (0)
#define WRITEK(t) do { LAS char* kb_ = K_lds + ((t) & 1) * TILE_B; *(LAS bf16x8*)(kb_ + kst0) = gk0; *(LAS bf16x8*)(kb_ + kst1) = gk1; } while (0)
#define WRITEV(t) do { LAS char* vb_ = V_lds + ((t) & 1) * TILE_B; *(LAS bf16x8*)(vb_ + vst0) = gv0; *(LAS bf16x8*)(vb_ + vst1) = gv1; } while (0)
  f32x4 s[2][4]; bf16x8 pa[2][2];
#define KRD(KF, kbase, kb0) do { _Pragma("unroll") for (int b = 0; b < 2; ++b) _Pragma("unroll") for (int m = 0; m < 2; ++m) _Pragma("unroll") for (int ks = 0; ks < 2; ++ks) \
      KF[b][m][ks] = *(const LAS bf16x8*)((kbase) + offK(16 * ((kb0) + b) + i16, 8 * m + 4 * ks + g)); } while (0)
#define QKM(KF, kb0) do { _Pragma("unroll") for (int b = 0; b < 2; ++b) _Pragma("unroll") for (int m = 0; m < 2; ++m) { \
      f32x4 c_ = (f32x4){negm[m], negm[m], negm[m], negm[m]}; \
      c_ = __builtin_amdgcn_mfma_f32_16x16x32_bf16(KF[b][m][0], qf[m][0], c_, 0, 0, 0); \
      s[m][(kb0) + b] = __builtin_amdgcn_mfma_f32_16x16x32_bf16(KF[b][m][1], qf[m][1], c_, 0, 0, 0); } } while (0)
#define VRD(VF, vbase, t) do { _Pragma("unroll") for (int cb = 0; cb < 8; ++cb) { \
      const int r0_ = 32 * (t) + 4 * g + tq, r1_ = r0_ + 16; \
      VF[cb][0] = vtr((vbase) + 256 * r0_ + 32 * (cb ^ (r0_ & 7)) + 8 * tp); VF[cb][1] = vtr((vbase) + 256 * r1_ + 32 * (cb ^ (r1_ & 7)) + 8 * tp); } } while (0)
#define PVB(VF, t) do { _Pragma("unroll") for (int cb = 0; cb < 8; ++cb) { const bf16x8 vf_ = (bf16x8){VF[cb][0][0], VF[cb][0][1], VF[cb][0][2], VF[cb][0][3], VF[cb][1][0], VF[cb][1][1], VF[cb][1][2], VF[cb][1][3]}; \
      o[0][cb] = __builtin_amdgcn_mfma_f32_16x16x32_bf16(pa[0][t], vf_, o[0][cb], 0, 0, 0); \
      o[1][cb] = __builtin_amdgcn_mfma_f32_16x16x32_bf16(pa[1][t], vf_, o[1][cb], 0, 0, 0); } } while (0)
#define MSEG(tqi, tv, DO_QK) do { const LAS char* vbp_ = V_lds + ((tv) & 1) * TILE_B; const LAS char* kbp_ = K_lds + ((tqi) & 1) * TILE_B; \
    s16x4 va[8][2], vb[8][2]; bf16x8 ka[2][2][2], kc[2][2][2]; \
    VRD(va, vbp_, 0); SBAR(); \
    VRD(vb, vbp_, 1); PVB(va, 0); SBAR(); \
    if (DO_QK) KRD(ka, kbp_, 0); PVB(vb, 1); SBAR(); \
    if (DO_QK) { KRD(kc, kbp_, 2); QKM(ka, 0); SBAR(); QKM(kc, 2); } } while (0)
#define SMSEG(FIRST) do { \
    _Pragma("unroll") for (int m = 0; m < 2; ++m) { asm volatile("" : "+v"(s[m][0]), "+v"(s[m][1]), "+v"(s[m][2]), "+v"(s[m][3])); \
      bool resc_; float dl; \
      if (FIRST) { float mx = fmaxf(fmaxf(s[m][0][0], s[m][0][1]), fmaxf(s[m][0][2], s[m][0][3])); \
        _Pragma("unroll") for (int kb = 1; kb < 4; ++kb) mx = fmaxf(mx, fmaxf(fmaxf(s[m][kb][0], s[m][kb][1]), fmaxf(s[m][kb][2], s[m][kb][3]))); \
        dl = xmax4(mx); resc_ = true; \
      } else {       \
        int im = max(max(__float_as_int(s[m][0][0]), __float_as_int(s[m][0][1])), max(__float_as_int(s[m][0][2]), __float_as_int(s[m][0][3]))); \
        _Pragma("unroll") for (int kb = 1; kb < 4; ++kb) im = max(im, max(max(__float_as_int(s[m][kb][0]), __float_as_int(s[m][kb][1])), max(__float_as_int(s[m][kb][2]), __float_as_int(s[m][kb][3])))); \
        im = xmaxi4(im); resc_ = __builtin_expect(__any(im > 0x41000000  ), 0); dl = __int_as_float(max(im, 0)); } \
      if (resc_) { \
        _Pragma("unroll") for (int kb = 0; kb < 4; ++kb) s[m][kb] = s[m][kb] - dl; \
        negm[m] -= dl; \
        if (!(FIRST)) { const float al = __builtin_amdgcn_exp2f(-dl); l_reg[m] *= al; if (g == 0) ws[16 * m + i16] = al; \
          const f32x4 a4 = *(const LAS f32x4*)(ws + 16 * m + 4 * g); \
          _Pragma("unroll") for (int cb = 0; cb < 8; ++cb) o[m][cb] = o[m][cb] * a4; } } \
      f32x4 e4_ = {0.f, 0.f, 0.f, 0.f}; \
      _Pragma("unroll") for (int kb = 0; kb < 4; ++kb) { _Pragma("unroll") for (int r = 0; r < 4; ++r) s[m][kb][r] = __builtin_amdgcn_exp2f(s[m][kb][r]); e4_ += s[m][kb]; }        \
      const float ps = (e4_[0] + e4_[1]) + (e4_[2] + e4_[3]); \
      l_reg[m] += xsum4(ps); \
      _Pragma("unroll") for (int t = 0; t < 2; ++t) { u32x4 w_; w_.x = cvt_pk_bf16(s[m][2 * t][0], s[m][2 * t][1]); w_.y = cvt_pk_bf16(s[m][2 * t][2], s[m][2 * t][3]); \
        w_.z = cvt_pk_bf16(s[m][2 * t + 1][0], s[m][2 * t + 1][1]); w_.w = cvt_pk_bf16(s[m][2 * t + 1][2], s[m][2 * t + 1][3]); pa[m][t] = __builtin_bit_cast(bf16x8, w_); } } } while (0)
#define BAR() __syncthreads()
  LOADK(0); LOADV(0); WRITEK(0); WRITEV(0); LOADK(1); WRITEK(1);
  if (2 < NT) LOADK(2); LOADV(1);
  BAR();
  { bf16x8 ka[2][2][2], kc[2][2][2]; KRD(ka, K_lds, 0); KRD(kc, K_lds, 2); QKM(ka, 0); QKM(kc, 2); } SMSEG(true);
  BAR();
  if (half == 0) {
    for (int n = 0; n + 1 < NT; ++n) {
      SBAR(); MSEG(n + 1, n, true); SBAR(); BAR();
      SMSEG(false); if (n + 2 < NT) WRITEK(n + 2); WRITEV(n + 1); if (n + 3 < NT) LOADK(n + 3); if (n + 2 < NT) LOADV(n + 2); SBAR(); BAR();
    }
    MSEG(0, NT - 1, false); BAR(); BAR();
  } else {
    if (2 < NT) WRITEK(2); WRITEV(1); if (3 < NT) LOADK(3); if (2 < NT) LOADV(2); BAR();
    for (int n = 0; n + 1 < NT; ++n) {
      SBAR(); MSEG(n + 1, n, true); SBAR(); BAR();
      SMSEG(false); if (n + 3 < NT) WRITEK(n + 3); if (n + 2 < NT) WRITEV(n + 2); if (n + 4 < NT) LOADK(n + 4); if (n + 3 < NT) LOADV(n + 3); SBAR(); BAR();
    }
    MSEG(0, NT - 1, false); BAR();
  }
  if (g == 0) { ws[i16] = __builtin_amdgcn_rcpf(l_reg[0]); ws[16 + i16] = lam * __builtin_amdgcn_rcpf(l_reg[1]); }
  const f32x4 il0 = *(const LAS f32x4*)(ws + 4 * g), il1 = *(const LAS f32x4*)(ws + 16 + 4 * g);
  f32x4 ss = (f32x4){0.f, 0.f, 0.f, 0.f};
#pragma unroll
  for (int cb = 0; cb < 8; ++cb) { o[0][cb] = o[0][cb] * il0 - o[1][cb] * il1; ss = ss + o[0][cb] * o[0][cb]; }
  f32x4 rs;
#pragma unroll
  for (int r = 0; r < 4; ++r) rs[r] = 0.8f / sqrtf(sum16(ss[r]) * (1.f / 128.f) + EPS);
  bf16_t* Aw = An + (long)(wid * 16 + 4 * g) * 1024 + i16;
#pragma unroll
  for (int cb = 0; cb < 8; ++cb) { const float gn = subln[16 * cb + i16];
#pragma unroll
    for (int r = 0; r < 4; ++r) Aw[(long)r * 1024 + 16 * cb] = (bf16_t)(cvt_pk_bf16(o[0][cb][r] * rs[r] * gn, 0.f) & 0xffffu); }
  BAR();
#undef LOADK
#undef LOADV
#undef WRITEK
#undef WRITEV
#undef KRD
#undef QKM
#undef VRD
#undef PVB
#undef MSEG
#undef SMSEG
#undef BAR
}
#undef SBAR
}
__device__ __forceinline__ void dsincos(double x, double& s, double& c) {
    const double k = __builtin_rint(x * 0.15915494309189535);
    double r = __builtin_fma(-k, 6.283185307179586, x); r = __builtin_fma(-k, 2.4492935982947064e-16, r);
    const double r2 = r * r;
    double ps = 1.1309962886447718e-31;
    ps = ps * r2 - 9.183689863795546e-29;
    ps = ps * r2 + 6.446950284384474e-26;
    ps = ps * r2 - 3.8681701706306835e-23;
    ps = ps * r2 + 1.9572941063391263e-20;
    ps = ps * r2 - 8.22063524662433e-18;
    ps = ps * r2 + 2.8114572543455206e-15;
    ps = ps * r2 - 7.647163731819816e-13;
    ps = ps * r2 + 1.6059043836821613e-10;
    ps = ps * r2 - 2.505210838544172e-08;
    ps = ps * r2 + 2.7557319223985893e-06;
    ps = ps * r2 - 0.0001984126984126984;
    ps = ps * r2 + 0.008333333333333333;
    ps = ps * r2 - 0.16666666666666666;
    s = r + r * r2 * ps;
    double pc = -3.7699876288159054e-33;
    pc = pc * r2 + 3.279889237069838e-30;
    pc = pc * r2 - 2.4795962632247972e-27;
    pc = pc * r2 + 1.6117375710961184e-24;
    pc = pc * r2 - 8.896791392450574e-22;
    pc = pc * r2 + 4.110317623312165e-19;
    pc = pc * r2 - 1.5619206968586225e-16;
    pc = pc * r2 + 4.779477332387385e-14;
    pc = pc * r2 - 1.1470745597729725e-11;
    pc = pc * r2 + 2.08767569878681e-09;
    pc = pc * r2 - 2.755731922398589e-07;
    pc = pc * r2 + 2.48015873015873e-05;
    pc = pc * r2 - 0.001388888888888889;
    pc = pc * r2 + 0.041666666666666664;
    pc = pc * r2 - 0.5;
    c = 1.0 + r2 * pc;
}
__device__ __forceinline__ double dexp(double x) {
    const double k = __builtin_rint(x * 1.4426950408889634);
    double r = __builtin_fma(-k, 0.6931471805599453, x); r = __builtin_fma(-k, 2.3190468138462996e-17, r);
    double p = 1.6059043836821613e-10;
    p = p * r + 2.08767569878681e-09; p = p * r + 2.505210838544172e-08; p = p * r + 2.755731922398589e-07; p = p * r + 2.7557319223985893e-06; p = p * r + 2.48015873015873e-05;
    p = p * r + 0.0001984126984126984; p = p * r + 0.001388888888888889; p = p * r + 0.008333333333333333; p = p * r + 0.041666666666666664; p = p * r + 0.16666666666666666; p = p * r + 0.5; p = p * r + 1.0; p = p * r + 1.0;
    const long long bits = ((long long)k + 1023LL) << 52;
    return p * __builtin_bit_cast(double, bits);
}

__device__ __forceinline__ void rms_row_bf16(const float* xrow, const float* gain, bf16_t* orow, int lane) {
    const f32x4* xr = (const f32x4*)xrow + lane; const f32x4* gr = (const f32x4*)gain + lane;
    f32x4 v[8]; float s = 0.f;
#pragma unroll
    for (int j = 0; j < 8; ++j) { v[j] = xr[64 * j]; s += (v[j].x * v[j].x + v[j].y * v[j].y) + (v[j].z * v[j].z + v[j].w * v[j].w); }
    f32x4 gv[8];
#pragma unroll
    for (int j = 0; j < 8; ++j) gv[j] = gr[64 * j];
    const float rs = 1.0f / sqrtf(wave_sum(s) * (1.f / DM) + EPS);
    u32x2* o8 = (u32x2*)orow + lane;
#pragma unroll
    for (int j = 0; j < 8; ++j) { const f32x4 g = gv[j]; u32x2 w; w.x = cvt_pk_bf16(v[j].x * rs * g.x, v[j].y * rs * g.y); w.y = cvt_pk_bf16(v[j].z * rs * g.z, v[j].w * rs * g.w); o8[64 * j] = w; }
}
__device__ __forceinline__ void rms_row2_bf16(const float* xrow0, const float* xrow1, const float* gain, bf16_t* orow0, bf16_t* orow1, int lane) {
    const f32x4* xa = (const f32x4*)xrow0 + lane; const f32x4* xb = (const f32x4*)xrow1 + lane; const f32x4* gr = (const f32x4*)gain + lane;
    f32x4 va[8], vb[8]; float sa = 0.f, sb = 0.f;
#pragma unroll
    for (int j = 0; j < 8; ++j) { va[j] = xa[64 * j]; vb[j] = xb[64 * j]; }
    f32x4 gv[8];
#pragma unroll
    for (int j = 0; j < 8; ++j) gv[j] = gr[64 * j];
#pragma unroll
    for (int j = 0; j < 8; ++j) { sa += (va[j].x * va[j].x + va[j].y * va[j].y) + (va[j].z * va[j].z + va[j].w * va[j].w); sb += (vb[j].x * vb[j].x + vb[j].y * vb[j].y) + (vb[j].z * vb[j].z + vb[j].w * vb[j].w); }
    const float ra = 1.0f / sqrtf(wave_sum(sa) * (1.f / DM) + EPS), rb = 1.0f / sqrtf(wave_sum(sb) * (1.f / DM) + EPS);
    u32x2* oa = (u32x2*)orow0 + lane; u32x2* ob = (u32x2*)orow1 + lane;
#pragma unroll
    for (int j = 0; j < 8; ++j) { const f32x4 g = gv[j]; u32x2 w;
        w.x = cvt_pk_bf16(va[j].x * ra * g.x, va[j].y * ra * g.y); w.y = cvt_pk_bf16(va[j].z * ra * g.z, va[j].w * ra * g.w); oa[64 * j] = w;
        w.x = cvt_pk_bf16(vb[j].x * rb * g.x, vb[j].y * rb * g.y); w.y = cvt_pk_bf16(vb[j].z * rb * g.z, vb[j].w * rb * g.w); ob[64 * j] = w; }
}
__device__ __forceinline__ void rms_row2_bf16_xr(const float* xrow0, const float* xrow1, const float* gain, bf16_t* orow0, bf16_t* orow1, bf16_t* rrow0, bf16_t* rrow1, int lane) {
    const f32x4* xa = (const f32x4*)xrow0 + lane; const f32x4* xb = (const f32x4*)xrow1 + lane; const f32x4* gr = (const f32x4*)gain + lane;
    f32x4 va[8], vb[8]; float sa = 0.f, sb = 0.f;
#pragma unroll
    for (int j = 0; j < 8; ++j) { va[j] = xa[64 * j]; vb[j] = xb[64 * j]; }
    f32x4 gv[8];
#pragma unroll
    for (int j = 0; j < 8; ++j) gv[j] = gr[64 * j];
#pragma unroll
    for (int j = 0; j < 8; ++j) { sa += (va[j].x * va[j].x + va[j].y * va[j].y) + (va[j].z * va[j].z + va[j].w * va[j].w); sb += (vb[j].x * vb[j].x + vb[j].y * vb[j].y) + (vb[j].z * vb[j].z + vb[j].w * vb[j].w); }
    const float ra = 1.0f / sqrtf(wave_sum(sa) * (1.f / DM) + EPS), rb = 1.0f / sqrtf(wave_sum(sb) * (1.f / DM) + EPS);
    u32x2* oa = (u32x2*)orow0 + lane; u32x2* ob = (u32x2*)orow1 + lane; u32x2* qa = (u32x2*)rrow0 + lane; u32x2* qb = (u32x2*)rrow1 + lane;
#pragma unroll
    for (int j = 0; j < 8; ++j) { const f32x4 g = gv[j]; u32x2 w;
        w.x = cvt_pk_bf16(va[j].x * ra * g.x, va[j].y * ra * g.y); w.y = cvt_pk_bf16(va[j].z * ra * g.z, va[j].w * ra * g.w); oa[64 * j] = w;
        w.x = cvt_pk_bf16(vb[j].x * rb * g.x, vb[j].y * rb * g.y); w.y = cvt_pk_bf16(vb[j].z * rb * g.z, vb[j].w * rb * g.w); ob[64 * j] = w;
        w.x = cvt_pk_bf16(va[j].x, va[j].y); w.y = cvt_pk_bf16(va[j].z, va[j].w); qa[64 * j] = w;
        w.x = cvt_pk_bf16(vb[j].x, vb[j].y); w.y = cvt_pk_bf16(vb[j].z, vb[j].w); qb[64 * j] = w; }
}
__device__ __forceinline__ void rms_row_f32_inplace(float* xrow, const float* gain, int lane) {
    f32x4* xr = (f32x4*)xrow + lane; const f32x4* gr = (const f32x4*)gain + lane;
    f32x4 v[8]; float s = 0.f;
#pragma unroll
    for (int j = 0; j < 8; ++j) { v[j] = xr[64 * j]; s += (v[j].x * v[j].x + v[j].y * v[j].y) + (v[j].z * v[j].z + v[j].w * v[j].w); }
    const float rs = 1.0f / sqrtf(wave_sum(s) * (1.f / DM) + EPS);
#pragma unroll
    for (int j = 0; j < 8; ++j) { const f32x4 g = gr[64 * j]; xr[64 * j] = v[j] * rs * g; }
}
__device__ __forceinline__ void rms_row_f32_ss(float* xrow, const float* gain, float ss, int lane) {
    f32x4* xr = (f32x4*)xrow + lane; const f32x4* gr = (const f32x4*)gain + lane;
    const float rs = 1.0f / sqrtf(ss * (1.f / DM) + EPS);
#pragma unroll
    for (int j = 0; j < 8; ++j) { const f32x4 g = gr[64 * j]; xr[64 * j] = xr[64 * j] * rs * g; }
}
__device__ __forceinline__ void final_norm_rows(float* out, const float* gain, const float* SS, int gp, int Mp, int gw, int NGW, int lane) {
    const f32x4* gr = (const f32x4*)gain + lane; f32x4 gv[8];
#pragma unroll
    for (int j = 0; j < 8; ++j) gv[j] = gr[64 * j];
    for (int m = gw; m < Mp; m += 2 * NGW) { const int m2 = (m + NGW < Mp) ? m + NGW : m;
        f32x4* xa = (f32x4*)(out + (size_t)(gp + m) * DM) + lane; f32x4* xb = (f32x4*)(out + (size_t)(gp + m2) * DM) + lane;
        const u32x2* ba = (const u32x2*)(out + (size_t)(gp + m) * DM) + lane; const u32x2* bb = (const u32x2*)(out + (size_t)(gp + m2) * DM) + lane;
        const float ssa = SS[gp + m], ssb = SS[gp + m2]; u32x2 wa[8], wb[8];
#pragma unroll
        for (int j = 0; j < 8; ++j) { wa[j] = ba[64 * j]; wb[j] = bb[64 * j]; }
        const float ra = 1.0f / sqrtf(ssa * (1.f / DM) + EPS), rb = 1.0f / sqrtf(ssb * (1.f / DM) + EPS);
        f32x4 va[8], vb[8];
#pragma unroll
        for (int j = 0; j < 8; ++j) { va[j][0] = bf_lo(wa[j].x); va[j][1] = bf_hi(wa[j].x); va[j][2] = bf_lo(wa[j].y); va[j][3] = bf_hi(wa[j].y);
            vb[j][0] = bf_lo(wb[j].x); vb[j][1] = bf_hi(wb[j].x); vb[j][2] = bf_lo(wb[j].y); vb[j][3] = bf_hi(wb[j].y); }
        if (m2 != m) {
#pragma unroll
            for (int j = 0; j < 8; ++j) { xa[64 * j] = va[j] * ra * gv[j]; xb[64 * j] = vb[j] * rb * gv[j]; }
        } else {
#pragma unroll
            for (int j = 0; j < 8; ++j) xa[64 * j] = va[j] * ra * gv[j];
        } }
}
__device__ __forceinline__ void attn_combine_row(const bf16_t* od, const float* subln, float lam, bf16_t* an, int lane) {
    const u32x4* p0 = (const u32x4*)(od + lane * 16); const u32x4* p1 = (const u32x4*)(od + 1024 + lane * 16);
    const u32x4 a0 = p0[0], a1 = p0[1], b0 = p1[0], b1 = p1[1];
    float d[16];
    const unsigned aw[8] = {a0.x, a0.y, a0.z, a0.w, a1.x, a1.y, a1.z, a1.w}, bw[8] = {b0.x, b0.y, b0.z, b0.w, b1.x, b1.y, b1.z, b1.w};
    float ss = 0.f;
#pragma unroll
    for (int i = 0; i < 8; ++i) { d[2 * i] = bf_lo(aw[i]) - lam * bf_lo(bw[i]); d[2 * i + 1] = bf_hi(aw[i]) - lam * bf_hi(bw[i]); ss += d[2 * i] * d[2 * i] + d[2 * i + 1] * d[2 * i + 1]; }
    ss = sum8(ss);
    const float rs = 0.8f / sqrtf(ss * (1.f / 128.f) + EPS);
    const float* g = subln + (lane & 7) * 16;
    u32x4 w0, w1;
    w0.x = cvt_pk_bf16(d[0] * rs * g[0], d[1] * rs * g[1]); w0.y = cvt_pk_bf16(d[2] * rs * g[2], d[3] * rs * g[3]); w0.z = cvt_pk_bf16(d[4] * rs * g[4], d[5] * rs * g[5]); w0.w = cvt_pk_bf16(d[6] * rs * g[6], d[7] * rs * g[7]);
    w1.x = cvt_pk_bf16(d[8] * rs * g[8], d[9] * rs * g[9]); w1.y = cvt_pk_bf16(d[10] * rs * g[10], d[11] * rs * g[11]); w1.z = cvt_pk_bf16(d[12] * rs * g[12], d[13] * rs * g[13]); w1.w = cvt_pk_bf16(d[14] * rs * g[14], d[15] * rs * g[15]);
    u32x4* o = (u32x4*)(an + lane * 16); o[0] = w0; o[1] = w1;
}
__device__ __forceinline__ void xsoftmax_head(const float* sc, bf16_t* prow, int l16) {
    const f32x4* sp = (const f32x4*)(sc + l16 * 16); f32x4 v[4]; float mx = -3.0e38f;
#pragma unroll
    for (int q = 0; q < 4; ++q) { v[q] = sp[q]; mx = fmaxf(mx, fmaxf(fmaxf(v[q].x, v[q].y), fmaxf(v[q].z, v[q].w))); }
    mx = max16(mx);
    float s = 0.f;
#pragma unroll
    for (int q = 0; q < 4; ++q) { v[q].x = __expf(v[q].x - mx); v[q].y = __expf(v[q].y - mx); v[q].z = __expf(v[q].z - mx); v[q].w = __expf(v[q].w - mx); s += (v[q].x + v[q].y) + (v[q].z + v[q].w); }
    s = sum16(s);
    const float inv = 1.0f / s;
    u32x4 w0, w1;
    w0.x = cvt_pk_bf16(v[0].x * inv, v[0].y * inv); w0.y = cvt_pk_bf16(v[0].z * inv, v[0].w * inv); w0.z = cvt_pk_bf16(v[1].x * inv, v[1].y * inv); w0.w = cvt_pk_bf16(v[1].z * inv, v[1].w * inv);
    w1.x = cvt_pk_bf16(v[2].x * inv, v[2].y * inv); w1.y = cvt_pk_bf16(v[2].z * inv, v[2].w * inv); w1.z = cvt_pk_bf16(v[3].x * inv, v[3].y * inv); w1.w = cvt_pk_bf16(v[3].z * inv, v[3].w * inv);
    u32x4* o = (u32x4*)(prow + l16 * 16); o[0] = w0; o[1] = w1;
}
__device__ __forceinline__ void xsoftmax_head2_bf16(const bf16_t* sc0, bf16_t* p0, const bf16_t* sc1, bf16_t* p1, int l16) {
    const u32x4* s0 = (const u32x4*)(sc0 + l16 * 16); const u32x4* s1 = (const u32x4*)(sc1 + l16 * 16);
    const u32x4 a0 = s0[0], a1 = s0[1], b0 = s1[0], b1 = s1[1];
    const unsigned aw[8] = {a0.x, a0.y, a0.z, a0.w, a1.x, a1.y, a1.z, a1.w}, bw[8] = {b0.x, b0.y, b0.z, b0.w, b1.x, b1.y, b1.z, b1.w};
    float va[16], vb[16]; float ma = -3.0e38f, mb = -3.0e38f;
#pragma unroll
    for (int i = 0; i < 8; ++i) { va[2 * i] = bf_lo(aw[i]); va[2 * i + 1] = bf_hi(aw[i]); vb[2 * i] = bf_lo(bw[i]); vb[2 * i + 1] = bf_hi(bw[i]);
        ma = fmaxf(ma, fmaxf(va[2 * i], va[2 * i + 1])); mb = fmaxf(mb, fmaxf(vb[2 * i], vb[2 * i + 1])); }
    ma = max16(ma); mb = max16(mb);
    float sa = 0.f, sb = 0.f;
#pragma unroll
    for (int i = 0; i < 16; ++i) { va[i] = __expf(va[i] - ma); vb[i] = __expf(vb[i] - mb); sa += va[i]; sb += vb[i]; }
    sa = sum16(sa); sb = sum16(sb);
    const float ia = 1.0f / sa, ib = 1.0f / sb;
    u32x4 w0, w1;
    w0.x = cvt_pk_bf16(va[0] * ia, va[1] * ia); w0.y = cvt_pk_bf16(va[2] * ia, va[3] * ia); w0.z = cvt_pk_bf16(va[4] * ia, va[5] * ia); w0.w = cvt_pk_bf16(va[6] * ia, va[7] * ia);
    w1.x = cvt_pk_bf16(va[8] * ia, va[9] * ia); w1.y = cvt_pk_bf16(va[10] * ia, va[11] * ia); w1.z = cvt_pk_bf16(va[12] * ia, va[13] * ia); w1.w = cvt_pk_bf16(va[14] * ia, va[15] * ia);
    { u32x4* o = (u32x4*)(p0 + l16 * 16); o[0] = w0; o[1] = w1; }
    w0.x = cvt_pk_bf16(vb[0] * ib, vb[1] * ib); w0.y = cvt_pk_bf16(vb[2] * ib, vb[3] * ib); w0.z = cvt_pk_bf16(vb[4] * ib, vb[5] * ib); w0.w = cvt_pk_bf16(vb[6] * ib, vb[7] * ib);
    w1.x = cvt_pk_bf16(vb[8] * ib, vb[9] * ib); w1.y = cvt_pk_bf16(vb[10] * ib, vb[11] * ib); w1.z = cvt_pk_bf16(vb[12] * ib, vb[13] * ib); w1.w = cvt_pk_bf16(vb[14] * ib, vb[15] * ib);
    { u32x4* o = (u32x4*)(p1 + l16 * 16); o[0] = w0; o[1] = w1; }
}
__device__ __forceinline__ void xsoftmax_row(const float* sc, bf16_t* prow, int lane) {
    const f32x4* sp = (const f32x4*)(sc + lane * 16); f32x4 v[4]; float mx = -3.0e38f;
#pragma unroll
    for (int q = 0; q < 4; ++q) { v[q] = sp[q]; mx = fmaxf(mx, fmaxf(fmaxf(v[q].x, v[q].y), fmaxf(v[q].z, v[q].w))); }
    mx = max16(mx);
    float s = 0.f;
#pragma unroll
    for (int q = 0; q < 4; ++q) { v[q].x = __expf(v[q].x - mx); v[q].y = __expf(v[q].y - mx); v[q].z = __expf(v[q].z - mx); v[q].w = __expf(v[q].w - mx); s += (v[q].x + v[q].y) + (v[q].z + v[q].w); }
    s = sum16(s);
    const float inv = 1.0f / s;
    u32x4 w0, w1;
    w0.x = cvt_pk_bf16(v[0].x * inv, v[0].y * inv); w0.y = cvt_pk_bf16(v[0].z * inv, v[0].w * inv); w0.z = cvt_pk_bf16(v[1].x * inv, v[1].y * inv); w0.w = cvt_pk_bf16(v[1].z * inv, v[1].w * inv);
    w1.x = cvt_pk_bf16(v[2].x * inv, v[2].y * inv); w1.y = cvt_pk_bf16(v[2].z * inv, v[2].w * inv); w1.z = cvt_pk_bf16(v[3].x * inv, v[3].y * inv); w1.w = cvt_pk_bf16(v[3].z * inv, v[3].w * inv);
    u32x4* o = (u32x4*)(prow + lane * 16); o[0] = w0; o[1] = w1;
}

constexpr int SSM_T = 32, NCH = 512;
struct SsmParams { const float *lre, *lim, *ldt, *bre, *bim, *cre, *cim; };
__device__ __forceinline__ void ssm_discretise(const SsmParams& P, int idx, float* SBB, float* APOW) {
    const int dg = idx >> 6;
    const double lr = (double)P.lre[idx], li = (double)P.lim[idx];
    const double dt = dexp((double)P.ldt[dg]);
    const double mag = dexp(lr * dt); double sn, cs; dsincos(li * dt, sn, cs);
    const double abr = mag * cs, abi = mag * sn, den = lr * lr + li * li, nr = abr - 1.0, ni = abi;
    const double kr = (nr * lr + ni * li) / den, ki = (ni * lr - nr * li) / den;
#pragma unroll
    for (int c = 0; c < 16; ++c) { const double br = (double)P.bre[idx * 16 + c], bi = (double)P.bim[idx * 16 + c];
        SBB[(idx * 16 + c) * 2] = (float)(kr * br - ki * bi); SBB[(idx * 16 + c) * 2 + 1] = (float)(kr * bi + ki * br); }
    double pr = 1.0, pi = 0.0;
    for (int t = 0; t <= SSM_T; ++t) { APOW[(idx * 33 + t) * 2] = (float)pr; APOW[(idx * 33 + t) * 2 + 1] = (float)pi; const double nr2 = pr * abr - pi * abi, ni2 = pr * abi + pi * abr; pr = nr2; pi = ni2; }
}
__device__ __forceinline__ void ssm_w1_item(int item, const float* SBB, const float* APOW, bf16_t* W1) {
    const int k8 = item & 63, n = (item >> 6) & 255, g = item >> 14, d = n >> 7, q = n & 127, p = q & 63, isim = q >> 6, j = k8 >> 1, c0 = (k8 & 1) * 8;
    const int idx = (d * 64 + g) * 64 + p, e = d ? j : (SSM_T - 1 - j);
    const float ar = APOW[(idx * 33 + e) * 2], ai = APOW[(idx * 33 + e) * 2 + 1];
    float v[8];
#pragma unroll
    for (int c = 0; c < 8; ++c) { const float br = SBB[(idx * 16 + c0 + c) * 2], bi = SBB[(idx * 16 + c0 + c) * 2 + 1]; v[c] = isim ? (ar * bi + ai * br) : (ar * br - ai * bi); }
    u32x4 w; w.x = cvt_pk_bf16(v[0], v[1]); w.y = cvt_pk_bf16(v[2], v[3]); w.z = cvt_pk_bf16(v[4], v[5]); w.w = cvt_pk_bf16(v[6], v[7]);
    *(u32x4*)(W1 + ((size_t)(g * 256 + n) * 512 + k8 * 8)) = w;
}
__device__ __forceinline__ void ssm_kfb_item(int item, const float* SBB, const float* APOW, const float* cre, const float* cim, float* KFB) {
    const int c = item & 15, ch = (item >> 4) & 15, tau = (item >> 8) & 31, d = (item >> 13) & 1, g = item >> 14;
    float acc = 0.f;
    for (int p = 0; p < 64; ++p) { const int idx = (d * 64 + g) * 64 + p;
        const float ar = APOW[(idx * 33 + tau) * 2], ai = APOW[(idx * 33 + tau) * 2 + 1], br = SBB[(idx * 16 + c) * 2], bi = SBB[(idx * 16 + c) * 2 + 1];
        const float tr = ar * br - ai * bi, ti = ar * bi + ai * br;
        acc += cre[((d * 64 + g) * 16 + ch) * 64 + p] * tr - cim[((d * 64 + g) * 16 + ch) * 64 + p] * ti; }
    KFB[item] = acc;
}
__device__ __forceinline__ void ssm_kfb_wave(int wid, int lane, const float* SBB, const float* APOW, const float* cre, const float* cim, float* KFB) {
    const int qc = wid & 3, to = (wid >> 2) & 3, d = (wid >> 4) & 1, g = wid >> 5, e = qc * 64 + lane, c = e & 15, ch = e >> 4, base = (d * 64 + g) * 64;
    float acc[8];
#pragma unroll
    for (int t = 0; t < 8; ++t) acc[t] = 0.f;
    const float* crp = cre + ((size_t)(d * 64 + g) * 16 + ch) * 64; const float* cip = cim + ((size_t)(d * 64 + g) * 16 + ch) * 64;
#pragma unroll 4
    for (int p = 0; p < 64; ++p) { const int idx = base + p;
        const f32x2 b = *(const f32x2*)(SBB + (size_t)(idx * 16 + c) * 2); const float cr = crp[p], ci = cip[p];
        const float wr = cr * b.x - ci * b.y, wi = cr * b.y + ci * b.x;
        const f32x2* ap = (const f32x2*)(APOW + (size_t)(idx * 33 + to * 8) * 2);
#pragma unroll
        for (int t = 0; t < 8; ++t) { const f32x2 a = ap[t]; acc[t] += a.x * wr - a.y * wi; } }
#pragma unroll
    for (int t = 0; t < 8; ++t) KFB[(size_t)(((g * 2 + d) * 32 + to * 8 + t) * 256) + e] = acc[t];
}
__device__ __forceinline__ void ssm_w3_item(int item, const float* APOW, const float* KFB, const float* cre, const float* cim, const float* dsk, bf16_t* W3) {
    const int k8 = item % 96, n = (item / 96) & 511, g = item / (96 * 512), j = n >> 4, ch = n & 15;
    float v[8];
    if (k8 < 64) { const int i = k8 >> 1, c0 = (k8 & 1) * 8;
#pragma unroll
        for (int c = 0; c < 8; ++c) v[c] = 0.f;
        if (i <= j) { const float* kf = KFB + (((g * 2 + 0) * 32 + (j - i)) * 256 + ch * 16 + c0);
#pragma unroll
            for (int c = 0; c < 8; ++c) v[c] += kf[c]; }
        if (i >= j) { const float* kb = KFB + (((g * 2 + 1) * 32 + (i - j)) * 256 + ch * 16 + c0);
#pragma unroll
            for (int c = 0; c < 8; ++c) v[c] += kb[c]; }
        if (i == j && (ch >> 3) == (c0 >> 3)) {
#pragma unroll
            for (int c = 0; c < 8; ++c) v[c] += (c0 + c == ch) ? dsk[g * 16 + ch] : 0.f; }
    } else { const int kk = (k8 - 64) * 8, d = kk >> 7, q0 = kk & 127, isim = q0 >> 6, p0 = q0 & 63, pw = d ? (SSM_T - j) : (j + 1);
#pragma unroll
        for (int c = 0; c < 8; ++c) { const int p = p0 + c, idx = (d * 64 + g) * 64 + p;
            const float ar = APOW[(idx * 33 + pw) * 2], ai = APOW[(idx * 33 + pw) * 2 + 1], cr = cre[((d * 64 + g) * 16 + ch) * 64 + p], ci = cim[((d * 64 + g) * 16 + ch) * 64 + p];
            v[c] = isim ? -(cr * ai + ci * ar) : (cr * ar - ci * ai); } }
    u32x4 w; w.x = cvt_pk_bf16(v[0], v[1]); w.y = cvt_pk_bf16(v[2], v[3]); w.z = cvt_pk_bf16(v[4], v[5]); w.w = cvt_pk_bf16(v[6], v[7]);
    *(u32x4*)(W3 + ((size_t)(g * 512 + n) * 768 + k8 * 8)) = w;
}
__device__ __forceinline__ void ssm_carry_wave(const float* APOW, const float* CS, bf16_t* A3, int d, int g, int chunk0, int ncs, int lane) {
    const int p = lane, idx = (d * 64 + g) * 64 + p;
    const float atr = APOW[(idx * 33 + SSM_T) * 2], ati = APOW[(idx * 33 + SSM_T) * 2 + 1];
    float xr = 0.f, xi = 0.f;
    const float* cs = CS + ((size_t)(g * NCH + chunk0) * 256 + d * 128 + p);
    bf16_t* a3 = A3 + ((size_t)(g * NCH + chunk0) * 768 + 512 + d * 128 + p);
    for (int cc = 0; cc < ncs; cc += 32) {
        float sr[32], si[32];
#pragma unroll
        for (int e = 0; e < 32; ++e) { const int c = d ? (ncs - 1 - (cc + e)) : (cc + e); sr[e] = cs[(size_t)c * 256]; si[e] = cs[(size_t)c * 256 + 64]; }
#pragma unroll
        for (int e = 0; e < 32; ++e) { const int c = d ? (ncs - 1 - (cc + e)) : (cc + e);
            a3[(size_t)c * 768] = (bf16_t)(cvt_pk_bf16(xr, 0.f) & 0xffffu); a3[(size_t)c * 768 + 64] = (bf16_t)(cvt_pk_bf16(xi, 0.f) & 0xffffu);
            const float nr = atr * xr - ati * xi + sr[e], ni = atr * xi + ati * xr + si[e]; xr = nr; xi = ni; }
    }
}
constexpr int NWAVES = 8;
#ifndef WGM_WIDE
#define WGM_WIDE 4
#endif
#ifndef MK_PER_PHASE
#define MK_PER_PHASE 0
#endif
constexpr int NG = 3;
constexpr int MAXG = 16384;
constexpr int NPH_G = 9, NPH0 = 1, NPH = NPH0 + NG * NPH_G + 1;

constexpr size_t MiB = 1u << 20;
constexpr size_t WS_CTL = 0, CTL_ZERO_BYTES = 1 * MiB;
constexpr size_t WS_ROPE = 1 * MiB;
constexpr size_t WS_SBB = 4 * MiB;
constexpr size_t WS_WIN = 5 * MiB;
constexpr size_t WS_WAP = WS_WIN + 32 * MiB;
constexpr size_t WS_WGLU = WS_WAP + 4 * MiB;
constexpr size_t WS_WMO = WS_WGLU + 8 * MiB;
constexpr size_t WS_WQC = WS_WMO + 8 * MiB;
constexpr size_t WS_WKV = WS_WQC + 8 * MiB;
constexpr size_t WS_WOC = WS_WKV + 16 * MiB;
constexpr size_t WS_WUP = WS_WOC + 8 * MiB;
constexpr size_t WS_WDN = WS_WUP + 32 * MiB;
constexpr size_t WS_MN = WS_WDN + 32 * MiB;
constexpr size_t WS_KVM = WS_MN + 8 * MiB;
constexpr size_t WS_XN = WS_KVM + 16 * MiB;
constexpr size_t WS_QKVU = WS_XN + 64 * MiB;
constexpr size_t WS_GATES = WS_QKVU + 128 * MiB;
constexpr size_t WS_H = WS_QKVU;
constexpr size_t WS_OD = WS_GATES + 128 * MiB;
constexpr size_t WS_OC = WS_OD;
constexpr size_t WS_AN = WS_OD + 64 * MiB;
constexpr size_t WS_Z = WS_AN + 32 * MiB;
constexpr size_t WS_MIX = WS_Z + 32 * MiB;
constexpr size_t WS_TQ = WS_MIX + 64 * MiB;
constexpr size_t WS_TVT = WS_TQ + 32 * MiB;
constexpr size_t WS_QC = WS_TQ;
constexpr size_t WS_SC = WS_QC + 64 * MiB;
constexpr size_t WS_P = WS_SC + 64 * MiB;
constexpr size_t WS_A3 = WS_P + 32 * MiB;
constexpr size_t WS_CS = WS_A3 + 48 * MiB;
constexpr size_t WS_W1 = WS_CS + 32 * MiB;
constexpr size_t WS_W3 = WS_W1 + 16 * MiB;
constexpr size_t WS_KFB = WS_W3 + 48 * MiB;
constexpr size_t WS_APOW = WS_KFB + 4 * MiB;
constexpr size_t WS_END = WS_APOW + 3 * MiB;
static_assert(WS_END <= 1024 * MiB, "workspace map");
constexpr int CW_BAR = 4096;

constexpr int RING_BYTES = 131072, LDSCTL_OFF = RING_BYTES, MISC_OFF = LDSCTL_OFF + 320, LDS_BYTES = 147456;

typedef GAS unsigned gu32;
#define RLX_AGENT __ATOMIC_RELAXED, __HIP_MEMORY_SCOPE_AGENT
#define LDS_WAIT() asm volatile("s_waitcnt lgkmcnt(0)" ::: "memory")

#define XB_TMO      128
#define XB_XCNT(j)  (256  + 64 * (j))
#define XB_XSUB(j)  (1280 + 64 * (j))
#define XB_XGEN(j)  (2304 + 64 * (j))
#define XB_TOP      3328
#define XB_TOPGEN   3392
#define XCD_BAR_WORDS 3456
#define XB_SPIN_CAP (1u << 22)
__device__ __forceinline__ unsigned xb_ld(gu32* p)              { return __hip_atomic_load(p, __ATOMIC_RELAXED, __HIP_MEMORY_SCOPE_AGENT); }
__device__ __forceinline__ unsigned xb_add(gu32* p, unsigned v) { return __hip_atomic_fetch_add(p, v, __ATOMIC_RELAXED, __HIP_MEMORY_SCOPE_AGENT); }
__device__ __forceinline__ unsigned xb_xcc_id() { return (unsigned)__builtin_amdgcn_s_getreg((3 << 11) | 20) & 0xFu; }
#define XB_SPIN(cond, bar) do { unsigned _sp = 0; while (cond) { __builtin_amdgcn_s_sleep(1); \
    if ((++_sp & 255u) == 0u) { if (xb_ld(&(bar)[XB_TMO])) break; if (_sp > XB_SPIN_CAP) { (void)xb_add(&(bar)[XB_TMO], 1u); break; } } } } while (0)
struct XcdBarrier { gu32* bar; unsigned x; volatile LAS unsigned* st; };
__device__ __forceinline__ XcdBarrier xcd_barrier_post(gu32* bar, volatile LAS unsigned* st) {
    XcdBarrier b; b.bar = bar; b.x = xb_xcc_id(); b.st = st;
    if (threadIdx.x == 0) (void)xb_add(&bar[XB_XCNT(b.x)], 1u);
    return b;
}
__device__ __forceinline__ void xcd_barrier_complete(gu32* bar, unsigned x, unsigned& nloc, unsigned& nx) {
    const unsigned G = gridDim.x * gridDim.y * gridDim.z;
    unsigned sum, cnt, mine, sp = 0u;
    for (;;) {
        sum = 0u; cnt = 0u; mine = 0u;
#pragma unroll
        for (unsigned j = 0; j < 16; ++j) { const unsigned c = xb_ld(&bar[XB_XCNT(j)]); sum += c; cnt += (c > 0u) ? 1u : 0u; mine = (j == x) ? c : mine; }
        if (sum == G) break;
        __builtin_amdgcn_s_sleep(1);
        if ((++sp & 255u) == 0u) { if (xb_ld(&bar[XB_TMO])) break; if (sp > XB_SPIN_CAP) { (void)xb_add(&bar[XB_TMO], 1u); break; } }
    }
    nloc = mine > 0u ? mine : 1u; nx = cnt > 0u ? cnt : 1u;
}
__device__ __forceinline__ void xcd_barrier(const XcdBarrier& b) {
    asm volatile("s_waitcnt vmcnt(0)" ::: "memory");
    __syncthreads();
    if (threadIdx.x == 0) {
        gu32* bar = b.bar; unsigned bx_ = b.x; asm volatile("" : "+s"(bar), "+s"(bx_));
        __builtin_amdgcn_s_waitcnt(0);
#ifdef EARLY_WB
        __builtin_amdgcn_fence(__ATOMIC_RELEASE, "agent");
#endif
        unsigned nloc = b.st[0], nx = b.st[1];
        if (nloc == 0u) { xcd_barrier_complete(bar, bx_, nloc, nx); b.st[0] = nloc; b.st[1] = nx; }
        const unsigned old = xb_add(&bar[XB_XSUB(bx_)], 1u);
        const unsigned gen = old / nloc;
        if (old + 1u == (gen + 1u) * nloc) {
            __builtin_amdgcn_fence(__ATOMIC_RELEASE, "agent");
            asm volatile("s_waitcnt vmcnt(0)" ::: "memory");
            const unsigned og = xb_add(&bar[XB_TOP], 1u);
            const unsigned tg = og / nx;
            if (og + 1u == (tg + 1u) * nx) xb_add(&bar[XB_TOPGEN], 1u);
            else XB_SPIN(xb_ld(&bar[XB_TOPGEN]) == tg, bar);
            __builtin_amdgcn_fence(__ATOMIC_ACQUIRE, "agent");
            xb_add(&bar[XB_XGEN(bx_)], 1u);
            asm volatile("s_waitcnt vmcnt(0)" ::: "memory");
        } else {
            XB_SPIN(xb_ld(&bar[XB_XGEN(bx_)]) == gen, bar);
            __builtin_amdgcn_fence(__ATOMIC_ACQUIRE, "agent");
            asm volatile("s_waitcnt vmcnt(0)" ::: "memory");
        }
    }
    __syncthreads();
}

__device__ __forceinline__ unsigned f2bf(float f) { unsigned u = __builtin_bit_cast(unsigned, f); return (u + 0x7fffu + ((u >> 16) & 1u)) >> 16; }
__device__ __forceinline__ unsigned pk2(float lo, float hi) { return f2bf(lo) | (f2bf(hi) << 16); }
template <int MODE>
__device__ __forceinline__ void p0_transpose_tile(const float* W, int K, int N, bf16_t* WT, int which, LAS float* T, int item, int tid, const float* kscale = nullptr) {
    const int nblk = N / 128, kb = item / nblk, nb = item - kb * nblk, k0 = 128 * kb, n0 = 128 * nb;
    { const int r = tid >> 5, c4 = tid & 31; f32x4 v[8];
#pragma unroll
      for (int p = 0; p < 8; ++p) v[p] = *(const f32x4*)(W + (size_t)(k0 + 16 * p + r) * N + n0 + 4 * c4);
#pragma unroll
      for (int p = 0; p < 8; ++p) { LAS float* d = T + (16 * p + r) * 129 + 4 * c4; d[0] = v[p].x; d[1] = v[p].y; d[2] = v[p].z; d[3] = v[p].w; } }
    __syncthreads();
#pragma unroll
    for (int q = 0; q < 4; ++q) { const int cid = q * 512 + tid, n = cid >> 4, ch = cid & 15; const LAS float* sp = T + (8 * ch) * 129 + n;
        float e0 = sp[0 * 129], e1 = sp[1 * 129], e2 = sp[2 * 129], e3 = sp[3 * 129], e4 = sp[4 * 129], e5 = sp[5 * 129], e6 = sp[6 * 129], e7 = sp[7 * 129];
        if (kscale) { const f32x4 ka = *(const f32x4*)(kscale + k0 + 8 * ch), kb2 = *(const f32x4*)(kscale + k0 + 8 * ch + 4); e0 *= ka.x; e1 *= ka.y; e2 *= ka.z; e3 *= ka.w; e4 *= kb2.x; e5 *= kb2.y; e6 *= kb2.z; e7 *= kb2.w; }
        u32x4 o; o.x = pk2(e0, e1); o.y = pk2(e2, e3); o.z = pk2(e4, e5); o.w = pk2(e6, e7);
        const int nl = n0 + n; int prow;
        if (MODE == 0) prow = nl;
        else if (MODE == 1) { if (nl < 2048) { const int o64 = nl & 63; prow = (nl & ~63) + 8 * ((o64 & 31) >> 2) + 4 * (o64 >> 5) + (o64 & 3); } else prow = nl; }
        else prow = 8 * (nl >> 2) + 4 * which + (nl & 3);
        *(GAS u32x4*)(WT + (size_t)prow * K + k0 + 8 * ch) = o; }
    __syncthreads();
}

struct Args { const float* in[29]; float* out; unsigned char* ws; int ph_lo, ph_hi; };

__global__ void __launch_bounds__(NWAVES * 64, 2) fwd_kernel(Args args) {
    extern __shared__ __attribute__((aligned(16))) unsigned char lds[];
    LAS unsigned char* ldsl = (LAS unsigned char*)lds;
    volatile LAS unsigned* MISC = (volatile LAS unsigned*)(ldsl + MISC_OFF);
    const int tid = threadIdx.x, lane = tid & 63, wave = __builtin_amdgcn_readfirstlane(tid >> 6);
    const int G = gridDim.x, bx = blockIdx.x;
    const int vcu = (G % 8 == 0) ? (bx % 8) * (G / 8) + bx / 8 : bx;
    const int gw = vcu * NWAVES + wave, NGW = G * NWAVES;
    unsigned char* ws = args.ws;
    unsigned* ctl = (unsigned*)(ws + WS_CTL);
    for (int u = tid; u < (LDS_BYTES - LDSCTL_OFF) / 4; u += NWAVES * 64) ((LAS unsigned*)(ldsl + LDSCTL_OFF))[u] = 0u;
    __syncthreads();
    XcdBarrier bar; bar.bar = (gu32*)(ctl + CW_BAR); bar.x = 0; bar.st = nullptr;
    if (!MK_PER_PHASE) bar = xcd_barrier_post((gu32*)(ctl + CW_BAR), MISC + 8);
    const int lo = args.ph_lo, hi = args.ph_hi;
#ifndef DBG_ONLY
#define DBG_ONLY -1
#endif
#ifndef DBG_REPEAT_MASK
#define DBG_REPEAT_MASK 0u
#endif
#ifndef DBG_REPEAT_PRO
#define DBG_REPEAT_PRO 0u
#endif
#define IN(k) (lo <= (k) && (k) < hi)
#define PHASE(n) for (int rep_ = 0; rep_ < (((DBG_REPEAT_MASK >> (n)) & 1u) ? 2 : 1); ++rep_) if ((DBG_ONLY < 0 || DBG_ONLY == NPH0 + (n)) && IN(pb + (n)))
#ifdef DBG_WAIT_MASK
    unsigned long long wacc_ = 0ull;
#define SEAM(k) do { if (!MK_PER_PHASE && IN(k) && IN((k) + 1)) { const unsigned long long t0_ = wall_clock64(); xcd_barrier(bar); const int sb_ = (k) == 0 ? 9 : ((k) - NPH0) % NPH_G; if ((DBG_WAIT_MASK >> sb_) & 1u) wacc_ += wall_clock64() - t0_; } } while (0)
#elif defined(DBG_MINWAIT)
    unsigned long long wacc_ = 0ull;
#define SEAM(k) do { if (!MK_PER_PHASE && IN(k) && IN((k) + 1)) { const unsigned long long t0_ = wall_clock64(); xcd_barrier(bar); const unsigned w_ = (unsigned)(wall_clock64() - t0_); \
        if (threadIdx.x == 0) atomicMax((unsigned*)(ws + WS_CTL + 600064) + (k), 0x40000000u - w_); } } while (0)
#elif defined(DBG_WORK_MASK)
#ifdef DBG_CYCLES
#define DBG_NOW() ((unsigned long long)clock64() / 24ull)
#else
#define DBG_NOW() wall_clock64()
#endif
    unsigned long long wacc_ = 0ull, trel_ = DBG_NOW();
#define SEAM(k) do { if (!MK_PER_PHASE && IN(k) && IN((k) + 1)) { const unsigned long long ta_ = DBG_NOW(); if ((DBG_WORK_MASK >> (k)) & 1ull) wacc_ += ta_ - trel_; xcd_barrier(bar); trel_ = DBG_NOW(); } } while (0)
#else
#define SEAM(k) do { if (!MK_PER_PHASE && IN(k) && IN((k) + 1)) xcd_barrier(bar); } while (0)
#endif

    const float* x_prompt = args.in[0]; const float* x_sample = args.in[1]; const float* mem_prompt = args.in[2]; const float* mem_sample = args.in[3];
    float* out = args.out;
    bf16_t* W_IN = (bf16_t*)(ws + WS_WIN); bf16_t* W_AP = (bf16_t*)(ws + WS_WAP); bf16_t* W_GLU = (bf16_t*)(ws + WS_WGLU); bf16_t* W_MO = (bf16_t*)(ws + WS_WMO);
    bf16_t* W_QC = (bf16_t*)(ws + WS_WQC); bf16_t* W_KV = (bf16_t*)(ws + WS_WKV); bf16_t* W_OC = (bf16_t*)(ws + WS_WOC); bf16_t* W_UP = (bf16_t*)(ws + WS_WUP); bf16_t* W_DN = (bf16_t*)(ws + WS_WDN);
    bf16_t* MN = (bf16_t*)(ws + WS_MN); bf16_t* KVM = (bf16_t*)(ws + WS_KVM); bf16_t* TQ = (bf16_t*)(ws + WS_TQ); bf16_t* TVT = (bf16_t*)(ws + WS_TVT);
    bf16_t* XN0 = (bf16_t*)(ws + WS_XN); bf16_t* XN1 = (bf16_t*)(ws + WS_OD); bf16_t* QKVU = (bf16_t*)(ws + WS_QKVU); bf16_t* GATES = (bf16_t*)(ws + WS_GATES); bf16_t* HB = (bf16_t*)(ws + WS_H);
    bf16_t* OD = (bf16_t*)(ws + WS_OD); bf16_t* OC = (bf16_t*)(ws + WS_OC); bf16_t* AN = (bf16_t*)(ws + WS_AN); bf16_t* ZB = (bf16_t*)(ws + WS_Z); bf16_t* MIX = (bf16_t*)(ws + WS_MIX);
    bf16_t* A3 = (bf16_t*)(ws + WS_A3); float* CS = (float*)(ws + WS_CS); bf16_t* W1 = (bf16_t*)(ws + WS_W1); bf16_t* W3 = (bf16_t*)(ws + WS_W3); float* KFB = (float*)(ws + WS_KFB); float* APOW = (float*)(ws + WS_APOW);
    float* SC = (float*)(ws + WS_SC); bf16_t* PB = (bf16_t*)(ws + WS_P);
    float* SS1 = (float*)(ws + WS_CTL + 65536); float* SS2 = SS1 + NTOK; float* SS3 = SS2 + NTOK;
    float* ROPE = (float*)(ws + WS_ROPE); float* SBB = (float*)(ws + WS_SBB);

    for (int rep_ = 0; rep_ < ((DBG_REPEAT_PRO & 1u) ? 2 : 1); ++rep_) if ((DBG_ONLY < 0 || DBG_ONLY == 0) && IN(0)) {
        { LAS float* T = (LAS float*)ldsl;
          constexpr int I_WIN = (DM / 128) * (INC / 128), I_AP = (AW / 128) * (DM / 128), I_GL = (SW / 128) * (DM / 128), I_SQ = (DM / 128) * (DM / 128), I_KV = (DM / 128) * (4096 / 128), I_UP = (DM / 128) * (DFF / 128), I_DN = (DFF / 128) * (DM / 128);
          constexpr int NITEMS = I_WIN + I_AP + 2 * I_GL + 2 * I_SQ + I_KV + I_UP + I_DN;
          for (int it = vcu; it < NITEMS; it += G) {
            int r = it;
            if (r < I_WIN) { p0_transpose_tile<1>(args.in[5], DM, INC, W_IN, 0, T, r, tid); continue; } r -= I_WIN;
            if (r < I_AP) { p0_transpose_tile<0>(args.in[8], AW, DM, W_AP, 0, T, r, tid); continue; } r -= I_AP;
            if (r < I_GL) { p0_transpose_tile<2>(args.in[17], SW, DM, W_GLU, 0, T, r, tid); continue; } r -= I_GL;
            if (r < I_GL) { p0_transpose_tile<2>(args.in[18], SW, DM, W_GLU, 1, T, r, tid); continue; } r -= I_GL;
            if (r < I_SQ) { p0_transpose_tile<0>(args.in[19], DM, DM, W_MO, 0, T, r, tid); continue; } r -= I_SQ;
            if (r < I_SQ) { p0_transpose_tile<0>(args.in[24], DM, DM, W_OC, 0, T, r, tid); continue; } r -= I_SQ;
            if (r < I_KV) { p0_transpose_tile<0>(args.in[23], DM, 4096, W_KV, 0, T, r, tid); continue; } r -= I_KV;
            if (r < I_UP) { p0_transpose_tile<0>(args.in[26], DM, DFF, W_UP, 0, T, r, tid, args.in[25]); continue; } r -= I_UP;
            p0_transpose_tile<0>(args.in[27], DFF, DM, W_DN, 0, T, r, tid);
          } }
        for (int i = gw * 64 + lane; i < DM * DM / 8; i += NGW * 64) { const f32x4* p = (const f32x4*)(args.in[22] + (size_t)i * 8); const f32x4 a = p[0], b = p[1];
            u32x4 w; w.x = pk2(a.x, a.y); w.y = pk2(a.z, a.w); w.z = pk2(b.x, b.y); w.w = pk2(b.z, b.w); *(u32x4*)(W_QC + (size_t)i * 8) = w; }
        for (int i = gw * 64 + lane; i < LPR * 32; i += NGW * 64) { const int pos = i >> 5, f = i & 31;
            const float inv = (float)dexp(-(double)f * (9.210340371976184 / 32.0));
            const float ang = (float)pos * inv; double s, c; dsincos((double)ang, s, c);
            ROPE[pos * 64 + f] = (float)c; ROPE[pos * 64 + 32 + f] = (float)s; }
        { const SsmParams P{args.in[9], args.in[10], args.in[11], args.in[12], args.in[13], args.in[14], args.in[15]};
          for (int i = gw * 64 + lane; i < 8192; i += NGW * 64) ssm_discretise(P, i, SBB, APOW); }
        for (int m = gw; m < 16384; m += 2 * NGW) { const int m2 = m + NGW;
            const int mb = m2 < 16384 ? m2 : m;
            rms_row2_bf16_xr(x_prompt + (size_t)m * DM, x_prompt + (size_t)mb * DM, args.in[4], XN0 + (size_t)m * DM, XN0 + (size_t)mb * DM, (bf16_t*)out + (size_t)m * pg8::XRS, (bf16_t*)out + (size_t)mb * pg8::XRS, lane); }
        for (int m = gw; m < NMEMROWS; m += NGW) { const float* src = m < 1024 ? mem_prompt + (size_t)m * DM : mem_sample + (size_t)(m - 1024) * DM; rms_row_bf16(src, args.in[21], MN + (size_t)m * DM, lane); }
    }
    SEAM(0);

    for (int gi = 0; gi < NG; ++gi) {
        const int pb = NPH0 + gi * NPH_G; if (pb >= hi || pb + NPH_G <= lo) continue;
        const int grow0 = gi * 16384, M = gi < 2 ? 16384 : 8192;
        const int L = grow0 < NPROMPT ? LPR : LSA, nseq = M / L, seq0 = grow0 < NPROMPT ? grow0 / LPR : 4 + (grow0 - NPROMPT) / LSA;
        bf16_t* XN = (gi & 1) ? XN1 : XN0; bf16_t* XNnext = (gi & 1) ? XN0 : XN1;
        PHASE(0) {
            { pg8::Gemm g{DM, DM, DM}; pg8::TileOrder S; S.init(XN, DM, W_IN, DM, M, INC, G, bx, WGM_WIDE); pg8::EpiWin E{QKVU, GATES, ROPE, grow0, A3}; pg8::gemm_phase(ldsl, g, S, E); }
            if (gi == 0) {
                struct MemOrder { const bf16_t* MN; const bf16_t* WKV; int G, c;
                    __device__ bool next(int i, pg8::Unit& u) const { const int id = i * G + c; if (id >= 128) return false; u.pm = id >> 4; u.pn = id & 15;
                        u.a = (const char*)(MN + (size_t)u.pm * 256 * DM); u.b = (const char*)(WKV + (size_t)u.pn * 256 * DM); return true; } };
                pg8::Gemm g{DM, DM, DM}; MemOrder S{MN, W_KV, G, G == 256 ? ((bx + 128) & 255) : bx}  ; pg8::EpiBf16<0> E{KVM, 4096, 1.0f}; pg8::gemm_phase(ldsl, g, S, E);
                int tl_ = threadIdx.x; asm volatile("" : "+v"(tl_)); const int lane = tl_ & 63;
                const int tb = (G == 256) ? 128 : G;
                if (bx < tb) { for (int it = (bx * NWAVES + wave) * 64 + lane; it < 64 * 256 * 64; it += tb * NWAVES * 64) ssm_w1_item(it, SBB, APOW, W1);
                    for (int wid = bx * NWAVES + wave; wid < 64 * 2 * 4 * 4; wid += tb * NWAVES) ssm_kfb_wave(wid, lane, SBB, APOW, args.in[14], args.in[15], KFB); }
            }
        }
        SEAM(pb + 0);
#ifdef DBG_IDLE_BEFORE_C
        if (gi == 1) { const unsigned long long ti_ = wall_clock64(); while (wall_clock64() - ti_ < DBG_IDLE_BEFORE_C) __builtin_amdgcn_s_sleep(32);
#ifdef DBG_WORK_MASK
            trel_ = wall_clock64();
#endif
        }
#endif
        PHASE(1) {
            int tl_ = threadIdx.x; asm volatile("" : "+v"(tl_)); const int lane = tl_ & 63;
            float lam; { const float* dl = args.in[6]; float t0 = dl[lane] * dl[64 + lane], t1 = dl[128 + lane] * dl[192 + lane]; t0 = wave_sum(t0); t1 = wave_sum(t1); lam = __expf(t0) - __expf(t1) + 0.2f; }
            const int nqb = L / 128, NU = nseq * 8 * nqb;
            const int h0 = (G == 256) ? 128 : 0, nh = G - h0, nupc = (G == 256 && NU % 256 == 0) ? NU / 256 : 1, cohort = (bx >> 3) & (nupc - 1);
            for (int i = 0;; ++i) {
                if (i == cohort && bx >= h0) {
                    int tlr_ = threadIdx.x; asm volatile("" : "+v"(tlr_)); const int lane = tlr_ & 63;
                    const float* gmix = args.in[4]; const float* gfin = args.in[28]; asm volatile("" : "+s"(gmix), "+s"(gfin));
                    if (gi + 1 < NG) { const int g1 = (gi + 1) * 16384, M1 = gi + 1 < 2 ? 16384 : 8192;
                        for (int m = (bx - h0) * NWAVES + wave; m < M1; m += 2 * nh * NWAVES) { const int m2 = (m + nh * NWAVES < M1) ? m + nh * NWAVES : m, gr = g1 + m, gr2 = g1 + m2;
                            const float* src = gr < NPROMPT ? x_prompt + (size_t)gr * DM : x_sample + (size_t)(gr - NPROMPT) * DM; const float* src2 = gr2 < NPROMPT ? x_prompt + (size_t)gr2 * DM : x_sample + (size_t)(gr2 - NPROMPT) * DM;
                            rms_row2_bf16_xr(src, src2, gmix, XNnext + (size_t)m * DM, XNnext + (size_t)m2 * DM, (bf16_t*)out + (size_t)gr * pg8::XRS, (bf16_t*)out + (size_t)gr2 * pg8::XRS, lane); } }
                    if (gi > 0) final_norm_rows(out, gfin, SS3, (gi - 1) * 16384, 16384, (bx - h0) * NWAVES + wave, nh * NWAVES, lane);
                }
                int un; if (G == 256 && NU % 256 == 0) { const int per = NU / 8; un = (vcu >> 5) * per + (vcu & 31) + 32 * i; if (32 * i + (vcu & 31) >= per) break; } else { un = bx + i * G; if (un >= NU) break; }
                const int qb = un % nqb, sh = un / nqb, h = sh & 7, s = sh >> 3; const size_t srow = (size_t)s * L;
                attn3::attn_unit3(QKVU + (srow + (size_t)qb * 128) * 4096 + h * 128, QKVU + srow * 4096 + 1024 + h * 128, QKVU + srow * 4096 + 2048 + h * 128, AN + (srow + (size_t)qb * 128) * 1024 + h * 128, args.in[7], lam, L, (LAS char*)ldsl);
            }
            struct S1Order { const bf16_t* A3; const bf16_t* W1; int nmb, G, c;
                __device__ bool next(int i, pg8::Unit& u) const { const int id = i * G + c; if (id >= 64 * nmb) return false; const int g = id / nmb, mb = id - g * nmb;
                    u.pm = g * (NCH / 256) + mb; u.pn = 0; u.a = (const char*)(A3 + (size_t)(g * NCH + mb * 256) * 768); u.b = (const char*)(W1 + (size_t)g * 256 * 512); return true; } };
            { pg8::Gemm g{768, 512, 512}; S1Order S{A3, W1, M / (32 * 256), G, bx}; pg8::EpiF32 E{CS, 256}; pg8::gemm_phase(ldsl, g, S, E); }
            { int tl2_ = threadIdx.x; asm volatile("" : "+v"(tl2_)); const int lane = tl2_ & 63; const int nmb = M / (32 * 256), ncs = L / 32, nsb = 256 / ncs;
              for (int id = bx; id < 64 * nmb; id += G) { const int g = id / nmb, mb = id - g * nmb, sb = wave >> 1, d = wave & 1;
                  if (sb < nsb) ssm_carry_wave(APOW, CS, A3, d, g, mb * 256 + sb * ncs, ncs, lane); } }
            if (gi == 0) {
                struct TqOrder { const bf16_t* KVM; const bf16_t* WQ; int G, c;
                    __device__ bool next(int i, pg8::Unit& u) const { const int id = i * G + c; if (id >= 256) return false; const int sq = id >> 5, hx = (id >> 3) & 3, nb = id & 7;
                        u.pm = sq * 4 + hx; u.pn = nb; u.a = (const char*)(KVM + (size_t)sq * 256 * 4096 + hx * 512); u.b = (const char*)(WQ + (size_t)nb * 256 * DM + hx * 512); return true; } };
                struct TvOrder { const bf16_t* WO; const bf16_t* KVM; int G, c;
                    __device__ bool next(int i, pg8::Unit& u) const { const int id = i * G + c; if (id >= 256) return false; const int sq = id >> 5, hx = (id >> 3) & 3, mb = id & 7;
                        u.pm = sq * 8 + mb; u.pn = hx; u.a = (const char*)(WO + (size_t)mb * 256 * DM + hx * 512); u.b = (const char*)(KVM + (size_t)sq * 256 * 4096 + 2048 + hx * 512); return true; } };
                { pg8::Gemm g{4096, DM, 512}; TqOrder S{KVM, W_QC, G, bx}; pg8::EpiBf16Col E{TQ, DM, 0.044194173824159216f, args.in[20]}; pg8::gemm_phase(ldsl, g, S, E); }
                { pg8::Gemm g{DM, 4096, 512}; TvOrder S{W_OC, KVM, G, bx}; pg8::EpiBf16<0> E{TVT, 1024, 1.0f}; pg8::gemm_phase(ldsl, g, S, E); }
                int tl3_ = threadIdx.x; asm volatile("" : "+v"(tl3_)); const int lane = tl3_ & 63;
                for (int it = gw * 64 + lane; it < 64 * 512 * 96; it += NGW * 64) ssm_w3_item(it, APOW, KFB, args.in[14], args.in[15], args.in[16], W3);
            }
        }
        SEAM(pb + 1);
        PHASE(2) {
            { pg8::Gemm g{AW, AW, AW}; pg8::TileOrder S; S.init(AN, AW, W_AP, AW, M, DM, G, bx); pg8::EpiAttnProj E{GATES, MIX}; pg8::gemm_phase(ldsl, g, S, E); }
            struct S3Order { const bf16_t* A3; const bf16_t* W3; int nmb, G, c;
                __device__ bool next(int i, pg8::Unit& u) const { const int id = i * G + c; if (id >= 128 * nmb) return false; const int nb = id & 1, gm = id >> 1, g = gm / nmb, mb = gm - g * nmb;
                    u.pm = g * (NCH / 256) + mb; u.pn = nb; u.a = (const char*)(A3 + (size_t)(g * NCH + mb * 256) * 768); u.b = (const char*)(W3 + (size_t)(g * 512 + nb * 256) * 768); return true; } };
            pg8::Gemm g{768, 768, 768}; S3Order S{A3, W3, M / (32 * 256), G, bx}; pg8::EpiSsmOut E{ZB}; pg8::gemm_phase(ldsl, g, S, E);
        }
        SEAM(pb + 2);
        PHASE(3) { pg8::Gemm g{SW, SW, SW}; pg8::TileOrder S; S.init(ZB, SW, W_GLU, SW, M, 4096, G, bx); pg8::EpiGlu E{GATES, MIX}; pg8::gemm_phase(ldsl, g, S, E); }
        SEAM(pb + 3);
        PHASE(4) { pg8::Gemm g{DM, DM, DM}; pg8::TileOrder S; S.init(MIX, DM, W_MO, DM, M, DM, G, bx); pg8::EpiResidSS E{(bf16_t*)out, grow0, SS1, nullptr, nullptr}; pg8::gemm_phase(ldsl, g, S, E); }
        SEAM(pb + 4);
        PHASE(5) {
            struct OneScore { const char* a; const char* b; int pm, pn;
                __device__ bool next(int i, pg8::Unit& u) const { if (i > 0) return false; u.a = a; u.b = b; u.pm = pm; u.pn = pn; return true; } };
            const int nrb = M / 256, rbsh = (L == LPR) ? 5 : 3;
            for (int id = vcu; id < nrb * 4; id += G) { const int hx = id & 3, rb = id >> 2, sq = seq0 + (rb >> rbsh);
                { pg8::Gemm g{pg8::XRS, DM, DM}; OneScore S{(const char*)((const bf16_t*)out + (size_t)(grow0 + rb * 256) * pg8::XRS), (const char*)(TQ + ((size_t)sq * 1024 + hx * 256) * DM), rb, hx};
                  pg8::EpiBf16Rs<0> E{(bf16_t*)SC, 1024, 1.0f, SS1, grow0}; pg8::gemm_phase(ldsl, g, S, E); }
                for (int r4 = wave; r4 < 64; r4 += 2 * NWAVES) { const size_t row = (size_t)rb * 256 + r4 * 4 + (lane >> 4), row2 = row + 4 * NWAVES;
                    xsoftmax_head2_bf16((const bf16_t*)SC + row * 1024 + hx * 256, PB + row * 1024 + hx * 256, (const bf16_t*)SC + row2 * 1024 + hx * 256, PB + row2 * 1024 + hx * 256, lane & 15); }
            }
        }
        SEAM(pb + 5);
        PHASE(6) {
            struct XoOrder { pg8::TileOrder T; const bf16_t* TVT; int rbsh, seq0;
                __device__ bool next(int i, pg8::Unit& u) const { if (!T.next(i, u)) return false; u.b = (const char*)(TVT + ((size_t)(seq0 + (u.pm >> rbsh)) * 2048 + u.pn * 256) * 1024); return true; } };
            pg8::Gemm g{1024, 1024, 1024}; XoOrder S; S.T.init(PB, 1024, TVT, 1024, M, DM, G, bx); S.TVT = TVT; S.rbsh = (L == LPR) ? 5 : 3; S.seq0 = seq0;
            pg8::EpiResidSS E{(bf16_t*)out, grow0, SS2, nullptr, nullptr}; pg8::gemm_phase(ldsl, g, S, E);
        }
        SEAM(pb + 6);
        PHASE(7) { pg8::Gemm g{pg8::XRS, DM, DM}; pg8::TileOrder S; S.init((const bf16_t*)out + (size_t)grow0 * pg8::XRS, pg8::XRS, W_UP, DM, M, DFF, G, bx, WGM_WIDE); pg8::EpiBf16Rs<2> E{HB, DFF, 1.0f, SS2, grow0}; pg8::gemm_phase(ldsl, g, S, E); }
        SEAM(pb + 7);
        PHASE(8) { pg8::Gemm g{DFF, DFF, DFF}; pg8::TileOrder S; S.init(HB, DFF, W_DN, DFF, M, DM, G, bx); pg8::EpiResidSS E{(bf16_t*)out, grow0, SS3, nullptr, nullptr}; pg8::gemm_phase(ldsl, g, S, E); }
        SEAM(pb + 8);
    }
    if ((DBG_ONLY < 0 || DBG_ONLY == NPH - 1) && IN(NPH - 1)) { int tl_ = threadIdx.x; asm volatile("" : "+v"(tl_)); const int lane = tl_ & 63; const int gp = (NG - 1) * 16384, Mp = 8192; final_norm_rows(out, args.in[28], SS3, gp, Mp, gw, NGW, lane); }
#if defined(DBG_WAIT_MASK) || defined(DBG_WORK_MASK) || defined(DBG_MINWAIT)
    { unsigned long long* wtot = (unsigned long long*)(ws + WS_CTL + 600000);
      if (threadIdx.x == 0) atomicAdd(wtot, wacc_);
      xcd_barrier(bar);
#ifdef DBG_MINWAIT
      if (bx == 0 && threadIdx.x == 0) { unsigned long long sm = 0; for (int k = 0; k < NPH - 1; ++k) { const unsigned v = __hip_atomic_load((unsigned*)(ws + WS_CTL + 600064) + k, __ATOMIC_RELAXED, __HIP_MEMORY_SCOPE_AGENT); sm += (unsigned long long)(0x40000000u - v); } *wtot = sm * (unsigned long long)G; }
      __syncthreads();
#endif
      if (bx == 0 && threadIdx.x == 0) { unsigned long long tot = __hip_atomic_load(wtot, __ATOMIC_RELAXED, __HIP_MEMORY_SCOPE_AGENT) / (unsigned long long)G;
#ifdef DBG_SPIN_TICKS
        tot = DBG_SPIN_TICKS;
#endif
 const unsigned long long t0_ = wall_clock64(); while (wall_clock64() - t0_ < tot) __builtin_amdgcn_s_sleep(8); } }
#endif
#undef IN
#undef PHASE
#undef SEAM
}

#ifdef DBG_STOP
__global__ void dump_kernel(const unsigned char* ws, size_t off, size_t nelem, int is_f32, float* out, size_t nout) {
    for (size_t i = (size_t)blockIdx.x * blockDim.x + threadIdx.x; i < nout; i += (size_t)gridDim.x * blockDim.x) { const size_t idx = i % nelem;
        float v = is_f32 ? ((const float*)(ws + off))[idx] : __uint_as_float((unsigned)((const bf16_t*)(ws + off))[idx] << 16);
        if (!(v == v) || fabsf(v) > 1e30f) v = 12345.f; out[i] = v; }
}
#endif
extern "C" void kernel_launch(void* const* d_in, const int* in_sizes, int n_in, void* d_out, int out_size, void* d_ws, size_t ws_size, hipStream_t stream) {
    static int grid = 0;
    if (grid == 0) {
        if (n_in != 29 || out_size != NTOK * DM || ws_size < WS_END) { fprintf(stderr, "kernel_launch: unexpected shapes: n_in %d out %d ws %zu (need %zu)\n", n_in, out_size, ws_size, (size_t)WS_END); grid = -1; return; }
        int dev = 0, cus = 0, per_cu = 0;
        if (hipGetDevice(&dev) != hipSuccess || hipDeviceGetAttribute(&cus, hipDeviceAttributeMultiprocessorCount, dev) != hipSuccess) { grid = -1; return; }
        if (hipFuncSetAttribute((const void*)fwd_kernel, hipFuncAttributeMaxDynamicSharedMemorySize, LDS_BYTES) != hipSuccess) { fprintf(stderr, "kernel_launch: hipFuncSetAttribute failed\n"); grid = -1; return; }
        if (hipOccupancyMaxActiveBlocksPerMultiprocessor(&per_cu, (const void*)fwd_kernel, NWAVES * 64, LDS_BYTES) != hipSuccess || per_cu < 1) { fprintf(stderr, "kernel_launch: occupancy query says %d\n", per_cu); }
        (void)hipGetLastError();
        grid = cus;
    }
    if (grid < 0) return;
    (void)hipMemsetAsync((char*)d_ws + WS_CTL, 0, CTL_ZERO_BYTES, stream);
    Args a{};
    for (int i = 0; i < 29; ++i) a.in[i] = (const float*)d_in[i];
    a.out = (float*)d_out; a.ws = (unsigned char*)d_ws;
#if MK_PER_PHASE
#ifdef DBG_STOP
    for (int p = 0; p < DBG_STOP; ++p) { a.ph_lo = p; a.ph_hi = p + 1; hipLaunchKernelGGL(fwd_kernel, dim3(grid), dim3(NWAVES * 64), LDS_BYTES, stream, a); }
    hipLaunchKernelGGL(dump_kernel, dim3(2048), dim3(256), 0, stream, (const unsigned char*)d_ws, (size_t)DBG_OFF, (size_t)DBG_NELEM, (int)DBG_F32, (float*)d_out, (size_t)NTOK * DM);
#else
    for (int p = 0; p < NPH; ++p) { a.ph_lo = p; a.ph_hi = p + 1; hipLaunchKernelGGL(fwd_kernel, dim3(grid), dim3(NWAVES * 64), LDS_BYTES, stream, a); }
#endif
#else
    a.ph_lo = 0; a.ph_hi = NPH; hipLaunchKernelGGL(fwd_kernel, dim3(grid), dim3(NWAVES * 64), LDS_BYTES, stream, a);
#endif
}
```

```cpp
#include <hip/hip_runtime.h>
#include <hip/hip_bf16.h>
#include <cstdio>
#include <cstdint>
#include <cmath>

#define LAS __attribute__((address_space(3)))
#define GAS __attribute__((address_space(1)))
typedef unsigned short bf16_t;
typedef short bf16x8 __attribute__((ext_vector_type(8)));
typedef short s16x4 __attribute__((ext_vector_type(4)));
typedef float f32x4 __attribute__((ext_vector_type(4)));
typedef float f32x2 __attribute__((ext_vector_type(2)));
typedef float f32x16 __attribute__((ext_vector_type(16)));
typedef unsigned u32x4 __attribute__((ext_vector_type(4)));
typedef unsigned u32x2 __attribute__((ext_vector_type(2)));

constexpr int DM = 2048, NTOK = 40960, NPROMPT = 32768, LPR = 8192, LSA = 2048;
constexpr int INC = 8192, AW = 1024, SW = 1024, DFF = 8192, NMEMROWS = 2048;
constexpr float EPS = 1e-6f;

typedef __bf16 bf16x2_t __attribute__((ext_vector_type(2)));
__device__ __forceinline__ unsigned cvt_pk_bf16(float lo, float hi) { f32x2 v = {lo, hi}; bf16x2_t b = __builtin_convertvector(v, bf16x2_t); return __builtin_bit_cast(unsigned, b); }
__device__ __forceinline__ float bf_lo(unsigned w) { return __uint_as_float(w << 16); }
__device__ __forceinline__ float bf_hi(unsigned w) { return __uint_as_float(w & 0xffff0000u); }
__device__ __forceinline__ float sigmoidf_(float x) { return __builtin_amdgcn_rcpf(1.0f + __expf(-x)); }
template <int CTRL> __device__ __forceinline__ float dppf(float v) { return __int_as_float(__builtin_amdgcn_update_dpp(0, __float_as_int(v), CTRL, 0xF, 0xF, true)); }
__device__ __forceinline__ float sum4(float v) { v += dppf<0xB1>(v); v += dppf<0x4E>(v); return v; }
__device__ __forceinline__ float sum8(float v) { v = sum4(v); v += dppf<0x141>(v); return v; }
__device__ __forceinline__ float sum16(float v) { v = sum4(v); v += dppf<0x124>(v); v += dppf<0x128>(v); return v; }
__device__ __forceinline__ float max16(float v) { v = fmaxf(v, dppf<0xB1>(v)); v = fmaxf(v, dppf<0x4E>(v)); v = fmaxf(v, dppf<0x124>(v)); v = fmaxf(v, dppf<0x128>(v)); return v; }
__device__ __forceinline__ float wave_sum(float v) {
    v = sum16(v);
    { auto r = __builtin_amdgcn_permlane16_swap(__float_as_uint(v), __float_as_uint(v), false, false); v = __uint_as_float(r[0]) + __uint_as_float(r[1]); }
    { auto r = __builtin_amdgcn_permlane32_swap(__float_as_uint(v), __float_as_uint(v), false, false); v = __uint_as_float(r[0]) + __uint_as_float(r[1]); }
    return v;
}

namespace pg8 {
constexpr int BM = 256, BK = 64, HALF = 128, HTB = HALF * BK * 2, STAGE_BYTES = 8 * HTB, NXCD = 8;
__host__ __device__ __forceinline__ int lds_byte(int r, int c) { const int st = (r >> 4) * 2 + (c >> 5), rr = r & 15, cc = c & 31, ob = rr * 64 + cc * 2; return st * 1024 + (ob ^ (((ob >> 9) & 1) << 5)); }
__host__ __device__ __forceinline__ void stage_rc(int b, int& R, int& C) { const int st = b / 1024, sb = b % 1024, swz = sb ^ (((sb >> 9) & 1) << 5); R = (st >> 1) * 16 + swz / 64; C = (st & 1) * 32 + (swz % 64) / 2; }
__host__ __device__ __forceinline__ int perm32(int rho) { const int n = rho >> 4, i = rho & 15; return 8 * (i >> 2) + 4 * n + (i & 3); }

struct Unit { const char* a; const char* b; int pm, pn; };
struct Gemm { int lda, ldb, K; };

struct TileOrder {
    const char* A; const char* B; size_t ta, tb; int nM, nN, nwg, G, c, wgm;
    __device__ void init(const void* A_, int lda, const void* B_, int ldb, int M, int N, int G_, int c_, int WGM = 4) { A = (const char*)A_; B = (const char*)B_; ta = (size_t)BM * lda * 2; tb = (size_t)BM * ldb * 2; nM = M / BM; nN = N / BM; nwg = nM * nN; G = G_; c = c_; wgm = WGM; }
    __device__ bool next(int i, Unit& u) const {
        const long L = (long)i * G + c; if (L >= nwg) return false;
        int wgid = (int)L; { const int q = nwg / NXCD, r = nwg % NXCD, xcd = wgid % NXCD, off = wgid / NXCD; wgid = (xcd < r ? xcd * (q + 1) : r * (q + 1) + (xcd - r) * q) + off; }
        const int nig = wgm * nN, gid = wgid / nig, fm = gid * wgm, gsz = (nM - fm) < wgm ? (nM - fm) : wgm;
        u.pm = fm + ((wgid % nig) % gsz); u.pn = (wgid % nig) / gsz; u.a = A + (size_t)u.pm * ta; u.b = B + (size_t)u.pn * tb; return true;
    }
};

template <class Epi, class Sched>
__device__ __forceinline__ void gemm_phase(LAS unsigned char* lds, const Gemm g, const Sched& S, const Epi& E) {
    int tid_ = threadIdx.x; asm volatile("" : "+v"(tid_));
    const int tid = tid_, wid = __builtin_amdgcn_readfirstlane(tid >> 6), lane = tid & 63, wr = wid >> 2, wc = wid & 3, fr = lane & 15, fq = lane >> 4;
    int K_ = g.K; asm volatile("" : "+s"(K_));
    const int K = K_, nt = K / BK;
    unsigned voffA[2], voffB[2];
#pragma unroll
    for (int i = 0; i < 2; ++i) { int R, C; stage_rc(tid * 16 + i * 8192, R, C); const int Rb = Epi::PERM ? ((R & ~31) + perm32(R & 31)) : R;
        voffA[i] = (unsigned)(R * g.lda + C) * 2u; voffB[i] = (unsigned)(Rb * g.ldb + C) * 2u; }
    const size_t kstep = (size_t)(BK * 2);
    const size_t hsA = (size_t)HALF * g.lda * 2, hsB = (size_t)HALF * g.ldb * 2;
    const unsigned ldsw = (unsigned)wid * 1024u;
    const int aoff = lds_byte(wr * 64 + fr, fq * 8), boff = lds_byte(wc * 32 + fr, fq * 8);
#define PG8_SA(b, h) (((b) * 2 + (h)) * HTB)
#define PG8_SB(b, h) ((4 + (b) * 2 + (h)) * HTB)
#define PG8_STAGE(bufoff, gbase, voff) do { _Pragma("unroll") for (int _i = 0; _i < 2; ++_i) \
        __builtin_amdgcn_global_load_lds((const unsigned*)((const char*)(gbase) + (voff)[_i]), (LAS unsigned*)(lds + (bufoff) + ldsw + _i * 8192), 16, 0, 0); } while (0)
#define PG8_LDA(dst, b, h) do { _Pragma("unroll") for (int m = 0; m < 4; ++m) _Pragma("unroll") for (int k = 0; k < 2; ++k) dst[m][k] = *(const LAS bf16x8*)(lds + PG8_SA(b, h) + aoff + m * 2048 + k * 1024); } while (0)
#define PG8_LDB(dst, b, h) do { _Pragma("unroll") for (int n = 0; n < 2; ++n) _Pragma("unroll") for (int k = 0; k < 2; ++k) dst[n][k] = *(const LAS bf16x8*)(lds + PG8_SB(b, h) + boff + n * 2048 + k * 1024); } while (0)
#define PG8_MMA(ai, bj, At, Bt) do { __builtin_amdgcn_s_setprio(1); _Pragma("unroll") for (int m = 0; m < 4; ++m) _Pragma("unroll") for (int n = 0; n < 2; ++n) _Pragma("unroll") for (int k = 0; k < 2; ++k) \
        acc[ai][bj][m][n] = __builtin_amdgcn_mfma_f32_16x16x32_bf16(Bt[n][k], At[m][k], acc[ai][bj][m][n], 0, 0, 0); __builtin_amdgcn_s_setprio(0); } while (0)
#define PG8_WAIT_V(n) asm volatile("s_waitcnt vmcnt(" #n ")" ::: "memory")
#define PG8_WAIT_L(n) asm volatile("s_waitcnt lgkmcnt(" #n ")" ::: "memory")
#define PG8_BAR __builtin_amdgcn_s_barrier()
#define PG8_SCHED __builtin_amdgcn_sched_barrier(0)
    Unit cur, nxt; int ui = 0;
    if (!S.next(0, cur)) return;
    f32x4 acc[2][2][4][2];
#pragma unroll
    for (int a = 0; a < 2; ++a)
#pragma unroll
        for (int b = 0; b < 2; ++b)
#pragma unroll
            for (int m = 0; m < 4; ++m)
#pragma unroll
                for (int n = 0; n < 2; ++n) acc[a][b][m][n] = (f32x4){0.f, 0.f, 0.f, 0.f};
    bf16x8 At[4][2], B0[2][2], B1[2][2];
    const char* cA = cur.a; const char* cB = cur.b;
    PG8_STAGE(PG8_SB(0, 0), cB, voffB); PG8_STAGE(PG8_SB(0, 1), cB + hsB, voffB); PG8_STAGE(PG8_SA(0, 0), cA, voffA); PG8_STAGE(PG8_SA(0, 1), cA + hsA, voffA);
    if (wr == 1) PG8_BAR;
    PG8_WAIT_V(2); PG8_BAR;
    PG8_STAGE(PG8_SB(1, 0), cB + kstep, voffB); PG8_STAGE(PG8_SA(1, 0), cA + kstep, voffA); PG8_STAGE(PG8_SB(1, 1), cB + hsB + kstep, voffB);
    PG8_WAIT_V(6); PG8_BAR;
    for (;;) {
        const bool has_next = S.next(ui + 1, nxt);
        const char* nA = has_next ? nxt.a : cA; const char* nB = has_next ? nxt.b : cB;
        for (int t = 0; t < nt; t += 2) {
            const bool last = (t == nt - 2);
            const char* a1 = cA + (size_t)(t + 1) * kstep;
            const char* a2 = last ? nA : cA + (size_t)(t + 2) * kstep; const char* b2 = last ? nB : cB + (size_t)(t + 2) * kstep;
            const char* a3 = a2 + kstep; const char* b3 = b2 + kstep;
            PG8_LDB(B0, 0, 0); PG8_LDB(B1, 0, 1); PG8_SCHED; PG8_LDA(At, 0, 0); PG8_STAGE(PG8_SA(1, 1), a1 + hsA, voffA);
            PG8_WAIT_V(8); PG8_WAIT_L(0); PG8_BAR; PG8_MMA(0, 0, At, B0); PG8_MMA(0, 1, At, B1); PG8_BAR; PG8_SCHED;
            PG8_LDA(At, 0, 1); PG8_STAGE(PG8_SB(0, 0), b2, voffB); PG8_STAGE(PG8_SB(0, 1), b2 + hsB, voffB); PG8_STAGE(PG8_SA(0, 0), a2, voffA);
            PG8_WAIT_V(8); PG8_WAIT_L(0); PG8_BAR; PG8_MMA(1, 0, At, B0); PG8_MMA(1, 1, At, B1); PG8_BAR; PG8_SCHED;
            PG8_LDB(B0, 1, 0); PG8_LDB(B1, 1, 1); PG8_SCHED; PG8_LDA(At, 1, 0); PG8_STAGE(PG8_SA(0, 1), a2 + hsA, voffA);
            PG8_WAIT_V(8); PG8_WAIT_L(0); PG8_BAR; PG8_MMA(0, 0, At, B0); PG8_MMA(0, 1, At, B1); PG8_BAR; PG8_SCHED;
            PG8_LDA(At, 1, 1); PG8_STAGE(PG8_SB(1, 0), b3, voffB); PG8_STAGE(PG8_SB(1, 1), b3 + hsB, voffB); PG8_STAGE(PG8_SA(1, 0), a3, voffA);
            PG8_WAIT_V(8); PG8_WAIT_L(0); PG8_BAR; PG8_MMA(1, 0, At, B0); PG8_MMA(1, 1, At, B1); PG8_BAR; PG8_SCHED;
        }
        if (wr == 0) PG8_BAR;
        E(acc, cur, wr, wc, fr, fq);
        if (!has_next) break;
#pragma unroll
        for (int a = 0; a < 2; ++a)
#pragma unroll
            for (int b = 0; b < 2; ++b)
#pragma unroll
                for (int m = 0; m < 4; ++m)
#pragma unroll
                    for (int n = 0; n < 2; ++n) acc[a][b][m][n] = (f32x4){0.f, 0.f, 0.f, 0.f};
        cur = nxt; cA = nA; cB = nB; ++ui;
        if (wr == 1) PG8_BAR;
    }
    PG8_WAIT_V(0);
    PG8_BAR;
#undef PG8_SA
#undef PG8_SB
#undef PG8_STAGE
#undef PG8_LDA
#undef PG8_LDB
#undef PG8_MMA
#undef PG8_WAIT_V
#undef PG8_WAIT_L
#undef PG8_BAR
#undef PG8_SCHED
}
}
__device__ __forceinline__ float gelu_tanh(float x) {
    const float y2 = 1.5957691216057308f * (x + 0.044715f * x * x * x);
    return x * sigmoidf_(y2);
}
namespace pg8 {
__device__ __forceinline__ u32x4 pack8(const f32x4 v0, const f32x4 v1) { u32x4 w; w.x = cvt_pk_bf16(v0[0], v0[1]); w.y = cvt_pk_bf16(v0[2], v0[3]); w.z = cvt_pk_bf16(v1[0], v1[1]); w.w = cvt_pk_bf16(v1[2], v1[3]); return w; }
__device__ __forceinline__ u32x2 pack4(const f32x4 v) { u32x2 w; w.x = cvt_pk_bf16(v[0], v[1]); w.y = cvt_pk_bf16(v[2], v[3]); return w; }

template <int ACT> struct EpiBf16 {
    static constexpr bool PERM = true;
    bf16_t* O; int ldc; float scale;
    __device__ __forceinline__ void operator()(const f32x4 (&acc)[2][2][4][2], const Unit& u, int wr, int wc, int fr, int fq) const {
        const int row0 = u.pm * BM + wr * 64 + fr, col0 = u.pn * BM + wc * 32 + 8 * fq;
#pragma unroll
        for (int ai = 0; ai < 2; ++ai)
#pragma unroll
            for (int m = 0; m < 4; ++m) { bf16_t* rowp = O + (size_t)(row0 + ai * HALF + m * 16) * ldc + col0;
#pragma unroll
                for (int bj = 0; bj < 2; ++bj) { f32x4 v0 = acc[ai][bj][m][0], v1 = acc[ai][bj][m][1];
                    if (ACT == 2) {
#pragma unroll
                        for (int e = 0; e < 4; ++e) { const float a = fmaxf(v0[e], 0.f), b = fmaxf(v1[e], 0.f); v0[e] = a * a; v1[e] = b * b; } }
                    v0 = v0 * scale; v1 = v1 * scale;
                    *(u32x4*)(rowp + bj * HALF) = pack8(v0, v1); } }
    }
};
struct EpiBf16Col {
    static constexpr bool PERM = true;
    bf16_t* O; int ldc; float scale; const float* cg;
    __device__ __forceinline__ void operator()(const f32x4 (&acc)[2][2][4][2], const Unit& u, int wr, int wc, int fr, int fq) const {
        const int row0 = u.pm * BM + wr * 64 + fr, col0 = u.pn * BM + wc * 32 + 8 * fq;
        f32x4 gv[2][2];
#pragma unroll
        for (int bj = 0; bj < 2; ++bj) { gv[bj][0] = *(const f32x4*)(cg + col0 + bj * HALF) * scale; gv[bj][1] = *(const f32x4*)(cg + col0 + bj * HALF + 4) * scale; }
#pragma unroll
        for (int ai = 0; ai < 2; ++ai)
#pragma unroll
            for (int m = 0; m < 4; ++m) { bf16_t* rowp = O + (size_t)(row0 + ai * HALF + m * 16) * ldc + col0;
#pragma unroll
                for (int bj = 0; bj < 2; ++bj) *(u32x4*)(rowp + bj * HALF) = pack8(acc[ai][bj][m][0] * gv[bj][0], acc[ai][bj][m][1] * gv[bj][1]); }
    }
};
template <int ACT> struct EpiBf16Rs {
    static constexpr bool PERM = true;
    bf16_t* O; int ldc; float scale; const float* SS; int grow0;
    __device__ __forceinline__ void operator()(const f32x4 (&acc)[2][2][4][2], const Unit& u, int wr, int wc, int fr, int fq) const {
        const int row0 = u.pm * BM + wr * 64 + fr, col0 = u.pn * BM + wc * 32 + 8 * fq;
        float ssv[2][4];
#pragma unroll
        for (int ai = 0; ai < 2; ++ai)
#pragma unroll
            for (int m = 0; m < 4; ++m) ssv[ai][m] = SS[grow0 + row0 + ai * HALF + m * 16];
#pragma unroll
        for (int ai = 0; ai < 2; ++ai)
#pragma unroll
            for (int m = 0; m < 4; ++m) { const int rl = row0 + ai * HALF + m * 16; bf16_t* rowp = O + (size_t)rl * ldc + col0;
                float r = 1.0f / sqrtf(ssv[ai][m] * (1.f / DM) + EPS); if (ACT == 2) r = r * r; r *= scale;
#pragma unroll
                for (int bj = 0; bj < 2; ++bj) { f32x4 v0 = acc[ai][bj][m][0], v1 = acc[ai][bj][m][1];
                    if (ACT == 2) {
#pragma unroll
                        for (int e = 0; e < 4; ++e) { const float a = fmaxf(v0[e], 0.f), b = fmaxf(v1[e], 0.f); v0[e] = a * a; v1[e] = b * b; } }
                    v0 = v0 * r; v1 = v1 * r;
                    *(u32x4*)(rowp + bj * HALF) = pack8(v0, v1); } }
    }
};
struct EpiF32 {
    static constexpr bool PERM = false;
    float* O; int ldc;
    __device__ __forceinline__ void operator()(const f32x4 (&acc)[2][2][4][2], const Unit& u, int wr, int wc, int fr, int fq) const {
        const int row0 = u.pm * BM + wr * 64 + fr, col0 = u.pn * BM + wc * 32 + 4 * fq;
#pragma unroll
        for (int ai = 0; ai < 2; ++ai)
#pragma unroll
            for (int m = 0; m < 4; ++m) { float* rowp = O + (size_t)(row0 + ai * HALF + m * 16) * ldc + col0;
#pragma unroll
                for (int bj = 0; bj < 2; ++bj)
#pragma unroll
                    for (int n = 0; n < 2; ++n) *(f32x4*)(rowp + bj * HALF + n * 16) = acc[ai][bj][m][n]; }
    }
};
struct EpiF32Rs {
    static constexpr bool PERM = false;
    float* O; int ldc; const float* SS; int grow0;
    __device__ __forceinline__ void operator()(const f32x4 (&acc)[2][2][4][2], const Unit& u, int wr, int wc, int fr, int fq) const {
        const int row0 = u.pm * BM + wr * 64 + fr, col0 = u.pn * BM + wc * 32 + 4 * fq;
        float ssv[2][4];
#pragma unroll
        for (int ai = 0; ai < 2; ++ai)
#pragma unroll
            for (int m = 0; m < 4; ++m) ssv[ai][m] = SS[grow0 + row0 + ai * HALF + m * 16];
#pragma unroll
        for (int ai = 0; ai < 2; ++ai)
#pragma unroll
            for (int m = 0; m < 4; ++m) { const int rl = row0 + ai * HALF + m * 16; float* rowp = O + (size_t)rl * ldc + col0; const float r = 1.0f / sqrtf(ssv[ai][m] * (1.f / DM) + EPS);
#pragma unroll
                for (int bj = 0; bj < 2; ++bj)
#pragma unroll
                    for (int n = 0; n < 2; ++n) *(f32x4*)(rowp + bj * HALF + n * 16) = acc[ai][bj][m][n] * r; }
    }
};
struct EpiResid {
    static constexpr bool PERM = false;
    const float* xp; const float* xs; float* out; int grow0; int from_x;
    __device__ __forceinline__ void operator()(const f32x4 (&acc)[2][2][4][2], const Unit& u, int wr, int wc, int fr, int fq) const {
        const int row0 = grow0 + u.pm * BM + wr * 64 + fr, col0 = u.pn * BM + wc * 32 + 4 * fq;
#pragma unroll
        for (int ai = 0; ai < 2; ++ai)
#pragma unroll
            for (int m = 0; m < 4; ++m) { const int gr = row0 + ai * HALF + m * 16;
                float* op = out + (size_t)gr * DM + col0;
                const float* bp = from_x ? (gr < NPROMPT ? xp + (size_t)gr * DM : xs + (size_t)(gr - NPROMPT) * DM) + col0 : op;
#pragma unroll
                for (int bj = 0; bj < 2; ++bj)
#pragma unroll
                    for (int n = 0; n < 2; ++n) { const f32x4 b = *(const f32x4*)(bp + bj * HALF + n * 16); *(f32x4*)(op + bj * HALF + n * 16) = b + acc[ai][bj][m][n]; } }
    }
};
constexpr int XRS = 2 * DM;
__device__ __forceinline__ f32x4 unpack4(const u32x2 w) { f32x4 v; v[0] = bf_lo(w.x); v[1] = bf_hi(w.x); v[2] = bf_lo(w.y); v[3] = bf_hi(w.y); return v; }
struct EpiResidSS {
    static constexpr bool PERM = false;
    bf16_t* xr; int grow0; float* SSo; bf16_t* XN; const float* gain;
    __device__ __forceinline__ void operator()(const f32x4 (&acc)[2][2][4][2], const Unit& u, int wr, int wc, int fr, int fq) const {
        const int rowl0 = u.pm * BM + wr * 64 + fr, col0 = u.pn * BM + wc * 32 + 4 * fq;
        f32x4 gv[2][2];
        if (XN) {
#pragma unroll
            for (int bj = 0; bj < 2; ++bj)
#pragma unroll
                for (int n = 0; n < 2; ++n) gv[bj][n] = *(const f32x4*)(gain + col0 + bj * HALF + n * 16); }
        u32x2 bw[2][4][2][2];
#pragma unroll
        for (int ai = 0; ai < 2; ++ai)
#pragma unroll
            for (int m = 0; m < 4; ++m) { const bf16_t* bp = xr + (size_t)(grow0 + rowl0 + ai * HALF + m * 16) * XRS + col0;
#pragma unroll
                for (int bj = 0; bj < 2; ++bj)
#pragma unroll
                    for (int n = 0; n < 2; ++n) bw[ai][m][bj][n] = *(const u32x2*)(bp + bj * HALF + n * 16); }
#pragma unroll
        for (int ai = 0; ai < 2; ++ai) {
            f32x4 bv[4][2][2];
#pragma unroll
            for (int m = 0; m < 4; ++m)
#pragma unroll
                for (int bj = 0; bj < 2; ++bj)
#pragma unroll
                    for (int n = 0; n < 2; ++n) bv[m][bj][n] = unpack4(bw[ai][m][bj][n]);
#pragma unroll
            for (int m = 0; m < 4; ++m) { const int rl = rowl0 + ai * HALF + m * 16, gr = grow0 + rl;
                bf16_t* op = xr + (size_t)gr * XRS + col0;
                float ss = 0.f;
#pragma unroll
                for (int bj = 0; bj < 2; ++bj)
#pragma unroll
                    for (int n = 0; n < 2; ++n) { const f32x4 v = bv[m][bj][n] + acc[ai][bj][m][n]; *(u32x2*)(op + bj * HALF + n * 16) = pack4(v);
                        ss += (v[0] * v[0] + v[1] * v[1]) + (v[2] * v[2] + v[3] * v[3]);
                        if (XN) *(u32x2*)(XN + (size_t)rl * DM + col0 + bj * HALF + n * 16) = pack4(v * gv[bj][n]); }
                { auto r = __builtin_amdgcn_permlane16_swap(__float_as_uint(ss), __float_as_uint(ss), false, false); ss = __uint_as_float(r[0]) + __uint_as_float(r[1]); }
                { auto r = __builtin_amdgcn_permlane32_swap(__float_as_uint(ss), __float_as_uint(ss), false, false); ss = __uint_as_float(r[0]) + __uint_as_float(r[1]); }
                if (fq == 0) (void)__hip_atomic_fetch_add(SSo + gr, ss, __ATOMIC_RELAXED, __HIP_MEMORY_SCOPE_AGENT); } }
    }
};
struct EpiWin {
    static constexpr bool PERM = true;
    bf16_t* QKVU; bf16_t* GATES; const float* rope; int grow0; bf16_t* A3;
    __device__ __forceinline__ void operator()(const f32x4 (&acc)[2][2][4][2], const Unit& u, int wr, int wc, int fr, int fq) const {
        const int rowl0 = u.pm * BM + wr * 64 + fr, pn = u.pn;
        if (pn < 8) {
            const float sc = pn < 4 ? 0.125f * 1.4426950408889634f : 1.0f  ; const int g8 = 4 * (wc & 1) + fq;
#pragma unroll
            for (int ai = 0; ai < 2; ++ai) {
                f32x4 csv[4], snv[4];
#pragma unroll
                for (int m = 0; m < 4; ++m) { const int gr = grow0 + rowl0 + ai * HALF + m * 16, pos = gr < NPROMPT ? (gr & (LPR - 1)) : (gr & (LSA - 1));
                    csv[m] = *(const f32x4*)(rope + pos * 64 + 4 * g8); snv[m] = *(const f32x4*)(rope + pos * 64 + 32 + 4 * g8); }
#pragma unroll
                for (int m = 0; m < 4; ++m) { const int rl = rowl0 + ai * HALF + m * 16;
                    const f32x4 cs = csv[m] * sc, sn = snv[m] * sc;
#pragma unroll
                    for (int bj = 0; bj < 2; ++bj) { const f32x4 v0 = acc[ai][bj][m][0], v1 = acc[ai][bj][m][1];
                        const f32x4 o1 = v0 * cs - v1 * sn, o2 = v1 * cs + v0 * sn;
                        bf16_t* p = QKVU + (size_t)rl * 4096 + (4 * pn + 2 * bj + (wc >> 1)) * 64 + 4 * g8;
                        *(u32x2*)p = pack4(o1); *(u32x2*)(p + 32) = pack4(o2); } } }
        } else if (pn >= 12 && pn < 16) {
            const int ucol = (pn - 12) * BM + wc * 32 + 8 * fq;
#pragma unroll
            for (int ai = 0; ai < 2; ++ai)
#pragma unroll
                for (int m = 0; m < 4; ++m) { const int rl = rowl0 + ai * HALF + m * 16;
#pragma unroll
                    for (int bj = 0; bj < 2; ++bj) { const int uc = ucol + bj * HALF;
                        *(u32x4*)(A3 + ((size_t)((uc >> 4) * 512 + (rl >> 5)) * 768 + (rl & 31) * 16 + (uc & 15))) = pack8(acc[ai][bj][m][0], acc[ai][bj][m][1]); } }
        } else if (pn < 12) {
            const int col0 = pn * BM + wc * 32 + 8 * fq;
#pragma unroll
            for (int ai = 0; ai < 2; ++ai)
#pragma unroll
                for (int m = 0; m < 4; ++m) { bf16_t* rowp = QKVU + (size_t)(rowl0 + ai * HALF + m * 16) * 4096 + col0;
#pragma unroll
                    for (int bj = 0; bj < 2; ++bj) *(u32x4*)(rowp + bj * HALF) = pack8(acc[ai][bj][m][0], acc[ai][bj][m][1]); }
        } else {
            const int col0 = (pn - 16) * BM + wc * 32 + 8 * fq;
#pragma unroll
            for (int ai = 0; ai < 2; ++ai)
#pragma unroll
                for (int m = 0; m < 4; ++m) { bf16_t* rowp = GATES + (size_t)(rowl0 + ai * HALF + m * 16) * 4096 + col0;
#pragma unroll
                    for (int bj = 0; bj < 2; ++bj) { f32x4 v0 = acc[ai][bj][m][0], v1 = acc[ai][bj][m][1];
#pragma unroll
                        for (int e = 0; e < 4; ++e) { v0[e] = sigmoidf_(v0[e]); v1[e] = sigmoidf_(v1[e]); }
                        *(u32x4*)(rowp + bj * HALF) = pack8(v0, v1); } }
        }
    }
};
struct EpiAttnProj {
    static constexpr bool PERM = true;
    const bf16_t* GATES; bf16_t* MIX;
    __device__ __forceinline__ void operator()(const f32x4 (&acc)[2][2][4][2], const Unit& u, int wr, int wc, int fr, int fq) const {
        const int row0 = u.pm * BM + wr * 64 + fr, col0 = u.pn * BM + wc * 32 + 8 * fq;
        u32x4 gwv[2][4][2];
#pragma unroll
        for (int ai = 0; ai < 2; ++ai)
#pragma unroll
            for (int m = 0; m < 4; ++m)
#pragma unroll
                for (int bj = 0; bj < 2; ++bj) gwv[ai][m][bj] = *(const u32x4*)(GATES + (size_t)(row0 + ai * HALF + m * 16) * 4096 + col0 + bj * HALF);
#pragma unroll
        for (int ai = 0; ai < 2; ++ai) {
#pragma unroll
            for (int m = 0; m < 4; ++m) { const int r = row0 + ai * HALF + m * 16;
#pragma unroll
                for (int bj = 0; bj < 2; ++bj) { const u32x4 gw = gwv[ai][m][bj];
                    f32x4 v0 = acc[ai][bj][m][0], v1 = acc[ai][bj][m][1];
                    v0[0] *= bf_lo(gw.x); v0[1] *= bf_hi(gw.x); v0[2] *= bf_lo(gw.y); v0[3] *= bf_hi(gw.y);
                    v1[0] *= bf_lo(gw.z); v1[1] *= bf_hi(gw.z); v1[2] *= bf_lo(gw.w); v1[3] *= bf_hi(gw.w);
                    *(u32x4*)(MIX + (size_t)r * DM + col0 + bj * HALF) = pack8(v0, v1); } } }
    }
};
struct EpiGlu {
    static constexpr bool PERM = true;
    const bf16_t* GATES; bf16_t* MIX;
    __device__ __forceinline__ void operator()(const f32x4 (&acc)[2][2][4][2], const Unit& u, int wr, int wc, int fr, int fq) const {
        const int row0 = u.pm * BM + wr * 64 + fr, j0 = u.pn * 128 + wc * 16 + 4 * fq;
        u32x2 gwv[2][4][2], mwv[2][4][2];
#pragma unroll
        for (int ai = 0; ai < 2; ++ai)
#pragma unroll
            for (int m = 0; m < 4; ++m)
#pragma unroll
                for (int bj = 0; bj < 2; ++bj) { const int r = row0 + ai * HALF + m * 16, j = j0 + bj * 64;
                    gwv[ai][m][bj] = *(const u32x2*)(GATES + (size_t)r * 4096 + DM + j); mwv[ai][m][bj] = *(const u32x2*)(MIX + (size_t)r * DM + j); }
#pragma unroll
        for (int ai = 0; ai < 2; ++ai) {
#pragma unroll
            for (int m = 0; m < 4; ++m) { const int r = row0 + ai * HALF + m * 16;
#pragma unroll
                for (int bj = 0; bj < 2; ++bj) { const int j = j0 + bj * 64;
                    const u32x2 gw = gwv[ai][m][bj]; bf16_t* mp = MIX + (size_t)r * DM + j; const u32x2 mw = mwv[ai][m][bj];
                    const f32x4 a = acc[ai][bj][m][0], b = acc[ai][bj][m][1]; f32x4 o;
                    o[0] = a[0] * sigmoidf_(b[0]) * bf_lo(gw.x) + bf_lo(mw.x); o[1] = a[1] * sigmoidf_(b[1]) * bf_hi(gw.x) + bf_hi(mw.x);
                    o[2] = a[2] * sigmoidf_(b[2]) * bf_lo(gw.y) + bf_lo(mw.y); o[3] = a[3] * sigmoidf_(b[3]) * bf_hi(gw.y) + bf_hi(mw.y);
                    *(u32x2*)mp = pack4(o); } } }
    }
};
struct EpiSsmOut {
    static constexpr bool PERM = true;
    bf16_t* Z;
    __device__ __forceinline__ void operator()(const f32x4 (&acc)[2][2][4][2], const Unit& u, int wr, int wc, int fr, int fq) const {
        const int row0 = u.pm * BM + wr * 64 + fr, n00 = u.pn * BM + wc * 32 + 8 * fq;
#pragma unroll
        for (int ai = 0; ai < 2; ++ai)
#pragma unroll
            for (int m = 0; m < 4; ++m) { const int row = row0 + ai * HALF + m * 16, g = row >> 9, chunk = row & 511;
#pragma unroll
                for (int bj = 0; bj < 2; ++bj) { const int n0 = n00 + bj * HALF, j = n0 >> 4, ch0 = n0 & 15;
                    f32x4 v0 = acc[ai][bj][m][0], v1 = acc[ai][bj][m][1];
#pragma unroll
                    for (int e = 0; e < 4; ++e) { v0[e] = gelu_tanh(v0[e]); v1[e] = gelu_tanh(v1[e]); }
                    *(u32x4*)(Z + ((size_t)(chunk * 32 + j) * 1024 + g * 16 + ch0)) = pack8(v0, v1); } }
    }
};
}
namespace attn3 {
constexpr int KVBLK = 64, LDQ = 4096, LDK = 4096, TILE_B = 64 * 128 * 2;
constexpr float THR = 8.f;
typedef short v4i16_t __attribute__((ext_vector_type(4)));
#define SBAR() __builtin_amdgcn_sched_barrier(0)
__device__ __forceinline__ s16x4 vtr(const LAS char* p) { return __builtin_bit_cast(s16x4, __builtin_amdgcn_ds_read_tr16_b64_v4i16((LAS v4i16_t*)p)); }
__device__ __forceinline__ int offK(int row, int ch16) { return 256 * row + 16 * (ch16 ^ (row & 15)); }
__device__ __forceinline__ int offV(int row, int ch16) { return 256 * row + 32 * ((ch16 >> 1) ^ (row & 7)) + 16 * (ch16 & 1); }
__device__ __forceinline__ float xmax4(float v) {
    { auto r = __builtin_amdgcn_permlane16_swap(__float_as_uint(v), __float_as_uint(v), false, false); v = fmaxf(__uint_as_float(r[0]), __uint_as_float(r[1])); }
    { auto r = __builtin_amdgcn_permlane32_swap(__float_as_uint(v), __float_as_uint(v), false, false); v = fmaxf(__uint_as_float(r[0]), __uint_as_float(r[1])); }
    return v; }
__device__ __forceinline__ int xmaxi4(int v) {
    { auto r = __builtin_amdgcn_permlane16_swap((unsigned)v, (unsigned)v, false, false); v = max((int)r[0], (int)r[1]); }
    { auto r = __builtin_amdgcn_permlane32_swap((unsigned)v, (unsigned)v, false, false); v = max((int)r[0], (int)r[1]); }
    return v; }
__device__ __forceinline__ float xsum4(float v) {
    { auto r = __builtin_amdgcn_permlane16_swap(__float_as_uint(v), __float_as_uint(v), false, false); v = __uint_as_float(r[0]) + __uint_as_float(r[1]); }
    { auto r = __builtin_amdgcn_permlane32_swap(__float_as_uint(v), __float_as_uint(v), false, false); v = __uint_as_float(r[0]) + __uint_as_float(r[1]); }
    return v; }

__device__ __forceinline__ void attn_unit3(const bf16_t* __restrict__ Qb, const bf16_t* __restrict__ Kh, const bf16_t* __restrict__ Vh, bf16_t* __restrict__ An, const float* __restrict__ subln, float lam, int seq, LAS char* lds) {
  int tid_ = threadIdx.x; asm volatile("" : "+v"(tid_));
  const int tid = tid_, wid = __builtin_amdgcn_readfirstlane(tid >> 6), lane = tid & 63, i16 = lane & 15, g = lane >> 4, half = wid >> 2;
  LAS char* V_lds = lds; LAS char* K_lds = lds + 2 * TILE_B;
  LAS float* ws = (LAS float*)(lds + 4 * TILE_B) + wid * 64;
  bf16x8 qf[2][2];
  { const bf16_t* Qw = Qb + (long)(wid * 16 + i16) * LDQ + 8 * g;
#pragma unroll
    for (int m = 0; m < 2; ++m)
#pragma unroll
      for (int ks = 0; ks < 2; ++ks) qf[m][ks] = *reinterpret_cast<const bf16x8*>(Qw + 64 * m + 32 * ks); }
  f32x4 o[2][8];
#pragma unroll
  for (int m = 0; m < 2; ++m)
#pragma unroll
    for (int cb = 0; cb < 8; ++cb) o[m][cb] = (f32x4){0.f, 0.f, 0.f, 0.f};
  float l_reg[2] = {0.f, 0.f}, negm[2] = {0.f, 0.f};
  const int sr = tid >> 4, sc16 = tid & 15;
  const int kst0 = offK(sr, sc16), kst1 = offK(32 + sr, sc16), vst0 = offV(sr, sc16), vst1 = offV(32 + sr, sc16);
  const int tq = i16 >> 2, tp = i16 & 3;
  const int NT = seq / KVBLK;
  bf16x8 gk0, gk1, gv0, gv1;
#define LOADK(t) do { gk0 = *reinterpret_cast<const bf16x8*>(&Kh[(long)((t) * KVBLK + sr) * LDK + sc16 * 8]); gk1 = *reinterpret_cast<const bf16x8*>(&Kh[(long)((t) * KVBLK + 32 + sr) * LDK + sc16 * 8]); } while (0)
#define LOADV(t) do { gv0 = *reinterpret_cast<const bf16x8*>(&Vh[(long)((t) * KVBLK + sr) * LDK + sc16 * 8]); gv1 = *reinterpret_cast<const bf16x8*>(&Vh[(long)((t) * KVBLK + 32 + sr) * LDK + sc16 * 8]); } while (0)
#define WRITEK(t) do { LAS char* kb_ = K_lds + ((t) & 1) * TILE_B; *(LAS bf16x8*)(kb_ + kst0) = gk0; *(LAS bf16x8*)(kb_ + kst1) = gk1; } while (0)
#define WRITEV(t) do { LAS char* vb_ = V_lds + ((t) & 1) * TILE_B; *(LAS bf16x8*)(vb_ + vst0) = gv0; *(LAS bf16x8*)(vb_ + vst1) = gv1; } while (0)
  f32x4 s[2][4]; bf16x8 pa[2][2];
#define KRD(KF, kbase, kb0) do { _Pragma("unroll") for (int b = 0; b < 2; ++b) _Pragma("unroll") for (int m = 0; m < 2; ++m) _Pragma("unroll") for (int ks = 0; ks < 2; ++ks) \
      KF[b][m][ks] = *(const LAS bf16x8*)((kbase) + offK(16 * ((kb0) + b) + i16, 8 * m + 4 * ks + g)); } while (0)
#define QKM(KF, kb0) do { _Pragma("unroll") for (int b = 0; b < 2; ++b) _Pragma("unroll") for (int m = 0; m < 2; ++m) { \
      f32x4 c_ = (f32x4){negm[m], negm[m], negm[m], negm[m]}; \
      c_ = __builtin_amdgcn_mfma_f32_16x16x32_bf16(KF[b][m][0], qf[m][0], c_, 0, 0, 0); \
      s[m][(kb0) + b] = __builtin_amdgcn_mfma_f32_16x16x32_bf16(KF[b][m][1], qf[m][1], c_, 0, 0, 0); } } while (0)
#define VRD(VF, vbase, t) do { _Pragma("unroll") for (int cb = 0; cb < 8; ++cb) { \
      const int r0_ = 32 * (t) + 4 * g + tq, r1_ = r0_ + 16; \
      VF[cb][0] = vtr((vbase) + 256 * r0_ + 32 * (cb ^ (r0_ & 7)) + 8 * tp); VF[cb][1] = vtr((vbase) + 256 * r1_ + 32 * (cb ^ (r1_ & 7)) + 8 * tp); } } while (0)
#define PVB(VF, t) do { _Pragma("unroll") for (int cb = 0; cb < 8; ++cb) { const bf16x8 vf_ = (bf16x8){VF[cb][0][0], VF[cb][0][1], VF[cb][0][2], VF[cb][0][3], VF[cb][1][0], VF[cb][1][1], VF[cb][1][2], VF[cb][1][3]}; \
      o[0][cb] = __builtin_amdgcn_mfma_f32_16x16x32_bf16(pa[0][t], vf_, o[0][cb], 0, 0, 0); \
      o[1][cb] = __builtin_amdgcn_mfma_f32_16x16x32_bf16(pa[1][t], vf_, o[1][cb], 0, 0, 0); } } while (0)
#define MSEG(tqi, tv, DO_QK) do { const LAS char* vbp_ = V_lds + ((tv) & 1) * TILE_B; const LAS char* kbp_ = K_lds + ((tqi) & 1) * TILE_B; \
    s16x4 va[8][2], vb[8][2]; bf16x8 ka[2][2][2], kc[2][2][2]; \
    VRD(va, vbp_, 0); SBAR(); \
    VRD(vb, vbp_, 1); PVB(va, 0); SBAR(); \
    if (DO_QK) KRD(ka, kbp_, 0); PVB(vb, 1); SBAR(); \
    if (DO_QK) { KRD(kc, kbp_, 2); QKM(ka, 0); SBAR(); QKM(kc, 2); } } while (0)
#define SMSEG(FIRST) do { \
    _Pragma("unroll") for (int m = 0; m < 2; ++m) { asm volatile("" : "+v"(s[m][0]), "+v"(s[m][1]), "+v"(s[m][2]), "+v"(s[m][3])); \
      bool resc_; float dl; \
      if (FIRST) { float mx = fmaxf(fmaxf(s[m][0][0], s[m][0][1]), fmaxf(s[m][0][2], s[m][0][3])); \
        _Pragma("unroll") for (int kb = 1; kb < 4; ++kb) mx = fmaxf(mx, fmaxf(fmaxf(s[m][kb][0], s[m][kb][1]), fmaxf(s[m][kb][2], s[m][kb][3]))); \
        dl = xmax4(mx); resc_ = true; \
      } else {       \
        int im = max(max(__float_as_int(s[m][0][0]), __float_as_int(s[m][0][1])), max(__float_as_int(s[m][0][2]), __float_as_int(s[m][0][3]))); \
        _Pragma("unroll") for (int kb = 1; kb < 4; ++kb) im = max(im, max(max(__float_as_int(s[m][kb][0]), __float_as_int(s[m][kb][1])), max(__float_as_int(s[m][kb][2]), __float_as_int(s[m][kb][3])))); \
        im = xmaxi4(im); resc_ = __builtin_expect(__any(im > 0x41000000  ), 0); dl = __int_as_float(max(im, 0)); } \
      if (resc_) { \
        _Pragma("unroll") for (int kb = 0; kb < 4; ++kb) s[m][kb] = s[m][kb] - dl; \
        negm[m] -= dl; \
        if (!(FIRST)) { const float al = __builtin_amdgcn_exp2f(-dl); l_reg[m] *= al; if (g == 0) ws[16 * m + i16] = al; \
          const f32x4 a4 = *(const LAS f32x4*)(ws + 16 * m + 4 * g); \
          _Pragma("unroll") for (int cb = 0; cb < 8; ++cb) o[m][cb] = o[m][cb] * a4; } } \
      f32x4 e4_ = {0.f, 0.f, 0.f, 0.f}; \
      _Pragma("unroll") for (int kb = 0; kb < 4; ++kb) { _Pragma("unroll") for (int r = 0; r < 4; ++r) s[m][kb][r] = __builtin_amdgcn_exp2f(s[m][kb][r]); e4_ += s[m][kb]; }        \
      const float ps = (e4_[0] + e4_[1]) + (e4_[2] + e4_[3]); \
      l_reg[m] += xsum4(ps); \
      _Pragma("unroll") for (int t = 0; t < 2; ++t) { u32x4 w_; w_.x = cvt_pk_bf16(s[m][2 * t][0], s[m][2 * t][1]); w_.y = cvt_pk_bf16(s[m][2 * t][2], s[m][2 * t][3]); \
        w_.z = cvt_pk_bf16(s[m][2 * t + 1][0], s[m][2 * t + 1][1]); w_.w = cvt_pk_bf16(s[m][2 * t + 1][2], s[m][2 * t + 1][3]); pa[m][t] = __builtin_bit_cast(bf16x8, w_); } } } while (0)
#define BAR() __syncthreads()
  LOADK(0); LOADV(0); WRITEK(0); WRITEV(0); LOADK(1); WRITEK(1);
  if (2 < NT) LOADK(2); LOADV(1);
  BAR();
  { bf16x8 ka[2][2][2], kc[2][2][2]; KRD(ka, K_lds, 0); KRD(kc, K_lds, 2); QKM(ka, 0); QKM(kc, 2); } SMSEG(true);
  BAR();
  if (half == 0) {
    for (int n = 0; n + 1 < NT; ++n) {
      SBAR(); MSEG(n + 1, n, true); SBAR(); BAR();
      SMSEG(false); if (n + 2 < NT) WRITEK(n + 2); WRITEV(n + 1); if (n + 3 < NT) LOADK(n + 3); if (n + 2 < NT) LOADV(n + 2); SBAR(); BAR();
    }
    MSEG(0, NT - 1, false); BAR(); BAR();
  } else {
    if (2 < NT) WRITEK(2); WRITEV(1); if (3 < NT) LOADK(3); if (2 < NT) LOADV(2); BAR();
    for (int n = 0; n + 1 < NT; ++n) {
      SBAR(); MSEG(n + 1, n, true); SBAR(); BAR();
      SMSEG(false); if (n + 3 < NT) WRITEK(n + 3); if (n + 2 < NT) WRITEV(n + 2); if (n + 4 < NT) LOADK(n + 4); if (n + 3 < NT) LOADV(n + 3); SBAR(); BAR();
    }
    MSEG(0, NT - 1, false); BAR();
  }
  if (g == 0) { ws[i16] = __builtin_amdgcn_rcpf(l_reg[0]); ws[16 + i16] = lam * __builtin_amdgcn_rcpf(l_reg[1]); }
  const f32x4 il0 = *(const LAS f32x4*)(ws + 4 * g), il1 = *(const LAS f32x4*)(ws + 16 + 4 * g);
  f32x4 ss = (f32x4){0.f, 0.f, 0.f, 0.f};
#pragma unroll
  for (int cb = 0; cb < 8; ++cb) { o[0][cb] = o[0][cb] * il0 - o[1][cb] * il1; ss = ss + o[0][cb] * o[0][cb]; }
  f32x4 rs;
#pragma unroll
  for (int r = 0; r < 4; ++r) rs[r] = 0.8f / sqrtf(sum16(ss[r]) * (1.f / 128.f) + EPS);
  bf16_t* Aw = An + (long)(wid * 16 + 4 * g) * 1024 + i16;
#pragma unroll
  for (int cb = 0; cb < 8; ++cb) { const float gn = subln[16 * cb + i16];
#pragma unroll
    for (int r = 0; r < 4; ++r) Aw[(long)r * 1024 + 16 * cb] = (bf16_t)(cvt_pk_bf16(o[0][cb][r] * rs[r] * gn, 0.f) & 0xffffu); }
  BAR();
#undef LOADK
#undef LOADV
#undef WRITEK
#undef WRITEV
#undef KRD
#undef QKM
#undef VRD
#undef PVB
#undef MSEG
#undef SMSEG
#undef BAR
}
#undef SBAR
}
__device__ __forceinline__ void dsincos(double x, double& s, double& c) {
    const double k = __builtin_rint(x * 0.15915494309189535);
    double r = __builtin_fma(-k, 6.283185307179586, x); r = __builtin_fma(-k, 2.4492935982947064e-16, r);
    const double r2 = r * r;
    double ps = 1.1309962886447718e-31;
    ps = ps * r2 - 9.183689863795546e-29;
    ps = ps * r2 + 6.446950284384474e-26;
    ps = ps * r2 - 3.8681701706306835e-23;
    ps = ps * r2 + 1.9572941063391263e-20;
    ps = ps * r2 - 8.22063524662433e-18;
    ps = ps * r2 + 2.8114572543455206e-15;
    ps = ps * r2 - 7.647163731819816e-13;
    ps = ps * r2 + 1.6059043836821613e-10;
    ps = ps * r2 - 2.505210838544172e-08;
    ps = ps * r2 + 2.7557319223985893e-06;
    ps = ps * r2 - 0.0001984126984126984;
    ps = ps * r2 + 0.008333333333333333;
    ps = ps * r2 - 0.16666666666666666;
    s = r + r * r2 * ps;
    double pc = -3.7699876288159054e-33;
    pc = pc * r2 + 3.279889237069838e-30;
    pc = pc * r2 - 2.4795962632247972e-27;
    pc = pc * r2 + 1.6117375710961184e-24;
    pc = pc * r2 - 8.896791392450574e-22;
    pc = pc * r2 + 4.110317623312165e-19;
    pc = pc * r2 - 1.5619206968586225e-16;
    pc = pc * r2 + 4.779477332387385e-14;
    pc = pc * r2 - 1.1470745597729725e-11;
    pc = pc * r2 + 2.08767569878681e-09;
    pc = pc * r2 - 2.755731922398589e-07;
    pc = pc * r2 + 2.48015873015873e-05;
    pc = pc * r2 - 0.001388888888888889;
    pc = pc * r2 + 0.041666666666666664;
    pc = pc * r2 - 0.5;
    c = 1.0 + r2 * pc;
}
__device__ __forceinline__ double dexp(double x) {
    const double k = __builtin_rint(x * 1.4426950408889634);
    double r = __builtin_fma(-k, 0.6931471805599453, x); r = __builtin_fma(-k, 2.3190468138462996e-17, r);
    double p = 1.6059043836821613e-10;
    p = p * r + 2.08767569878681e-09; p = p * r + 2.505210838544172e-08; p = p * r + 2.755731922398589e-07; p = p * r + 2.7557319223985893e-06; p = p * r + 2.48015873015873e-05;
    p = p * r + 0.0001984126984126984; p = p * r + 0.001388888888888889; p = p * r + 0.008333333333333333; p = p * r + 0.041666666666666664; p = p * r + 0.16666666666666666; p = p * r + 0.5; p = p * r + 1.0; p = p * r + 1.0;
    const long long bits = ((long long)k + 1023LL) << 52;
    return p * __builtin_bit_cast(double, bits);
}

__device__ __forceinline__ void rms_row_bf16(const float* xrow, const float* gain, bf16_t* orow, int lane) {
    const f32x4* xr = (const f32x4*)xrow + lane; const f32x4* gr = (const f32x4*)gain + lane;
    f32x4 v[8]; float s = 0.f;
#pragma unroll
    for (int j = 0; j < 8; ++j) { v[j] = xr[64 * j]; s += (v[j].x * v[j].x + v[j].y * v[j].y) + (v[j].z * v[j].z + v[j].w * v[j].w); }
    f32x4 gv[8];
#pragma unroll
    for (int j = 0; j < 8; ++j) gv[j] = gr[64 * j];
    const float rs = 1.0f / sqrtf(wave_sum(s) * (1.f / DM) + EPS);
    u32x2* o8 = (u32x2*)orow + lane;
#pragma unroll
    for (int j = 0; j < 8; ++j) { const f32x4 g = gv[j]; u32x2 w; w.x = cvt_pk_bf16(v[j].x * rs * g.x, v[j].y * rs * g.y); w.y = cvt_pk_bf16(v[j].z * rs * g.z, v[j].w * rs * g.w); o8[64 * j] = w; }
}
__device__ __forceinline__ void rms_row2_bf16(const float* xrow0, const float* xrow1, const float* gain, bf16_t* orow0, bf16_t* orow1, int lane) {
    const f32x4* xa = (const f32x4*)xrow0 + lane; const f32x4* xb = (const f32x4*)xrow1 + lane; const f32x4* gr = (const f32x4*)gain + lane;
    f32x4 va[8], vb[8]; float sa = 0.f, sb = 0.f;
#pragma unroll
    for (int j = 0; j < 8; ++j) { va[j] = xa[64 * j]; vb[j] = xb[64 * j]; }
    f32x4 gv[8];
#pragma unroll
    for (int j = 0; j < 8; ++j) gv[j] = gr[64 * j];
#pragma unroll
    for (int j = 0; j < 8; ++j) { sa += (va[j].x * va[j].x + va[j].y * va[j].y) + (va[j].z * va[j].z + va[j].w * va[j].w); sb += (vb[j].x * vb[j].x + vb[j].y * vb[j].y) + (vb[j].z * vb[j].z + vb[j].w * vb[j].w); }
    const float ra = 1.0f / sqrtf(wave_sum(sa) * (1.f / DM) + EPS), rb = 1.0f / sqrtf(wave_sum(sb) * (1.f / DM) + EPS);
    u32x2* oa = (u32x2*)orow0 + lane; u32x2* ob = (u32x2*)orow1 + lane;
#pragma unroll
    for (int j = 0; j < 8; ++j) { const f32x4 g = gv[j]; u32x2 w;
        w.x = cvt_pk_bf16(va[j].x * ra * g.x, va[j].y * ra * g.y); w.y = cvt_pk_bf16(va[j].z * ra * g.z, va[j].w * ra * g.w); oa[64 * j] = w;
        w.x = cvt_pk_bf16(vb[j].x * rb * g.x, vb[j].y * rb * g.y); w.y = cvt_pk_bf16(vb[j].z * rb * g.z, vb[j].w * rb * g.w); ob[64 * j] = w; }
}
__device__ __forceinline__ void rms_row2_bf16_xr(const float* xrow0, const float* xrow1, const float* gain, bf16_t* orow0, bf16_t* orow1, bf16_t* rrow0, bf16_t* rrow1, int lane) {
    const f32x4* xa = (const f32x4*)xrow0 + lane; const f32x4* xb = (const f32x4*)xrow1 + lane; const f32x4* gr = (const f32x4*)gain + lane;
    f32x4 va[8], vb[8]; float sa = 0.f, sb = 0.f;
#pragma unroll
    for (int j = 0; j < 8; ++j) { va[j] = xa[64 * j]; vb[j] = xb[64 * j]; }
    f32x4 gv[8];
#pragma unroll
    for (int j = 0; j < 8; ++j) gv[j] = gr[64 * j];
#pragma unroll
    for (int j = 0; j < 8; ++j) { sa += (va[j].x * va[j].x + va[j].y * va[j].y) + (va[j].z * va[j].z + va[j].w * va[j].w); sb += (vb[j].x * vb[j].x + vb[j].y * vb[j].y) + (vb[j].z * vb[j].z + vb[j].w * vb[j].w); }
    const float ra = 1.0f / sqrtf(wave_sum(sa) * (1.f / DM) + EPS), rb = 1.0f / sqrtf(wave_sum(sb) * (1.f / DM) + EPS);
    u32x2* oa = (u32x2*)orow0 + lane; u32x2* ob = (u32x2*)orow1 + lane; u32x2* qa = (u32x2*)rrow0 + lane; u32x2* qb = (u32x2*)rrow1 + lane;
#pragma unroll
    for (int j = 0; j < 8; ++j) { const f32x4 g = gv[j]; u32x2 w;
        w.x = cvt_pk_bf16(va[j].x * ra * g.x, va[j].y * ra * g.y); w.y = cvt_pk_bf16(va[j].z * ra * g.z, va[j].w * ra * g.w); oa[64 * j] = w;
        w.x = cvt_pk_bf16(vb[j].x * rb * g.x, vb[j].y * rb * g.y); w.y = cvt_pk_bf16(vb[j].z * rb * g.z, vb[j].w * rb * g.w); ob[64 * j] = w;
        w.x = cvt_pk_bf16(va[j].x, va[j].y); w.y = cvt_pk_bf16(va[j].z, va[j].w); qa[64 * j] = w;
        w.x = cvt_pk_bf16(vb[j].x, vb[j].y); w.y = cvt_pk_bf16(vb[j].z, vb[j].w); qb[64 * j] = w; }
}
__device__ __forceinline__ void rms_row_f32_inplace(float* xrow, const float* gain, int lane) {
    f32x4* xr = (f32x4*)xrow + lane; const f32x4* gr = (const f32x4*)gain + lane;
    f32x4 v[8]; float s = 0.f;
#pragma unroll
    for (int j = 0; j < 8; ++j) { v[j] = xr[64 * j]; s += (v[j].x * v[j].x + v[j].y * v[j].y) + (v[j].z * v[j].z + v[j].w * v[j].w); }
    const float rs = 1.0f / sqrtf(wave_sum(s) * (1.f / DM) + EPS);
#pragma unroll
    for (int j = 0; j < 8; ++j) { const f32x4 g = gr[64 * j]; xr[64 * j] = v[j] * rs * g; }
}
__device__ __forceinline__ void rms_row_f32_ss(float* xrow, const float* gain, float ss, int lane) {
    f32x4* xr = (f32x4*)xrow + lane; const f32x4* gr = (const f32x4*)gain + lane;
    const float rs = 1.0f / sqrtf(ss * (1.f / DM) + EPS);
#pragma unroll
    for (int j = 0; j < 8; ++j) { const f32x4 g = gr[64 * j]; xr[64 * j] = xr[64 * j] * rs * g; }
}
__device__ __forceinline__ void final_norm_rows(float* out, const float* gain, const float* SS, int gp, int Mp, int gw, int NGW, int lane) {
    const f32x4* gr = (const f32x4*)gain + lane; f32x4 gv[8];
#pragma unroll
    for (int j = 0; j < 8; ++j) gv[j] = gr[64 * j];
    for (int m = gw; m < Mp; m += 2 * NGW) { const int m2 = (m + NGW < Mp) ? m + NGW : m;
        f32x4* xa = (f32x4*)(out + (size_t)(gp + m) * DM) + lane; f32x4* xb = (f32x4*)(out + (size_t)(gp + m2) * DM) + lane;
        const u32x2* ba = (const u32x2*)(out + (size_t)(gp + m) * DM) + lane; const u32x2* bb = (const u32x2*)(out + (size_t)(gp + m2) * DM) + lane;
        const float ssa = SS[gp + m], ssb = SS[gp + m2]; u32x2 wa[8], wb[8];
#pragma unroll
        for (int j = 0; j < 8; ++j) { wa[j] = ba[64 * j]; wb[j] = bb[64 * j]; }
        const float ra = 1.0f / sqrtf(ssa * (1.f / DM) + EPS), rb = 1.0f / sqrtf(ssb * (1.f / DM) + EPS);
        f32x4 va[8], vb[8];
#pragma unroll
        for (int j = 0; j < 8; ++j) { va[j][0] = bf_lo(wa[j].x); va[j][1] = bf_hi(wa[j].x); va[j][2] = bf_lo(wa[j].y); va[j][3] = bf_hi(wa[j].y);
            vb[j][0] = bf_lo(wb[j].x); vb[j][1] = bf_hi(wb[j].x); vb[j][2] = bf_lo(wb[j].y); vb[j][3] = bf_hi(wb[j].y); }
        if (m2 != m) {
#pragma unroll
            for (int j = 0; j < 8; ++j) { xa[64 * j] = va[j] * ra * gv[j]; xb[64 * j] = vb[j] * rb * gv[j]; }
        } else {
#pragma unroll
            for (int j = 0; j < 8; ++j) xa[64 * j] = va[j] * ra * gv[j];
        } }
}
__device__ __forceinline__ void attn_combine_row(const bf16_t* od, const float* subln, float lam, bf16_t* an, int lane) {
    const u32x4* p0 = (const u32x4*)(od + lane * 16); const u32x4* p1 = (const u32x4*)(od + 1024 + lane * 16);
    const u32x4 a0 = p0[0], a1 = p0[1], b0 = p1[0], b1 = p1[1];
    float d[16];
    const unsigned aw[8] = {a0.x, a0.y, a0.z, a0.w, a1.x, a1.y, a1.z, a1.w}, bw[8] = {b0.x, b0.y, b0.z, b0.w, b1.x, b1.y, b1.z, b1.w};
    float ss = 0.f;
#pragma unroll
    for (int i = 0; i < 8; ++i) { d[2 * i] = bf_lo(aw[i]) - lam * bf_lo(bw[i]); d[2 * i + 1] = bf_hi(aw[i]) - lam * bf_hi(bw[i]); ss += d[2 * i] * d[2 * i] + d[2 * i + 1] * d[2 * i + 1]; }
    ss = sum8(ss);
    const float rs = 0.8f / sqrtf(ss * (1.f / 128.f) + EPS);
    const float* g = subln + (lane & 7) * 16;
    u32x4 w0, w1;
    w0.x = cvt_pk_bf16(d[0] * rs * g[0], d[1] * rs * g[1]); w0.y = cvt_pk_bf16(d[2] * rs * g[2], d[3] * rs * g[3]); w0.z = cvt_pk_bf16(d[4] * rs * g[4], d[5] * rs * g[5]); w0.w = cvt_pk_bf16(d[6] * rs * g[6], d[7] * rs * g[7]);
    w1.x = cvt_pk_bf16(d[8] * rs * g[8], d[9] * rs * g[9]); w1.y = cvt_pk_bf16(d[10] * rs * g[10], d[11] * rs * g[11]); w1.z = cvt_pk_bf16(d[12] * rs * g[12], d[13] * rs * g[13]); w1.w = cvt_pk_bf16(d[14] * rs * g[14], d[15] * rs * g[15]);
    u32x4* o = (u32x4*)(an + lane * 16); o[0] = w0; o[1] = w1;
}
__device__ __forceinline__ void xsoftmax_head(const float* sc, bf16_t* prow, int l16) {
    const f32x4* sp = (const f32x4*)(sc + l16 * 16); f32x4 v[4]; float mx = -3.0e38f;
#pragma unroll
    for (int q = 0; q < 4; ++q) { v[q] = sp[q]; mx = fmaxf(mx, fmaxf(fmaxf(v[q].x, v[q].y), fmaxf(v[q].z, v[q].w))); }
    mx = max16(mx);
    float s = 0.f;
#pragma unroll
    for (int q = 0; q < 4; ++q) { v[q].x = __expf(v[q].x - mx); v[q].y = __expf(v[q].y - mx); v[q].z = __expf(v[q].z - mx); v[q].w = __expf(v[q].w - mx); s += (v[q].x + v[q].y) + (v[q].z + v[q].w); }
    s = sum16(s);
    const float inv = 1.0f / s;
    u32x4 w0, w1;
    w0.x = cvt_pk_bf16(v[0].x * inv, v[0].y * inv); w0.y = cvt_pk_bf16(v[0].z * inv, v[0].w * inv); w0.z = cvt_pk_bf16(v[1].x * inv, v[1].y * inv); w0.w = cvt_pk_bf16(v[1].z * inv, v[1].w * inv);
    w1.x = cvt_pk_bf16(v[2].x * inv, v[2].y * inv); w1.y = cvt_pk_bf16(v[2].z * inv, v[2].w * inv); w1.z = cvt_pk_bf16(v[3].x * inv, v[3].y * inv); w1.w = cvt_pk_bf16(v[3].z * inv, v[3].w * inv);
    u32x4* o = (u32x4*)(prow + l16 * 16); o[0] = w0; o[1] = w1;
}
__device__ __forceinline__ void xsoftmax_head2_bf16(const bf16_t* sc0, bf16_t* p0, const bf16_t* sc1, bf16_t* p1, int l16) {
    const u32x4* s0 = (const u32x4*)(sc0 + l16 * 16); const u32x4* s1 = (const u32x4*)(sc1 + l16 * 16);
    const u32x4 a0 = s0[0], a1 = s0[1], b0 = s1[0], b1 = s1[1];
    const unsigned aw[8] = {a0.x, a0.y, a0.z, a0.w, a1.x, a1.y, a1.z, a1.w}, bw[8] = {b0.x, b0.y, b0.z, b0.w, b1.x, b1.y, b1.z, b1.w};
    float va[16], vb[16]; float ma = -3.0e38f, mb = -3.0e38f;
#pragma unroll
    for (int i = 0; i < 8; ++i) { va[2 * i] = bf_lo(aw[i]); va[2 * i + 1] = bf_hi(aw[i]); vb[2 * i] = bf_lo(bw[i]); vb[2 * i + 1] = bf_hi(bw[i]);
        ma = fmaxf(ma, fmaxf(va[2 * i], va[2 * i + 1])); mb = fmaxf(mb, fmaxf(vb[2 * i], vb[2 * i + 1])); }
    ma = max16(ma); mb = max16(mb);
    float sa = 0.f, sb = 0.f;
#pragma unroll
    for (int i = 0; i < 16; ++i) { va[i] = __expf(va[i] - ma); vb[i] = __expf(vb[i] - mb); sa += va[i]; sb += vb[i]; }
    sa = sum16(sa); sb = sum16(sb);
    const float ia = 1.0f / sa, ib = 1.0f / sb;
    u32x4 w0, w1;
    w0.x = cvt_pk_bf16(va[0] * ia, va[1] * ia); w0.y = cvt_pk_bf16(va[2] * ia, va[3] * ia); w0.z = cvt_pk_bf16(va[4] * ia, va[5] * ia); w0.w = cvt_pk_bf16(va[6] * ia, va[7] * ia);
    w1.x = cvt_pk_bf16(va[8] * ia, va[9] * ia); w1.y = cvt_pk_bf16(va[10] * ia, va[11] * ia); w1.z = cvt_pk_bf16(va[12] * ia, va[13] * ia); w1.w = cvt_pk_bf16(va[14] * ia, va[15] * ia);
    { u32x4* o = (u32x4*)(p0 + l16 * 16); o[0] = w0; o[1] = w1; }
    w0.x = cvt_pk_bf16(vb[0] * ib, vb[1] * ib); w0.y = cvt_pk_bf16(vb[2] * ib, vb[3] * ib); w0.z = cvt_pk_bf16(vb[4] * ib, vb[5] * ib); w0.w = cvt_pk_bf16(vb[6] * ib, vb[7] * ib);
    w1.x = cvt_pk_bf16(vb[8] * ib, vb[9] * ib); w1.y = cvt_pk_bf16(vb[10] * ib, vb[11] * ib); w1.z = cvt_pk_bf16(vb[12] * ib, vb[13] * ib); w1.w = cvt_pk_bf16(vb[14] * ib, vb[15] * ib);
    { u32x4* o = (u32x4*)(p1 + l16 * 16); o[0] = w0; o[1] = w1; }
}
__device__ __forceinline__ void xsoftmax_row(const float* sc, bf16_t* prow, int lane) {
    const f32x4* sp = (const f32x4*)(sc + lane * 16); f32x4 v[4]; float mx = -3.0e38f;
#pragma unroll
    for (int q = 0; q < 4; ++q) { v[q] = sp[q]; mx = fmaxf(mx, fmaxf(fmaxf(v[q].x, v[q].y), fmaxf(v[q].z, v[q].w))); }
    mx = max16(mx);
    float s = 0.f;
#pragma unroll
    for (int q = 0; q < 4; ++q) { v[q].x = __expf(v[q].x - mx); v[q].y = __expf(v[q].y - mx); v[q].z = __expf(v[q].z - mx); v[q].w = __expf(v[q].w - mx); s += (v[q].x + v[q].y) + (v[q].z + v[q].w); }
    s = sum16(s);
    const float inv = 1.0f / s;
    u32x4 w0, w1;
    w0.x = cvt_pk_bf16(v[0].x * inv, v[0].y * inv); w0.y = cvt_pk_bf16(v[0].z * inv, v[0].w * inv); w0.z = cvt_pk_bf16(v[1].x * inv, v[1].y * inv); w0.w = cvt_pk_bf16(v[1].z * inv, v[1].w * inv);
    w1.x = cvt_pk_bf16(v[2].x * inv, v[2].y * inv); w1.y = cvt_pk_bf16(v[2].z * inv, v[2].w * inv); w1.z = cvt_pk_bf16(v[3].x * inv, v[3].y * inv); w1.w = cvt_pk_bf16(v[3].z * inv, v[3].w * inv);
    u32x4* o = (u32x4*)(prow + lane * 16); o[0] = w0; o[1] = w1;
}

constexpr int SSM_T = 32, NCH = 512;
struct SsmParams { const float *lre, *lim, *ldt, *bre, *bim, *cre, *cim; };
__device__ __forceinline__ void ssm_discretise(const SsmParams& P, int idx, float* SBB, float* APOW) {
    const int dg = idx >> 6;
    const double lr = (double)P.lre[idx], li = (double)P.lim[idx];
    const double dt = dexp((double)P.ldt[dg]);
    const double mag = dexp(lr * dt); double sn, cs; dsincos(li * dt, sn, cs);
    const double abr = mag * cs, abi = mag * sn, den = lr * lr + li * li, nr = abr - 1.0, ni = abi;
    const double kr = (nr * lr + ni * li) / den, ki = (ni * lr - nr * li) / den;
#pragma unroll
    for (int c = 0; c < 16; ++c) { const double br = (double)P.bre[idx * 16 + c], bi = (double)P.bim[idx * 16 + c];
        SBB[(idx * 16 + c) * 2] = (float)(kr * br - ki * bi); SBB[(idx * 16 + c) * 2 + 1] = (float)(kr * bi + ki * br); }
    double pr = 1.0, pi = 0.0;
    for (int t = 0; t <= SSM_T; ++t) { APOW[(idx * 33 + t) * 2] = (float)pr; APOW[(idx * 33 + t) * 2 + 1] = (float)pi; const double nr2 = pr * abr - pi * abi, ni2 = pr * abi + pi * abr; pr = nr2; pi = ni2; }
}
__device__ __forceinline__ void ssm_w1_item(int item, const float* SBB, const float* APOW, bf16_t* W1) {
    const int k8 = item & 63, n = (item >> 6) & 255, g = item >> 14, d = n >> 7, q = n & 127, p = q & 63, isim = q >> 6, j = k8 >> 1, c0 = (k8 & 1) * 8;
    const int idx = (d * 64 + g) * 64 + p, e = d ? j : (SSM_T - 1 - j);
    const float ar = APOW[(idx * 33 + e) * 2], ai = APOW[(idx * 33 + e) * 2 + 1];
    float v[8];
#pragma unroll
    for (int c = 0; c < 8; ++c) { const float br = SBB[(idx * 16 + c0 + c) * 2], bi = SBB[(idx * 16 + c0 + c) * 2 + 1]; v[c] = isim ? (ar * bi + ai * br) : (ar * br - ai * bi); }
    u32x4 w; w.x = cvt_pk_bf16(v[0], v[1]); w.y = cvt_pk_bf16(v[2], v[3]); w.z = cvt_pk_bf16(v[4], v[5]); w.w = cvt_pk_bf16(v[6], v[7]);
    *(u32x4*)(W1 + ((size_t)(g * 256 + n) * 512 + k8 * 8)) = w;
}
__device__ __forceinline__ void ssm_kfb_item(int item, const float* SBB, const float* APOW, const float* cre, const float* cim, float* KFB) {
    const int c = item & 15, ch = (item >> 4) & 15, tau = (item >> 8) & 31, d = (item >> 13) & 1, g = item >> 14;
    float acc = 0.f;
    for (int p = 0; p < 64; ++p) { const int idx = (d * 64 + g) * 64 + p;
        const float ar = APOW[(idx * 33 + tau) * 2], ai = APOW[(idx * 33 + tau) * 2 + 1], br = SBB[(idx * 16 + c) * 2], bi = SBB[(idx * 16 + c) * 2 + 1];
        const float tr = ar * br - ai * bi, ti = ar * bi + ai * br;
        acc += cre[((d * 64 + g) * 16 + ch) * 64 + p] * tr - cim[((d * 64 + g) * 16 + ch) * 64 + p] * ti; }
    KFB[item] = acc;
}
__device__ __forceinline__ void ssm_kfb_wave(int wid, int lane, const float* SBB, const float* APOW, const float* cre, const float* cim, float* KFB) {
    const int qc = wid & 3, to = (wid >> 2) & 3, d = (wid >> 4) & 1, g = wid >> 5, e = qc * 64 + lane, c = e & 15, ch = e >> 4, base = (d * 64 + g) * 64;
    float acc[8];
#pragma unroll
    for (int t = 0; t < 8; ++t) acc[t] = 0.f;
    const float* crp = cre + ((size_t)(d * 64 + g) * 16 + ch) * 64; const float* cip = cim + ((size_t)(d * 64 + g) * 16 + ch) * 64;
#pragma unroll 4
    for (int p = 0; p < 64; ++p) { const int idx = base + p;
        const f32x2 b = *(const f32x2*)(SBB + (size_t)(idx * 16 + c) * 2); const float cr = crp[p], ci = cip[p];
        const float wr = cr * b.x - ci * b.y, wi = cr * b.y + ci * b.x;
        const f32x2* ap = (const f32x2*)(APOW + (size_t)(idx * 33 + to * 8) * 2);
#pragma unroll
        for (int t = 0; t < 8; ++t) { const f32x2 a = ap[t]; acc[t] += a.x * wr - a.y * wi; } }
#pragma unroll
    for (int t = 0; t < 8; ++t) KFB[(size_t)(((g * 2 + d) * 32 + to * 8 + t) * 256) + e] = acc[t];
}
__device__ __forceinline__ void ssm_w3_item(int item, const float* APOW, const float* KFB, const float* cre, const float* cim, const float* dsk, bf16_t* W3) {
    const int k8 = item % 96, n = (item / 96) & 511, g = item / (96 * 512), j = n >> 4, ch = n & 15;
    float v[8];
    if (k8 < 64) { const int i = k8 >> 1, c0 = (k8 & 1) * 8;
#pragma unroll
        for (int c = 0; c < 8; ++c) v[c] = 0.f;
        if (i <= j) { const float* kf = KFB + (((g * 2 + 0) * 32 + (j - i)) * 256 + ch * 16 + c0);
#pragma unroll
            for (int c = 0; c < 8; ++c) v[c] += kf[c]; }
        if (i >= j) { const float* kb = KFB + (((g * 2 + 1) * 32 + (i - j)) * 256 + ch * 16 + c0);
#pragma unroll
            for (int c = 0; c < 8; ++c) v[c] += kb[c]; }
        if (i == j && (ch >> 3) == (c0 >> 3)) {
#pragma unroll
            for (int c = 0; c < 8; ++c) v[c] += (c0 + c == ch) ? dsk[g * 16 + ch] : 0.f; }
    } else { const int kk = (k8 - 64) * 8, d = kk >> 7, q0 = kk & 127, isim = q0 >> 6, p0 = q0 & 63, pw = d ? (SSM_T - j) : (j + 1);
#pragma unroll
        for (int c = 0; c < 8; ++c) { const int p = p0 + c, idx = (d * 64 + g) * 64 + p;
            const float ar = APOW[(idx * 33 + pw) * 2], ai = APOW[(idx * 33 + pw) * 2 + 1], cr = cre[((d * 64 + g) * 16 + ch) * 64 + p], ci = cim[((d * 64 + g) * 16 + ch) * 64 + p];
            v[c] = isim ? -(cr * ai + ci * ar) : (cr * ar - ci * ai); } }
    u32x4 w; w.x = cvt_pk_bf16(v[0], v[1]); w.y = cvt_pk_bf16(v[2], v[3]); w.z = cvt_pk_bf16(v[4], v[5]); w.w = cvt_pk_bf16(v[6], v[7]);
    *(u32x4*)(W3 + ((size_t)(g * 512 + n) * 768 + k8 * 8)) = w;
}
__device__ __forceinline__ void ssm_carry_wave(const float* APOW, const float* CS, bf16_t* A3, int d, int g, int chunk0, int ncs, int lane) {
    const int p = lane, idx = (d * 64 + g) * 64 + p;
    const float atr = APOW[(idx * 33 + SSM_T) * 2], ati = APOW[(idx * 33 + SSM_T) * 2 + 1];
    float xr = 0.f, xi = 0.f;
    const float* cs = CS + ((size_t)(g * NCH + chunk0) * 256 + d * 128 + p);
    bf16_t* a3 = A3 + ((size_t)(g * NCH + chunk0) * 768 + 512 + d * 128 + p);
    for (int cc = 0; cc < ncs; cc += 32) {
        float sr[32], si[32];
#pragma unroll
        for (int e = 0; e < 32; ++e) { const int c = d ? (ncs - 1 - (cc + e)) : (cc + e); sr[e] = cs[(size_t)c * 256]; si[e] = cs[(size_t)c * 256 + 64]; }
#pragma unroll
        for (int e = 0; e < 32; ++e) { const int c = d ? (ncs - 1 - (cc + e)) : (cc + e);
            a3[(size_t)c * 768] = (bf16_t)(cvt_pk_bf16(xr, 0.f) & 0xffffu); a3[(size_t)c * 768 + 64] = (bf16_t)(cvt_pk_bf16(xi, 0.f) & 0xffffu);
            const float nr = atr * xr - ati * xi + sr[e], ni = atr * xi + ati * xr + si[e]; xr = nr; xi = ni; }
    }
}
constexpr int NWAVES = 8;
#ifndef WGM_WIDE
#define WGM_WIDE 4
#endif
#ifndef MK_PER_PHASE
#define MK_PER_PHASE 0
#endif
constexpr int NG = 3;
constexpr int MAXG = 16384;
constexpr int NPH_G = 9, NPH0 = 1, NPH = NPH0 + NG * NPH_G + 1;

constexpr size_t MiB = 1u << 20;
constexpr size_t WS_CTL = 0, CTL_ZERO_BYTES = 1 * MiB;
constexpr size_t WS_ROPE = 1 * MiB;
constexpr size_t WS_SBB = 4 * MiB;
constexpr size_t WS_WIN = 5 * MiB;
constexpr size_t WS_WAP = WS_WIN + 32 * MiB;
constexpr size_t WS_WGLU = WS_WAP + 4 * MiB;
constexpr size_t WS_WMO = WS_WGLU + 8 * MiB;
constexpr size_t WS_WQC = WS_WMO + 8 * MiB;
constexpr size_t WS_WKV = WS_WQC + 8 * MiB;
constexpr size_t WS_WOC = WS_WKV + 16 * MiB;
constexpr size_t WS_WUP = WS_WOC + 8 * MiB;
constexpr size_t WS_WDN = WS_WUP + 32 * MiB;
constexpr size_t WS_MN = WS_WDN + 32 * MiB;
constexpr size_t WS_KVM = WS_MN + 8 * MiB;
constexpr size_t WS_XN = WS_KVM + 16 * MiB;
constexpr size_t WS_QKVU = WS_XN + 64 * MiB;
constexpr size_t WS_GATES = WS_QKVU + 128 * MiB;
constexpr size_t WS_H = WS_QKVU;
constexpr size_t WS_OD = WS_GATES + 128 * MiB;
constexpr size_t WS_OC = WS_OD;
constexpr size_t WS_AN = WS_OD + 64 * MiB;
constexpr size_t WS_Z = WS_AN + 32 * MiB;
constexpr size_t WS_MIX = WS_Z + 32 * MiB;
constexpr size_t WS_TQ = WS_MIX + 64 * MiB;
constexpr size_t WS_TVT = WS_TQ + 32 * MiB;
constexpr size_t WS_QC = WS_TQ;
constexpr size_t WS_SC = WS_QC + 64 * MiB;
constexpr size_t WS_P = WS_SC + 64 * MiB;
constexpr size_t WS_A3 = WS_P + 32 * MiB;
constexpr size_t WS_CS = WS_A3 + 48 * MiB;
constexpr size_t WS_W1 = WS_CS + 32 * MiB;
constexpr size_t WS_W3 = WS_W1 + 16 * MiB;
constexpr size_t WS_KFB = WS_W3 + 48 * MiB;
constexpr size_t WS_APOW = WS_KFB + 4 * MiB;
constexpr size_t WS_END = WS_APOW + 3 * MiB;
static_assert(WS_END <= 1024 * MiB, "workspace map");
constexpr int CW_BAR = 4096;

constexpr int RING_BYTES = 131072, LDSCTL_OFF = RING_BYTES, MISC_OFF = LDSCTL_OFF + 320, LDS_BYTES = 147456;

typedef GAS unsigned gu32;
#define RLX_AGENT __ATOMIC_RELAXED, __HIP_MEMORY_SCOPE_AGENT
#define LDS_WAIT() asm volatile("s_waitcnt lgkmcnt(0)" ::: "memory")

#define XB_TMO      128
#define XB_XCNT(j)  (256  + 64 * (j))
#define XB_XSUB(j)  (1280 + 64 * (j))
#define XB_XGEN(j)  (2304 + 64 * (j))
#define XB_TOP      3328
#define XB_TOPGEN   3392
#define XCD_BAR_WORDS 3456
#define XB_SPIN_CAP (1u << 22)
__device__ __forceinline__ unsigned xb_ld(gu32* p)              { return __hip_atomic_load(p, __ATOMIC_RELAXED, __HIP_MEMORY_SCOPE_AGENT); }
__device__ __forceinline__ unsigned xb_add(gu32* p, unsigned v) { return __hip_atomic_fetch_add(p, v, __ATOMIC_RELAXED, __HIP_MEMORY_SCOPE_AGENT); }
__device__ __forceinline__ unsigned xb_xcc_id() { return (unsigned)__builtin_amdgcn_s_getreg((3 << 11) | 20) & 0xFu; }
#define XB_SPIN(cond, bar) do { unsigned _sp = 0; while (cond) { __builtin_amdgcn_s_sleep(1); \
    if ((++_sp & 255u) == 0u) { if (xb_ld(&(bar)[XB_TMO])) break; if (_sp > XB_SPIN_CAP) { (void)xb_add(&(bar)[XB_TMO], 1u); break; } } } } while (0)
struct XcdBarrier { gu32* bar; unsigned x; volatile LAS unsigned* st; };
__device__ __forceinline__ XcdBarrier xcd_barrier_post(gu32* bar, volatile LAS unsigned* st) {
    XcdBarrier b; b.bar = bar; b.x = xb_xcc_id(); b.st = st;
    if (threadIdx.x == 0) (void)xb_add(&bar[XB_XCNT(b.x)], 1u);
    return b;
}
__device__ __forceinline__ void xcd_barrier_complete(gu32* bar, unsigned x, unsigned& nloc, unsigned& nx) {
    const unsigned G = gridDim.x * gridDim.y * gridDim.z;
    unsigned sum, cnt, mine, sp = 0u;
    for (;;) {
        sum = 0u; cnt = 0u; mine = 0u;
#pragma unroll
        for (unsigned j = 0; j < 16; ++j) { const unsigned c = xb_ld(&bar[XB_XCNT(j)]); sum += c; cnt += (c > 0u) ? 1u : 0u; mine = (j == x) ? c : mine; }
        if (sum == G) break;
        __builtin_amdgcn_s_sleep(1);
        if ((++sp & 255u) == 0u) { if (xb_ld(&bar[XB_TMO])) break; if (sp > XB_SPIN_CAP) { (void)xb_add(&bar[XB_TMO], 1u); break; } }
    }
    nloc = mine > 0u ? mine : 1u; nx = cnt > 0u ? cnt : 1u;
}
__device__ __forceinline__ void xcd_barrier(const XcdBarrier& b) {
    asm volatile("s_waitcnt vmcnt(0)" ::: "memory");
    __syncthreads();
    if (threadIdx.x == 0) {
        gu32* bar = b.bar; unsigned bx_ = b.x; asm volatile("" : "+s"(bar), "+s"(bx_));
        __builtin_amdgcn_s_waitcnt(0);
#ifdef EARLY_WB
        __builtin_amdgcn_fence(__ATOMIC_RELEASE, "agent");
#endif
        unsigned nloc = b.st[0], nx = b.st[1];
        if (nloc == 0u) { xcd_barrier_complete(bar, bx_, nloc, nx); b.st[0] = nloc; b.st[1] = nx; }
        const unsigned old = xb_add(&bar[XB_XSUB(bx_)], 1u);
        const unsigned gen = old / nloc;
        if (old + 1u == (gen + 1u) * nloc) {
            __builtin_amdgcn_fence(__ATOMIC_RELEASE, "agent");
            asm volatile("s_waitcnt vmcnt(0)" ::: "memory");
            const unsigned og = xb_add(&bar[XB_TOP], 1u);
            const unsigned tg = og / nx;
            if (og + 1u == (tg + 1u) * nx) xb_add(&bar[XB_TOPGEN], 1u);
            else XB_SPIN(xb_ld(&bar[XB_TOPGEN]) == tg, bar);
            __builtin_amdgcn_fence(__ATOMIC_ACQUIRE, "agent");
            xb_add(&bar[XB_XGEN(bx_)], 1u);
            asm volatile("s_waitcnt vmcnt(0)" ::: "memory");
        } else {
            XB_SPIN(xb_ld(&bar[XB_XGEN(bx_)]) == gen, bar);
            __builtin_amdgcn_fence(__ATOMIC_ACQUIRE, "agent");
            asm volatile("s_waitcnt vmcnt(0)" ::: "memory");
        }
    }
    __syncthreads();
}

__device__ __forceinline__ unsigned f2bf(float f) { unsigned u = __builtin_bit_cast(unsigned, f); return (u + 0x7fffu + ((u >> 16) & 1u)) >> 16; }
__device__ __forceinline__ unsigned pk2(float lo, float hi) { return f2bf(lo) | (f2bf(hi) << 16); }
template <int MODE>
__device__ __forceinline__ void p0_transpose_tile(const float* W, int K, int N, bf16_t* WT, int which, LAS float* T, int item, int tid, const float* kscale = nullptr) {
    const int nblk = N / 128, kb = item / nblk, nb = item - kb * nblk, k0 = 128 * kb, n0 = 128 * nb;
    { const int r = tid >> 5, c4 = tid & 31; f32x4 v[8];
#pragma unroll
      for (int p = 0; p < 8; ++p) v[p] = *(const f32x4*)(W + (size_t)(k0 + 16 * p + r) * N + n0 + 4 * c4);
#pragma unroll
      for (int p = 0; p < 8; ++p) { LAS float* d = T + (16 * p + r) * 129 + 4 * c4; d[0] = v[p].x; d[1] = v[p].y; d[2] = v[p].z; d[3] = v[p].w; } }
    __syncthreads();
#pragma unroll
    for (int q = 0; q < 4; ++q) { const int cid = q * 512 + tid, n = cid >> 4, ch = cid & 15; const LAS float* sp = T + (8 * ch) * 129 + n;
        float e0 = sp[0 * 129], e1 = sp[1 * 129], e2 = sp[2 * 129], e3 = sp[3 * 129], e4 = sp[4 * 129], e5 = sp[5 * 129], e6 = sp[6 * 129], e7 = sp[7 * 129];
        if (kscale) { const f32x4 ka = *(const f32x4*)(kscale + k0 + 8 * ch), kb2 = *(const f32x4*)(kscale + k0 + 8 * ch + 4); e0 *= ka.x; e1 *= ka.y; e2 *= ka.z; e3 *= ka.w; e4 *= kb2.x; e5 *= kb2.y; e6 *= kb2.z; e7 *= kb2.w; }
        u32x4 o; o.x = pk2(e0, e1); o.y = pk2(e2, e3); o.z = pk2(e4, e5); o.w = pk2(e6, e7);
        const int nl = n0 + n; int prow;
        if (MODE == 0) prow = nl;
        else if (MODE == 1) { if (nl < 2048) { const int o64 = nl & 63; prow = (nl & ~63) + 8 * ((o64 & 31) >> 2) + 4 * (o64 >> 5) + (o64 & 3); } else prow = nl; }
        else prow = 8 * (nl >> 2) + 4 * which + (nl & 3);
        *(GAS u32x4*)(WT + (size_t)prow * K + k0 + 8 * ch) = o; }
    __syncthreads();
}

struct Args { const float* in[29]; float* out; unsigned char* ws; int ph_lo, ph_hi; };

__global__ void __launch_bounds__(NWAVES * 64, 2) fwd_kernel(Args args) {
    extern __shared__ __attribute__((aligned(16))) unsigned char lds[];
    LAS unsigned char* ldsl = (LAS unsigned char*)lds;
    volatile LAS unsigned* MISC = (volatile LAS unsigned*)(ldsl + MISC_OFF);
    const int tid = threadIdx.x, lane = tid & 63, wave = __builtin_amdgcn_readfirstlane(tid >> 6);
    const int G = gridDim.x, bx = blockIdx.x;
    const int vcu = (G % 8 == 0) ? (bx % 8) * (G / 8) + bx / 8 : bx;
    const int gw = vcu * NWAVES + wave, NGW = G * NWAVES;
    unsigned char* ws = args.ws;
    unsigned* ctl = (unsigned*)(ws + WS_CTL);
    for (int u = tid; u < (LDS_BYTES - LDSCTL_OFF) / 4; u += NWAVES * 64) ((LAS unsigned*)(ldsl + LDSCTL_OFF))[u] = 0u;
    __syncthreads();
    XcdBarrier bar; bar.bar = (gu32*)(ctl + CW_BAR); bar.x = 0; bar.st = nullptr;
    if (!MK_PER_PHASE) bar = xcd_barrier_post((gu32*)(ctl + CW_BAR), MISC + 8);
    const int lo = args.ph_lo, hi = args.ph_hi;
#ifndef DBG_ONLY
#define DBG_ONLY -1
#endif
#ifndef DBG_REPEAT_MASK
#define DBG_REPEAT_MASK 0u
#endif
#ifndef DBG_REPEAT_PRO
#define DBG_REPEAT_PRO 0u
#endif
#define IN(k) (lo <= (k) && (k) < hi)
#define PHASE(n) for (int rep_ = 0; rep_ < (((DBG_REPEAT_MASK >> (n)) & 1u) ? 2 : 1); ++rep_) if ((DBG_ONLY < 0 || DBG_ONLY == NPH0 + (n)) && IN(pb + (n)))
#ifdef DBG_WAIT_MASK
    unsigned long long wacc_ = 0ull;
#define SEAM(k) do { if (!MK_PER_PHASE && IN(k) && IN((k) + 1)) { const unsigned long long t0_ = wall_clock64(); xcd_barrier(bar); const int sb_ = (k) == 0 ? 9 : ((k) - NPH0) % NPH_G; if ((DBG_WAIT_MASK >> sb_) & 1u) wacc_ += wall_clock64() - t0_; } } while (0)
#elif defined(DBG_MINWAIT)
    unsigned long long wacc_ = 0ull;
#define SEAM(k) do { if (!MK_PER_PHASE && IN(k) && IN((k) + 1)) { const unsigned long long t0_ = wall_clock64(); xcd_barrier(bar); const unsigned w_ = (unsigned)(wall_clock64() - t0_); \
        if (threadIdx.x == 0) atomicMax((unsigned*)(ws + WS_CTL + 600064) + (k), 0x40000000u - w_); } } while (0)
#elif defined(DBG_WORK_MASK)
#ifdef DBG_CYCLES
#define DBG_NOW() ((unsigned long long)clock64() / 24ull)
#else
#define DBG_NOW() wall_clock64()
#endif
    unsigned long long wacc_ = 0ull, trel_ = DBG_NOW();
#define SEAM(k) do { if (!MK_PER_PHASE && IN(k) && IN((k) + 1)) { const unsigned long long ta_ = DBG_NOW(); if ((DBG_WORK_MASK >> (k)) & 1ull) wacc_ += ta_ - trel_; xcd_barrier(bar); trel_ = DBG_NOW(); } } while (0)
#else
#define SEAM(k) do { if (!MK_PER_PHASE && IN(k) && IN((k) + 1)) xcd_barrier(bar); } while (0)
#endif

    const float* x_prompt = args.in[0]; const float* x_sample = args.in[1]; const float* mem_prompt = args.in[2]; const float* mem_sample = args.in[3];
    float* out = args.out;
    bf16_t* W_IN = (bf16_t*)(ws + WS_WIN); bf16_t* W_AP = (bf16_t*)(ws + WS_WAP); bf16_t* W_GLU = (bf16_t*)(ws + WS_WGLU); bf16_t* W_MO = (bf16_t*)(ws + WS_WMO);
    bf16_t* W_QC = (bf16_t*)(ws + WS_WQC); bf16_t* W_KV = (bf16_t*)(ws + WS_WKV); bf16_t* W_OC = (bf16_t*)(ws + WS_WOC); bf16_t* W_UP = (bf16_t*)(ws + WS_WUP); bf16_t* W_DN = (bf16_t*)(ws + WS_WDN);
    bf16_t* MN = (bf16_t*)(ws + WS_MN); bf16_t* KVM = (bf16_t*)(ws + WS_KVM); bf16_t* TQ = (bf16_t*)(ws + WS_TQ); bf16_t* TVT = (bf16_t*)(ws + WS_TVT);
    bf16_t* XN0 = (bf16_t*)(ws + WS_XN); bf16_t* XN1 = (bf16_t*)(ws + WS_OD); bf16_t* QKVU = (bf16_t*)(ws + WS_QKVU); bf16_t* GATES = (bf16_t*)(ws + WS_GATES); bf16_t* HB = (bf16_t*)(ws + WS_H);
    bf16_t* OD = (bf16_t*)(ws + WS_OD); bf16_t* OC = (bf16_t*)(ws + WS_OC); bf16_t* AN = (bf16_t*)(ws + WS_AN); bf16_t* ZB = (bf16_t*)(ws + WS_Z); bf16_t* MIX = (bf16_t*)(ws + WS_MIX);
    bf16_t* A3 = (bf16_t*)(ws + WS_A3); float* CS = (float*)(ws + WS_CS); bf16_t* W1 = (bf16_t*)(ws + WS_W1); bf16_t* W3 = (bf16_t*)(ws + WS_W3); float* KFB = (float*)(ws + WS_KFB); float* APOW = (float*)(ws + WS_APOW);
    float* SC = (float*)(ws + WS_SC); bf16_t* PB = (bf16_t*)(ws + WS_P);
    float* SS1 = (float*)(ws + WS_CTL + 65536); float* SS2 = SS1 + NTOK; float* SS3 = SS2 + NTOK;
    float* ROPE = (float*)(ws + WS_ROPE); float* SBB = (float*)(ws + WS_SBB);

    for (int rep_ = 0; rep_ < ((DBG_REPEAT_PRO & 1u) ? 2 : 1); ++rep_) if ((DBG_ONLY < 0 || DBG_ONLY == 0) && IN(0)) {
        { LAS float* T = (LAS float*)ldsl;
          constexpr int I_WIN = (DM / 128) * (INC / 128), I_AP = (AW / 128) * (DM / 128), I_GL = (SW / 128) * (DM / 128), I_SQ = (DM / 128) * (DM / 128), I_KV = (DM / 128) * (4096 / 128), I_UP = (DM / 128) * (DFF / 128), I_DN = (DFF / 128) * (DM / 128);
          constexpr int NITEMS = I_WIN + I_AP + 2 * I_GL + 2 * I_SQ + I_KV + I_UP + I_DN;
          for (int it = vcu; it < NITEMS; it += G) {
            int r = it;
            if (r < I_WIN) { p0_transpose_tile<1>(args.in[5], DM, INC, W_IN, 0, T, r, tid); continue; } r -= I_WIN;
            if (r < I_AP) { p0_transpose_tile<0>(args.in[8], AW, DM, W_AP, 0, T, r, tid); continue; } r -= I_AP;
            if (r < I_GL) { p0_transpose_tile<2>(args.in[17], SW, DM, W_GLU, 0, T, r, tid); continue; } r -= I_GL;
            if (r < I_GL) { p0_transpose_tile<2>(args.in[18], SW, DM, W_GLU, 1, T, r, tid); continue; } r -= I_GL;
            if (r < I_SQ) { p0_transpose_tile<0>(args.in[19], DM, DM, W_MO, 0, T, r, tid); continue; } r -= I_SQ;
            if (r < I_SQ) { p0_transpose_tile<0>(args.in[24], DM, DM, W_OC, 0, T, r, tid); continue; } r -= I_SQ;
            if (r < I_KV) { p0_transpose_tile<0>(args.in[23], DM, 4096, W_KV, 0, T, r, tid); continue; } r -= I_KV;
            if (r < I_UP) { p0_transpose_tile<0>(args.in[26], DM, DFF, W_UP, 0, T, r, tid, args.in[25]); continue; } r -= I_UP;
            p0_transpose_tile<0>(args.in[27], DFF, DM, W_DN, 0, T, r, tid);
          } }
        for (int i = gw * 64 + lane; i < DM * DM / 8; i += NGW * 64) { const f32x4* p = (const f32x4*)(args.in[22] + (size_t)i * 8); const f32x4 a = p[0], b = p[1];
            u32x4 w; w.x = pk2(a.x, a.y); w.y = pk2(a.z, a.w); w.z = pk2(b.x, b.y); w.w = pk2(b.z, b.w); *(u32x4*)(W_QC + (size_t)i * 8) = w; }
        for (int i = gw * 64 + lane; i < LPR * 32; i += NGW * 64) { const int pos = i >> 5, f = i & 31;
            const float inv = (float)dexp(-(double)f * (9.210340371976184 / 32.0));
            const float ang = (float)pos * inv; double s, c; dsincos((double)ang, s, c);
            ROPE[pos * 64 + f] = (float)c; ROPE[pos * 64 + 32 + f] = (float)s; }
        { const SsmParams P{args.in[9], args.in[10], args.in[11], args.in[12], args.in[13], args.in[14], args.in[15]};
          for (int i = gw * 64 + lane; i < 8192; i += NGW * 64) ssm_discretise(P, i, SBB, APOW); }
        for (int m = gw; m < 16384; m += 2 * NGW) { const int m2 = m + NGW;
            const int mb = m2 < 16384 ? m2 : m;
            rms_row2_bf16_xr(x_prompt + (size_t)m * DM, x_prompt + (size_t)mb * DM, args.in[4], XN0 + (size_t)m * DM, XN0 + (size_t)mb * DM, (bf16_t*)out + (size_t)m * pg8::XRS, (bf16_t*)out + (size_t)mb * pg8::XRS, lane); }
        for (int m = gw; m < NMEMROWS; m += NGW) { const float* src = m < 1024 ? mem_prompt + (size_t)m * DM : mem_sample + (size_t)(m - 1024) * DM; rms_row_bf16(src, args.in[21], MN + (size_t)m * DM, lane); }
    }
    SEAM(0);

    for (int gi = 0; gi < NG; ++gi) {
        const int pb = NPH0 + gi * NPH_G; if (pb >= hi || pb + NPH_G <= lo) continue;
        const int grow0 = gi * 16384, M = gi < 2 ? 16384 : 8192;
        const int L = grow0 < NPROMPT ? LPR : LSA, nseq = M / L, seq0 = grow0 < NPROMPT ? grow0 / LPR : 4 + (grow0 - NPROMPT) / LSA;
        bf16_t* XN = (gi & 1) ? XN1 : XN0; bf16_t* XNnext = (gi & 1) ? XN0 : XN1;
        PHASE(0) {
            { pg8::Gemm g{DM, DM, DM}; pg8::TileOrder S; S.init(XN, DM, W_IN, DM, M, INC, G, bx, WGM_WIDE); pg8::EpiWin E{QKVU, GATES, ROPE, grow0, A3}; pg8::gemm_phase(ldsl, g, S, E); }
            if (gi == 0) {
                struct MemOrder { const bf16_t* MN; const bf16_t* WKV; int G, c;
                    __device__ bool next(int i, pg8::Unit& u) const { const int id = i * G + c; if (id >= 128) return false; u.pm = id >> 4; u.pn = id & 15;
                        u.a = (const char*)(MN + (size_t)u.pm * 256 * DM); u.b = (const char*)(WKV + (size_t)u.pn * 256 * DM); return true; } };
                pg8::Gemm g{DM, DM, DM}; MemOrder S{MN, W_KV, G, G == 256 ? ((bx + 128) & 255) : bx}  ; pg8::EpiBf16<0> E{KVM, 4096, 1.0f}; pg8::gemm_phase(ldsl, g, S, E);
                int tl_ = threadIdx.x; asm volatile("" : "+v"(tl_)); const int lane = tl_ & 63;
                const int tb = (G == 256) ? 128 : G;
                if (bx < tb) { for (int it = (bx * NWAVES + wave) * 64 + lane; it < 64 * 256 * 64; it += tb * NWAVES * 64) ssm_w1_item(it, SBB, APOW, W1);
                    for (int wid = bx * NWAVES + wave; wid < 64 * 2 * 4 * 4; wid += tb * NWAVES) ssm_kfb_wave(wid, lane, SBB, APOW, args.in[14], args.in[15], KFB); }
            }
        }
        SEAM(pb + 0);
#ifdef DBG_IDLE_BEFORE_C
        if (gi == 1) { const unsigned long long ti_ = wall_clock64(); while (wall_clock64() - ti_ < DBG_IDLE_BEFORE_C) __builtin_amdgcn_s_sleep(32);
#ifdef DBG_WORK_MASK
            trel_ = wall_clock64();
#endif
        }
#endif
        PHASE(1) {
            int tl_ = threadIdx.x; asm volatile("" : "+v"(tl_)); const int lane = tl_ & 63;
            float lam; { const float* dl = args.in[6]; float t0 = dl[lane] * dl[64 + lane], t1 = dl[128 + lane] * dl[192 + lane]; t0 = wave_sum(t0); t1 = wave_sum(t1); lam = __expf(t0) - __expf(t1) + 0.2f; }
            const int nqb = L / 128, NU = nseq * 8 * nqb;
            const int h0 = (G == 256 && gi + 1 < NG) ? 128 : 0  , nh = G - h0, nupc = (G == 256 && NU % 256 == 0) ? NU / 256 : 1, cohort = (bx >> 3) & (nupc - 1);
            for (int i = 0;; ++i) {
                if (i == cohort && bx >= h0) {
                    int tlr_ = threadIdx.x; asm volatile("" : "+v"(tlr_)); const int lane = tlr_ & 63;
                    const float* gmix = args.in[4]; const float* gfin = args.in[28]; asm volatile("" : "+s"(gmix), "+s"(gfin));
                    if (gi + 1 < NG) { const int g1 = (gi + 1) * 16384, M1 = gi + 1 < 2 ? 16384 : 8192;
                        for (int m = (bx - h0) * NWAVES + wave; m < M1; m += 2 * nh * NWAVES) { const int m2 = (m + nh * NWAVES < M1) ? m + nh * NWAVES : m, gr = g1 + m, gr2 = g1 + m2;
                            const float* src = gr < NPROMPT ? x_prompt + (size_t)gr * DM : x_sample + (size_t)(gr - NPROMPT) * DM; const float* src2 = gr2 < NPROMPT ? x_prompt + (size_t)gr2 * DM : x_sample + (size_t)(gr2 - NPROMPT) * DM;
                            rms_row2_bf16_xr(src, src2, gmix, XNnext + (size_t)m * DM, XNnext + (size_t)m2 * DM, (bf16_t*)out + (size_t)gr * pg8::XRS, (bf16_t*)out + (size_t)gr2 * pg8::XRS, lane); } }
                    if (gi > 0) final_norm_rows(out, gfin, SS3, (gi - 1) * 16384, 16384, (bx - h0) * NWAVES + wave, nh * NWAVES, lane);
                }
                int un; if (G == 256 && NU % 256 == 0) { const int per = NU / 8; un = (vcu >> 5) * per + (vcu & 31) + 32 * i; if (32 * i + (vcu & 31) >= per) break; } else { un = bx + i * G; if (un >= NU) break; }
                const int qb = un % nqb, sh = un / nqb, h = sh & 7, s = sh >> 3; const size_t srow = (size_t)s * L;
                attn3::attn_unit3(QKVU + (srow + (size_t)qb * 128) * 4096 + h * 128, QKVU + srow * 4096 + 1024 + h * 128, QKVU + srow * 4096 + 2048 + h * 128, AN + (srow + (size_t)qb * 128) * 1024 + h * 128, args.in[7], lam, L, (LAS char*)ldsl);
            }
            struct S1Order { const bf16_t* A3; const bf16_t* W1; int nmb, G, c;
                __device__ bool next(int i, pg8::Unit& u) const { const int id = i * G + c; if (id >= 64 * nmb) return false; const int g = id / nmb, mb = id - g * nmb;
                    u.pm = g * (NCH / 256) + mb; u.pn = 0; u.a = (const char*)(A3 + (size_t)(g * NCH + mb * 256) * 768); u.b = (const char*)(W1 + (size_t)g * 256 * 512); return true; } };
            { pg8::Gemm g{768, 512, 512}; S1Order S{A3, W1, M / (32 * 256), G, bx}; pg8::EpiF32 E{CS, 256}; pg8::gemm_phase(ldsl, g, S, E); }
            { int tl2_ = threadIdx.x; asm volatile("" : "+v"(tl2_)); const int lane = tl2_ & 63; const int nmb = M / (32 * 256), ncs = L / 32, nsb = 256 / ncs;
              for (int id = bx; id < 64 * nmb; id += G) { const int g = id / nmb, mb = id - g * nmb, sb = wave >> 1, d = wave & 1;
                  if (sb < nsb) ssm_carry_wave(APOW, CS, A3, d, g, mb * 256 + sb * ncs, ncs, lane); } }
            if (gi == 0) {
                struct TqOrder { const bf16_t* KVM; const bf16_t* WQ; int G, c;
                    __device__ bool next(int i, pg8::Unit& u) const { const int id = i * G + c; if (id >= 256) return false; const int sq = id >> 5, hx = (id >> 3) & 3, nb = id & 7;
                        u.pm = sq * 4 + hx; u.pn = nb; u.a = (const char*)(KVM + (size_t)sq * 256 * 4096 + hx * 512); u.b = (const char*)(WQ + (size_t)nb * 256 * DM + hx * 512); return true; } };
                struct TvOrder { const bf16_t* WO; const bf16_t* KVM; int G, c;
                    __device__ bool next(int i, pg8::Unit& u) const { const int id = i * G + c; if (id >= 256) return false; const int sq = id >> 5, hx = (id >> 3) & 3, mb = id & 7;
                        u.pm = sq * 8 + mb; u.pn = hx; u.a = (const char*)(WO + (size_t)mb * 256 * DM + hx * 512); u.b = (const char*)(KVM + (size_t)sq * 256 * 4096 + 2048 + hx * 512); return true; } };
                { pg8::Gemm g{4096, DM, 512}; TqOrder S{KVM, W_QC, G, bx}; pg8::EpiBf16Col E{TQ, DM, 0.044194173824159216f, args.in[20]}; pg8::gemm_phase(ldsl, g, S, E); }
                { pg8::Gemm g{DM, 4096, 512}; TvOrder S{W_OC, KVM, G, bx}; pg8::EpiBf16<0> E{TVT, 1024, 1.0f}; pg8::gemm_phase(ldsl, g, S, E); }
                int tl3_ = threadIdx.x; asm volatile("" : "+v"(tl3_)); const int lane = tl3_ & 63;
                for (int it = gw * 64 + lane; it < 64 * 512 * 96; it += NGW * 64) ssm_w3_item(it, APOW, KFB, args.in[14], args.in[15], args.in[16], W3);
            }
        }
        SEAM(pb + 1);
        PHASE(2) {
            { pg8::Gemm g{AW, AW, AW}; pg8::TileOrder S; S.init(AN, AW, W_AP, AW, M, DM, G, bx); pg8::EpiAttnProj E{GATES, MIX}; pg8::gemm_phase(ldsl, g, S, E); }
            struct S3Order { const bf16_t* A3; const bf16_t* W3; int nmb, G, c;
                __device__ bool next(int i, pg8::Unit& u) const { const int id = i * G + c; if (id >= 128 * nmb) return false; const int nb = id & 1, gm = id >> 1, g = gm / nmb, mb = gm - g * nmb;
                    u.pm = g * (NCH / 256) + mb; u.pn = nb; u.a = (const char*)(A3 + (size_t)(g * NCH + mb * 256) * 768); u.b = (const char*)(W3 + (size_t)(g * 512 + nb * 256) * 768); return true; } };
            pg8::Gemm g{768, 768, 768}; S3Order S{A3, W3, M / (32 * 256), G, bx}; pg8::EpiSsmOut E{ZB}; pg8::gemm_phase(ldsl, g, S, E);
        }
        SEAM(pb + 2);
        PHASE(3) { pg8::Gemm g{SW, SW, SW}; pg8::TileOrder S; S.init(ZB, SW, W_GLU, SW, M, 4096, G, bx); pg8::EpiGlu E{GATES, MIX}; pg8::gemm_phase(ldsl, g, S, E); }
        SEAM(pb + 3);
        PHASE(4) { pg8::Gemm g{DM, DM, DM}; pg8::TileOrder S; S.init(MIX, DM, W_MO, DM, M, DM, G, bx); pg8::EpiResidSS E{(bf16_t*)out, grow0, SS1, nullptr, nullptr}; pg8::gemm_phase(ldsl, g, S, E); }
        SEAM(pb + 4);
        PHASE(5) {
            struct OneScore { const char* a; const char* b; int pm, pn;
                __device__ bool next(int i, pg8::Unit& u) const { if (i > 0) return false; u.a = a; u.b = b; u.pm = pm; u.pn = pn; return true; } };
            const int nrb = M / 256, rbsh = (L == LPR) ? 5 : 3;
            for (int id = vcu; id < nrb * 4; id += G) { const int hx = id & 3, rb = id >> 2, sq = seq0 + (rb >> rbsh);
                { pg8::Gemm g{pg8::XRS, DM, DM}; OneScore S{(const char*)((const bf16_t*)out + (size_t)(grow0 + rb * 256) * pg8::XRS), (const char*)(TQ + ((size_t)sq * 1024 + hx * 256) * DM), rb, hx};
                  pg8::EpiBf16Rs<0> E{(bf16_t*)SC, 1024, 1.0f, SS1, grow0}; pg8::gemm_phase(ldsl, g, S, E); }
                for (int r4 = wave; r4 < 64; r4 += 2 * NWAVES) { const size_t row = (size_t)rb * 256 + r4 * 4 + (lane >> 4), row2 = row + 4 * NWAVES;
                    xsoftmax_head2_bf16((const bf16_t*)SC + row * 1024 + hx * 256, PB + row * 1024 + hx * 256, (const bf16_t*)SC + row2 * 1024 + hx * 256, PB + row2 * 1024 + hx * 256, lane & 15); }
            }
        }
        SEAM(pb + 5);
        PHASE(6) {
            struct XoOrder { pg8::TileOrder T; const bf16_t* TVT; int rbsh, seq0;
                __device__ bool next(int i, pg8::Unit& u) const { if (!T.next(i, u)) return false; u.b = (const char*)(TVT + ((size_t)(seq0 + (u.pm >> rbsh)) * 2048 + u.pn * 256) * 1024); return true; } };
            pg8::Gemm g{1024, 1024, 1024}; XoOrder S; S.T.init(PB, 1024, TVT, 1024, M, DM, G, bx); S.TVT = TVT; S.rbsh = (L == LPR) ? 5 : 3; S.seq0 = seq0;
            pg8::EpiResidSS E{(bf16_t*)out, grow0, SS2, nullptr, nullptr}; pg8::gemm_phase(ldsl, g, S, E);
        }
        SEAM(pb + 6);
        PHASE(7) { pg8::Gemm g{pg8::XRS, DM, DM}; pg8::TileOrder S; S.init((const bf16_t*)out + (size_t)grow0 * pg8::XRS, pg8::XRS, W_UP, DM, M, DFF, G, bx, WGM_WIDE); pg8::EpiBf16Rs<2> E{HB, DFF, 1.0f, SS2, grow0}; pg8::gemm_phase(ldsl, g, S, E); }
        SEAM(pb + 7);
        PHASE(8) { pg8::Gemm g{DFF, DFF, DFF}; pg8::TileOrder S; S.init(HB, DFF, W_DN, DFF, M, DM, G, bx); pg8::EpiResidSS E{(bf16_t*)out, grow0, SS3, nullptr, nullptr}; pg8::gemm_phase(ldsl, g, S, E); }
        SEAM(pb + 8);
    }
    if ((DBG_ONLY < 0 || DBG_ONLY == NPH - 1) && IN(NPH - 1)) { int tl_ = threadIdx.x; asm volatile("" : "+v"(tl_)); const int lane = tl_ & 63; const int gp = (NG - 1) * 16384, Mp = 8192; final_norm_rows(out, args.in[28], SS3, gp, Mp, gw, NGW, lane); }
#if defined(DBG_WAIT_MASK) || defined(DBG_WORK_MASK) || defined(DBG_MINWAIT)
    { unsigned long long* wtot = (unsigned long long*)(ws + WS_CTL + 600000);
      if (threadIdx.x == 0) atomicAdd(wtot, wacc_);
      xcd_barrier(bar);
#ifdef DBG_MINWAIT
      if (bx == 0 && threadIdx.x == 0) { unsigned long long sm = 0; for (int k = 0; k < NPH - 1; ++k) { const unsigned v = __hip_atomic_load((unsigned*)(ws + WS_CTL + 600064) + k, __ATOMIC_RELAXED, __HIP_MEMORY_SCOPE_AGENT); sm += (unsigned long long)(0x40000000u - v); } *wtot = sm * (unsigned long long)G; }
      __syncthreads();
#endif
      if (bx == 0 && threadIdx.x == 0) { unsigned long long tot = __hip_atomic_load(wtot, __ATOMIC_RELAXED, __HIP_MEMORY_SCOPE_AGENT) / (unsigned long long)G;
#ifdef DBG_SPIN_TICKS
        tot = DBG_SPIN_TICKS;
#endif
 const unsigned long long t0_ = wall_clock64(); while (wall_clock64() - t0_ < tot) __builtin_amdgcn_s_sleep(8); } }
#endif
#undef IN
#undef PHASE
#undef SEAM
}

#ifdef DBG_STOP
__global__ void dump_kernel(const unsigned char* ws, size_t off, size_t nelem, int is_f32, float* out, size_t nout) {
    for (size_t i = (size_t)blockIdx.x * blockDim.x + threadIdx.x; i < nout; i += (size_t)gridDim.x * blockDim.x) { const size_t idx = i % nelem;
        float v = is_f32 ? ((const float*)(ws + off))[idx] : __uint_as_float((unsigned)((const bf16_t*)(ws + off))[idx] << 16);
        if (!(v == v) || fabsf(v) > 1e30f) v = 12345.f; out[i] = v; }
}
#endif
extern "C" void kernel_launch(void* const* d_in, const int* in_sizes, int n_in, void* d_out, int out_size, void* d_ws, size_t ws_size, hipStream_t stream) {
    static int grid = 0;
    if (grid == 0) {
        if (n_in != 29 || out_size != NTOK * DM || ws_size < WS_END) { fprintf(stderr, "kernel_launch: unexpected shapes: n_in %d out %d ws %zu (need %zu)\n", n_in, out_size, ws_size, (size_t)WS_END); grid = -1; return; }
        int dev = 0, cus = 0, per_cu = 0;
        if (hipGetDevice(&dev) != hipSuccess || hipDeviceGetAttribute(&cus, hipDeviceAttributeMultiprocessorCount, dev) != hipSuccess) { grid = -1; return; }
        if (hipFuncSetAttribute((const void*)fwd_kernel, hipFuncAttributeMaxDynamicSharedMemorySize, LDS_BYTES) != hipSuccess) { fprintf(stderr, "kernel_launch: hipFuncSetAttribute failed\n"); grid = -1; return; }
        if (hipOccupancyMaxActiveBlocksPerMultiprocessor(&per_cu, (const void*)fwd_kernel, NWAVES * 64, LDS_BYTES) != hipSuccess || per_cu < 1) { fprintf(stderr, "kernel_launch: occupancy query says %d\n", per_cu); }
        (void)hipGetLastError();
        grid = cus;
    }
    if (grid < 0) return;
    (void)hipMemsetAsync((char*)d_ws + WS_CTL, 0, CTL_ZERO_BYTES, stream);
    Args a{};
    for (int i = 0; i < 29; ++i) a.in[i] = (const float*)d_in[i];
    a.out = (float*)d_out; a.ws = (unsigned char*)d_ws;
#if MK_PER_PHASE
#ifdef DBG_STOP
    for (int p = 0; p < DBG_STOP; ++p) { a.ph_lo = p; a.ph_hi = p + 1; hipLaunchKernelGGL(fwd_kernel, dim3(grid), dim3(NWAVES * 64), LDS_BYTES, stream, a); }
    hipLaunchKernelGGL(dump_kernel, dim3(2048), dim3(256), 0, stream, (const unsigned char*)d_ws, (size_t)DBG_OFF, (size_t)DBG_NELEM, (int)DBG_F32, (float*)d_out, (size_t)NTOK * DM);
#else
    for (int p = 0; p < NPH; ++p) { a.ph_lo = p; a.ph_hi = p + 1; hipLaunchKernelGGL(fwd_kernel, dim3(grid), dim3(NWAVES * 64), LDS_BYTES, stream, a); }
#endif
#else
    a.ph_lo = 0; a.ph_hi = NPH; hipLaunchKernelGGL(fwd_kernel, dim3(grid), dim3(NWAVES * 64), LDS_BYTES, stream, a);
#endif
}
```

```cpp
#include <hip/hip_runtime.h>
#include <hip/hip_bf16.h>
#include <cstdio>
#include <cstdint>
#include <cmath>

#define LAS __attribute__((address_space(3)))
#define GAS __attribute__((address_space(1)))
typedef unsigned short bf16_t;
typedef short bf16x8 __attribute__((ext_vector_type(8)));
typedef short s16x4 __attribute__((ext_vector_type(4)));
typedef float f32x4 __attribute__((ext_vector_type(4)));
typedef float f32x2 __attribute__((ext_vector_type(2)));
typedef float f32x16 __attribute__((ext_vector_type(16)));
typedef unsigned u32x4 __attribute__((ext_vector_type(4)));
typedef unsigned u32x2 __attribute__((ext_vector_type(2)));

constexpr int DM = 2048, NTOK = 40960, NPROMPT = 32768, LPR = 8192, LSA = 2048;
constexpr int INC = 8192, AW = 1024, SW = 1024, DFF = 8192, NMEMROWS = 2048;
constexpr float EPS = 1e-6f;

typedef __bf16 bf16x2_t __attribute__((ext_vector_type(2)));
__device__ __forceinline__ unsigned cvt_pk_bf16(float lo, float hi) { f32x2 v = {lo, hi}; bf16x2_t b = __builtin_convertvector(v, bf16x2_t); return __builtin_bit_cast(unsigned, b); }
__device__ __forceinline__ float bf_lo(unsigned w) { return __uint_as_float(w << 16); }
__device__ __forceinline__ float bf_hi(unsigned w) { return __uint_as_float(w & 0xffff0000u); }
__device__ __forceinline__ float sigmoidf_(float x) { return __builtin_amdgcn_rcpf(1.0f + __expf(-x)); }
template <int CTRL> __device__ __forceinline__ float dppf(float v) { return __int_as_float(__builtin_amdgcn_update_dpp(0, __float_as_int(v), CTRL, 0xF, 0xF, true)); }
__device__ __forceinline__ float sum4(float v) { v += dppf<0xB1>(v); v += dppf<0x4E>(v); return v; }
__device__ __forceinline__ float sum8(float v) { v = sum4(v); v += dppf<0x141>(v); return v; }
__device__ __forceinline__ float sum16(float v) { v = sum4(v); v += dppf<0x124>(v); v += dppf<0x128>(v); return v; }
__device__ __forceinline__ float max16(float v) { v = fmaxf(v, dppf<0xB1>(v)); v = fmaxf(v, dppf<0x4E>(v)); v = fmaxf(v, dppf<0x124>(v)); v = fmaxf(v, dppf<0x128>(v)); return v; }
__device__ __forceinline__ float wave_sum(float v) {
    v = sum16(v);
    { auto r = __builtin_amdgcn_permlane16_swap(__float_as_uint(v), __float_as_uint(v), false, false); v = __uint_as_float(r[0]) + __uint_as_float(r[1]); }
    { auto r = __builtin_amdgcn_permlane32_swap(__float_as_uint(v), __float_as_uint(v), false, false); v = __uint_as_float(r[0]) + __uint_as_float(r[1]); }
    return v;
}

namespace pg8 {
constexpr int BM = 256, BK = 64, HALF = 128, HTB = HALF * BK * 2, STAGE_BYTES = 8 * HTB, NXCD = 8;
__host__ __device__ __forceinline__ int lds_byte(int r, int c) { const int st = (r >> 4) * 2 + (c >> 5), rr = r & 15, cc = c & 31, ob = rr * 64 + cc * 2; return st * 1024 + (ob ^ (((ob >> 9) & 1) << 5)); }
__host__ __device__ __forceinline__ void stage_rc(int b, int& R, int& C) { const int st = b / 1024, sb = b % 1024, swz = sb ^ (((sb >> 9) & 1) << 5); R = (st >> 1) * 16 + swz / 64; C = (st & 1) * 32 + (swz % 64) / 2; }
__host__ __device__ __forceinline__ int perm32(int rho) { const int n = rho >> 4, i = rho & 15; return 8 * (i >> 2) + 4 * n + (i & 3); }

struct Unit { const char* a; const char* b; int pm, pn; };
struct Gemm { int lda, ldb, K; };

struct TileOrder {
    const char* A; const char* B; size_t ta, tb; int nM, nN, nwg, G, c, wgm;
    __device__ void init(const void* A_, int lda, const void* B_, int ldb, int M, int N, int G_, int c_, int WGM = 4) { A = (const char*)A_; B = (const char*)B_; ta = (size_t)BM * lda * 2; tb = (size_t)BM * ldb * 2; nM = M / BM; nN = N / BM; nwg = nM * nN; G = G_; c = c_; wgm = WGM; }
    __device__ bool next(int i, Unit& u) const {
        const long L = (long)i * G + c; if (L >= nwg) return false;
        int wgid = (int)L; { const int q = nwg / NXCD, r = nwg % NXCD, xcd = wgid % NXCD, off = wgid / NXCD; wgid = (xcd < r ? xcd * (q + 1) : r * (q + 1) + (xcd - r) * q) + off; }
        const int nig = wgm * nN, gid = wgid / nig, fm = gid * wgm, gsz = (nM - fm) < wgm ? (nM - fm) : wgm;
        u.pm = fm + ((wgid % nig) % gsz); u.pn = (wgid % nig) / gsz; u.a = A + (size_t)u.pm * ta; u.b = B + (size_t)u.pn * tb; return true;
    }
};

template <class Epi, class Sched>
__device__ __forceinline__ void gemm_phase(LAS unsigned char* lds, const Gemm g, const Sched& S, const Epi& E) {
    int tid_ = threadIdx.x; asm volatile("" : "+v"(tid_));
    const int tid = tid_, wid = __builtin_amdgcn_readfirstlane(tid >> 6), lane = tid & 63, wr = wid >> 2, wc = wid & 3, fr = lane & 15, fq = lane >> 4;
    int K_ = g.K; asm volatile("" : "+s"(K_));
    const int K = K_, nt = K / BK;
    unsigned voffA[2], voffB[2];
#pragma unroll
    for (int i = 0; i < 2; ++i) { int R, C; stage_rc(tid * 16 + i * 8192, R, C); const int Rb = Epi::PERM ? ((R & ~31) + perm32(R & 31)) : R;
        voffA[i] = (unsigned)(R * g.lda + C) * 2u; voffB[i] = (unsigned)(Rb * g.ldb + C) * 2u; }
    const size_t kstep = (size_t)(BK * 2);
    const size_t hsA = (size_t)HALF * g.lda * 2, hsB = (size_t)HALF * g.ldb * 2;
    const unsigned ldsw = (unsigned)wid * 1024u;
    const int aoff = lds_byte(wr * 64 + fr, fq * 8), boff = lds_byte(wc * 32 + fr, fq * 8);
#define PG8_SA(b, h) (((b) * 2 + (h)) * HTB)
#define PG8_SB(b, h) ((4 + (b) * 2 + (h)) * HTB)
#define PG8_STAGE(bufoff, gbase, voff) do { _Pragma("unroll") for (int _i = 0; _i < 2; ++_i) \
        __builtin_amdgcn_global_load_lds((const unsigned*)((const char*)(gbase) + (voff)[_i]), (LAS unsigned*)(lds + (bufoff) + ldsw + _i * 8192), 16, 0, 0); } while (0)
#define PG8_LDA(dst, b, h) do { _Pragma("unroll") for (int m = 0; m < 4; ++m) _Pragma("unroll") for (int k = 0; k < 2; ++k) dst[m][k] = *(const LAS bf16x8*)(lds + PG8_SA(b, h) + aoff + m * 2048 + k * 1024); } while (0)
#define PG8_LDB(dst, b, h) do { _Pragma("unroll") for (int n = 0; n < 2; ++n) _Pragma("unroll") for (int k = 0; k < 2; ++k) dst[n][k] = *(const LAS bf16x8*)(lds + PG8_SB(b, h) + boff + n * 2048 + k * 1024); } while (0)
#define PG8_MMA(ai, bj, At, Bt) do { __builtin_amdgcn_s_setprio(1); _Pragma("unroll") for (int m = 0; m < 4; ++m) _Pragma("unroll") for (int n = 0; n < 2; ++n) _Pragma("unroll") for (int k = 0; k < 2; ++k) \
        acc[ai][bj][m][n] = __builtin_amdgcn_mfma_f32_16x16x32_bf16(Bt[n][k], At[m][k], acc[ai][bj][m][n], 0, 0, 0); __builtin_amdgcn_s_setprio(0); } while (0)
#define PG8_WAIT_V(n) asm volatile("s_waitcnt vmcnt(" #n ")" ::: "memory")
#define PG8_WAIT_L(n) asm volatile("s_waitcnt lgkmcnt(" #n ")" ::: "memory")
#define PG8_BAR __builtin_amdgcn_s_barrier()
#define PG8_SCHED __builtin_amdgcn_sched_barrier(0)
    Unit cur, nxt; int ui = 0;
    if (!S.next(0, cur)) return;
    f32x4 acc[2][2][4][2];
#pragma unroll
    for (int a = 0; a < 2; ++a)
#pragma unroll
        for (int b = 0; b < 2; ++b)
#pragma unroll
            for (int m = 0; m < 4; ++m)
#pragma unroll
                for (int n = 0; n < 2; ++n) acc[a][b][m][n] = (f32x4){0.f, 0.f, 0.f, 0.f};
    bf16x8 At[4][2], B0[2][2], B1[2][2];
    const char* cA = cur.a; const char* cB = cur.b;
    PG8_STAGE(PG8_SB(0, 0), cB, voffB); PG8_STAGE(PG8_SB(0, 1), cB + hsB, voffB); PG8_STAGE(PG8_SA(0, 0), cA, voffA); PG8_STAGE(PG8_SA(0, 1), cA + hsA, voffA);
    if (wr == 1) PG8_BAR;
    PG8_WAIT_V(2); PG8_BAR;
    PG8_STAGE(PG8_SB(1, 0), cB + kstep, voffB); PG8_STAGE(PG8_SA(1, 0), cA + kstep, voffA); PG8_STAGE(PG8_SB(1, 1), cB + hsB + kstep, voffB);
    PG8_WAIT_V(6); PG8_BAR;
    for (;;) {
        const bool has_next = S.next(ui + 1, nxt);
        const char* nA = has_next ? nxt.a : cA; const char* nB = has_next ? nxt.b : cB;
        for (int t = 0; t < nt; t += 2) {
            const bool last = (t == nt - 2);
            const char* a1 = cA + (size_t)(t + 1) * kstep;
            const char* a2 = last ? nA : cA + (size_t)(t + 2) * kstep; const char* b2 = last ? nB : cB + (size_t)(t + 2) * kstep;
            const char* a3 = a2 + kstep; const char* b3 = b2 + kstep;
            PG8_LDB(B0, 0, 0); PG8_LDB(B1, 0, 1); PG8_SCHED; PG8_LDA(At, 0, 0); PG8_STAGE(PG8_SA(1, 1), a1 + hsA, voffA);
            PG8_WAIT_V(8); PG8_WAIT_L(0); PG8_BAR; PG8_MMA(0, 0, At, B0); PG8_MMA(0, 1, At, B1); PG8_BAR; PG8_SCHED;
            PG8_LDA(At, 0, 1); PG8_STAGE(PG8_SB(0, 0), b2, voffB); PG8_STAGE(PG8_SB(0, 1), b2 + hsB, voffB); PG8_STAGE(PG8_SA(0, 0), a2, voffA);
            PG8_WAIT_V(8); PG8_WAIT_L(0); PG8_BAR; PG8_MMA(1, 0, At, B0); PG8_MMA(1, 1, At, B1); PG8_BAR; PG8_SCHED;
            PG8_LDB(B0, 1, 0); PG8_LDB(B1, 1, 1); PG8_SCHED; PG8_LDA(At, 1, 0); PG8_STAGE(PG8_SA(0, 1), a2 + hsA, voffA);
            PG8_WAIT_V(8); PG8_WAIT_L(0); PG8_BAR; PG8_MMA(0, 0, At, B0); PG8_MMA(0, 1, At, B1); PG8_BAR; PG8_SCHED;
            PG8_LDA(At, 1, 1); PG8_STAGE(PG8_SB(1, 0), b3, voffB); PG8_STAGE(PG8_SB(1, 1), b3 + hsB, voffB); PG8_STAGE(PG8_SA(1, 0), a3, voffA);
            PG8_WAIT_V(8); PG8_WAIT_L(0); PG8_BAR; PG8_MMA(1, 0, At, B0); PG8_MMA(1, 1, At, B1); PG8_BAR; PG8_SCHED;
        }
        if (wr == 0) PG8_BAR;
        E(acc, cur, wr, wc, fr, fq);
        if (!has_next) break;
#pragma unroll
        for (int a = 0; a < 2; ++a)
#pragma unroll
            for (int b = 0; b < 2; ++b)
#pragma unroll
                for (int m = 0; m < 4; ++m)
#pragma unroll
                    for (int n = 0; n < 2; ++n) acc[a][b][m][n] = (f32x4){0.f, 0.f, 0.f, 0.f};
        cur = nxt; cA = nA; cB = nB; ++ui;
        if (wr == 1) PG8_BAR;
    }
    PG8_WAIT_V(0);
    PG8_BAR;
#undef PG8_SA
#undef PG8_SB
#undef PG8_STAGE
#undef PG8_LDA
#undef PG8_LDB
#undef PG8_MMA
#undef PG8_WAIT_V
#undef PG8_WAIT_L
#undef PG8_BAR
#undef PG8_SCHED
}
}
__device__ __forceinline__ float gelu_tanh(float x) {
    const float y2 = 1.5957691216057308f * (x + 0.044715f * x * x * x);
    return x * sigmoidf_(y2);
}
namespace pg8 {
__device__ __forceinline__ u32x4 pack8(const f32x4 v0, const f32x4 v1) { u32x4 w; w.x = cvt_pk_bf16(v0[0], v0[1]); w.y = cvt_pk_bf16(v0[2], v0[3]); w.z = cvt_pk_bf16(v1[0], v1[1]); w.w = cvt_pk_bf16(v1[2], v1[3]); return w; }
__device__ __forceinline__ u32x2 pack4(const f32x4 v) { u32x2 w; w.x = cvt_pk_bf16(v[0], v[1]); w.y = cvt_pk_bf16(v[2], v[3]); return w; }

template <int ACT> struct EpiBf16 {
    static constexpr bool PERM = true;
    bf16_t* O; int ldc; float scale;
    __device__ __forceinline__ void operator()(const f32x4 (&acc)[2][2][4][2], const Unit& u, int wr, int wc, int fr, int fq) const {
        const int row0 = u.pm * BM + wr * 64 + fr, col0 = u.pn * BM + wc * 32 + 8 * fq;
#pragma unroll
        for (int ai = 0; ai < 2; ++ai)
#pragma unroll
            for (int m = 0; m < 4; ++m) { bf16_t* rowp = O + (size_t)(row0 + ai * HALF + m * 16) * ldc + col0;
#pragma unroll
                for (int bj = 0; bj < 2; ++bj) { f32x4 v0 = acc[ai][bj][m][0], v1 = acc[ai][bj][m][1];
                    if (ACT == 2) {
#pragma unroll
                        for (int e = 0; e < 4; ++e) { const float a = fmaxf(v0[e], 0.f), b = fmaxf(v1[e], 0.f); v0[e] = a * a; v1[e] = b * b; } }
                    v0 = v0 * scale; v1 = v1 * scale;
                    *(u32x4*)(rowp + bj * HALF) = pack8(v0, v1); } }
    }
};
struct EpiBf16Col {
    static constexpr bool PERM = true;
    bf16_t* O; int ldc; float scale; const float* cg;
    __device__ __forceinline__ void operator()(const f32x4 (&acc)[2][2][4][2], const Unit& u, int wr, int wc, int fr, int fq) const {
        const int row0 = u.pm * BM + wr * 64 + fr, col0 = u.pn * BM + wc * 32 + 8 * fq;
        f32x4 gv[2][2];
#pragma unroll
        for (int bj = 0; bj < 2; ++bj) { gv[bj][0] = *(const f32x4*)(cg + col0 + bj * HALF) * scale; gv[bj][1] = *(const f32x4*)(cg + col0 + bj * HALF + 4) * scale; }
#pragma unroll
        for (int ai = 0; ai < 2; ++ai)
#pragma unroll
            for (int m = 0; m < 4; ++m) { bf16_t* rowp = O + (size_t)(row0 + ai * HALF + m * 16) * ldc + col0;
#pragma unroll
                for (int bj = 0; bj < 2; ++bj) *(u32x4*)(rowp + bj * HALF) = pack8(acc[ai][bj][m][0] * gv[bj][0], acc[ai][bj][m][1] * gv[bj][1]); }
    }
};
template <int ACT> struct EpiBf16Rs {
    static constexpr bool PERM = true;
    bf16_t* O; int ldc; float scale; const float* SS; int grow0;
    __device__ __forceinline__ void operator()(const f32x4 (&acc)[2][2][4][2], const Unit& u, int wr, int wc, int fr, int fq) const {
        const int row0 = u.pm * BM + wr * 64 + fr, col0 = u.pn * BM + wc * 32 + 8 * fq;
        float ssv[2][4];
#pragma unroll
        for (int ai = 0; ai < 2; ++ai)
#pragma unroll
            for (int m = 0; m < 4; ++m) ssv[ai][m] = SS[grow0 + row0 + ai * HALF + m * 16];
#pragma unroll
        for (int ai = 0; ai < 2; ++ai)
#pragma unroll
            for (int m = 0; m < 4; ++m) { const int rl = row0 + ai * HALF + m * 16; bf16_t* rowp = O + (size_t)rl * ldc + col0;
                float r = 1.0f / sqrtf(ssv[ai][m] * (1.f / DM) + EPS); if (ACT == 2) r = r * r; r *= scale;
#pragma unroll
                for (int bj = 0; bj < 2; ++bj) { f32x4 v0 = acc[ai][bj][m][0], v1 = acc[ai][bj][m][1];
                    if (ACT == 2) {
#pragma unroll
                        for (int e = 0; e < 4; ++e) { const float a = fmaxf(v0[e], 0.f), b = fmaxf(v1[e], 0.f); v0[e] = a * a; v1[e] = b * b; } }
                    v0 = v0 * r; v1 = v1 * r;
                    *(u32x4*)(rowp + bj * HALF) = pack8(v0, v1); } }
    }
};
struct EpiF32 {
    static constexpr bool PERM = false;
    float* O; int ldc;
    __device__ __forceinline__ void operator()(const f32x4 (&acc)[2][2][4][2], const Unit& u, int wr, int wc, int fr, int fq) const {
        const int row0 = u.pm * BM + wr * 64 + fr, col0 = u.pn * BM + wc * 32 + 4 * fq;
#pragma unroll
        for (int ai = 0; ai < 2; ++ai)
#pragma unroll
            for (int m = 0; m < 4; ++m) { float* rowp = O + (size_t)(row0 + ai * HALF + m * 16) * ldc + col0;
#pragma unroll
                for (int bj = 0; bj < 2; ++bj)
#pragma unroll
                    for (int n = 0; n < 2; ++n) *(f32x4*)(rowp + bj * HALF + n * 16) = acc[ai][bj][m][n]; }
    }
};
struct EpiF32Rs {
    static constexpr bool PERM = false;
    float* O; int ldc; const float* SS; int grow0;
    __device__ __forceinline__ void operator()(const f32x4 (&acc)[2][2][4][2], const Unit& u, int wr, int wc, int fr, int fq) const {
        const int row0 = u.pm * BM + wr * 64 + fr, col0 = u.pn * BM + wc * 32 + 4 * fq;
        float ssv[2][4];
#pragma unroll
        for (int ai = 0; ai < 2; ++ai)
#pragma unroll
            for (int m = 0; m < 4; ++m) ssv[ai][m] = SS[grow0 + row0 + ai * HALF + m * 16];
#pragma unroll
        for (int ai = 0; ai < 2; ++ai)
#pragma unroll
            for (int m = 0; m < 4; ++m) { const int rl = row0 + ai * HALF + m * 16; float* rowp = O + (size_t)rl * ldc + col0; const float r = 1.0f / sqrtf(ssv[ai][m] * (1.f / DM) + EPS);
#pragma unroll
                for (int bj = 0; bj < 2; ++bj)
#pragma unroll
                    for (int n = 0; n < 2; ++n) *(f32x4*)(rowp + bj * HALF + n * 16) = acc[ai][bj][m][n] * r; }
    }
};
struct EpiResid {
    static constexpr bool PERM = false;
    const float* xp; const float* xs; float* out; int grow0; int from_x;
    __device__ __forceinline__ void operator()(const f32x4 (&acc)[2][2][4][2], const Unit& u, int wr, int wc, int fr, int fq) const {
        const int row0 = grow0 + u.pm * BM + wr * 64 + fr, col0 = u.pn * BM + wc * 32 + 4 * fq;
#pragma unroll
        for (int ai = 0; ai < 2; ++ai)
#pragma unroll
            for (int m = 0; m < 4; ++m) { const int gr = row0 + ai * HALF + m * 16;
                float* op = out + (size_t)gr * DM + col0;
                const float* bp = from_x ? (gr < NPROMPT ? xp + (size_t)gr * DM : xs + (size_t)(gr - NPROMPT) * DM) + col0 : op;
#pragma unroll
                for (int bj = 0; bj < 2; ++bj)
#pragma unroll
                    for (int n = 0; n < 2; ++n) { const f32x4 b = *(const f32x4*)(bp + bj * HALF + n * 16); *(f32x4*)(op + bj * HALF + n * 16) = b + acc[ai][bj][m][n]; } }
    }
};
constexpr int XRS = 2 * DM;
__device__ __forceinline__ f32x4 unpack4(const u32x2 w) { f32x4 v; v[0] = bf_lo(w.x); v[1] = bf_hi(w.x); v[2] = bf_lo(w.y); v[3] = bf_hi(w.y); return v; }
struct EpiResidSS {
    static constexpr bool PERM = false;
    bf16_t* xr; int grow0; float* SSo; bf16_t* XN; const float* gain;
    __device__ __forceinline__ void operator()(const f32x4 (&acc)[2][2][4][2], const Unit& u, int wr, int wc, int fr, int fq) const {
        const int rowl0 = u.pm * BM + wr * 64 + fr, col0 = u.pn * BM + wc * 32 + 4 * fq;
        f32x4 gv[2][2];
        if (XN) {
#pragma unroll
            for (int bj = 0; bj < 2; ++bj)
#pragma unroll
                for (int n = 0; n < 2; ++n) gv[bj][n] = *(const f32x4*)(gain + col0 + bj * HALF + n * 16); }
        u32x2 bw[2][4][2][2];
#pragma unroll
        for (int ai = 0; ai < 2; ++ai)
#pragma unroll
            for (int m = 0; m < 4; ++m) { const bf16_t* bp = xr + (size_t)(grow0 + rowl0 + ai * HALF + m * 16) * XRS + col0;
#pragma unroll
                for (int bj = 0; bj < 2; ++bj)
#pragma unroll
                    for (int n = 0; n < 2; ++n) bw[ai][m][bj][n] = *(const u32x2*)(bp + bj * HALF + n * 16); }
#pragma unroll
        for (int ai = 0; ai < 2; ++ai) {
            f32x4 bv[4][2][2];
#pragma unroll
            for (int m = 0; m < 4; ++m)
#pragma unroll
                for (int bj = 0; bj < 2; ++bj)
#pragma unroll
                    for (int n = 0; n < 2; ++n) bv[m][bj][n] = unpack4(bw[ai][m][bj][n]);
#pragma unroll
            for (int m = 0; m < 4; ++m) { const int rl = rowl0 + ai * HALF + m * 16, gr = grow0 + rl;
                bf16_t* op = xr + (size_t)gr * XRS + col0;
                float ss = 0.f;
#pragma unroll
                for (int bj = 0; bj < 2; ++bj)
#pragma unroll
                    for (int n = 0; n < 2; ++n) { const f32x4 v = bv[m][bj][n] + acc[ai][bj][m][n]; *(u32x2*)(op + bj * HALF + n * 16) = pack4(v);
                        ss += (v[0] * v[0] + v[1] * v[1]) + (v[2] * v[2] + v[3] * v[3]);
                        if (XN) *(u32x2*)(XN + (size_t)rl * DM + col0 + bj * HALF + n * 16) = pack4(v * gv[bj][n]); }
                { auto r = __builtin_amdgcn_permlane16_swap(__float_as_uint(ss), __float_as_uint(ss), false, false); ss = __uint_as_float(r[0]) + __uint_as_float(r[1]); }
                { auto r = __builtin_amdgcn_permlane32_swap(__float_as_uint(ss), __float_as_uint(ss), false, false); ss = __uint_as_float(r[0]) + __uint_as_float(r[1]); }
                if (fq == 0) (void)__hip_atomic_fetch_add(SSo + gr, ss, __ATOMIC_RELAXED, __HIP_MEMORY_SCOPE_AGENT); } }
    }
};
struct EpiWin {
    static constexpr bool PERM = true;
    bf16_t* QKVU; bf16_t* GATES; const float* rope; int grow0; bf16_t* A3;
    __device__ __forceinline__ void operator()(const f32x4 (&acc)[2][2][4][2], const Unit& u, int wr, int wc, int fr, int fq) const {
        const int rowl0 = u.pm * BM + wr * 64 + fr, pn = u.pn;
        if (pn < 8) {
            const float sc = pn < 4 ? 0.125f * 1.4426950408889634f : 1.0f  ; const int g8 = 4 * (wc & 1) + fq;
#pragma unroll
            for (int ai = 0; ai < 2; ++ai) {
                f32x4 csv[4], snv[4];
#pragma unroll
                for (int m = 0; m < 4; ++m) { const int gr = grow0 + rowl0 + ai * HALF + m * 16, pos = gr < NPROMPT ? (gr & (LPR - 1)) : (gr & (LSA - 1));
                    csv[m] = *(const f32x4*)(rope + pos * 64 + 4 * g8); snv[m] = *(const f32x4*)(rope + pos * 64 + 32 + 4 * g8); }
#pragma unroll
                for (int m = 0; m < 4; ++m) { const int rl = rowl0 + ai * HALF + m * 16;
                    const f32x4 cs = csv[m] * sc, sn = snv[m] * sc;
#pragma unroll
                    for (int bj = 0; bj < 2; ++bj) { const f32x4 v0 = acc[ai][bj][m][0], v1 = acc[ai][bj][m][1];
                        const f32x4 o1 = v0 * cs - v1 * sn, o2 = v1 * cs + v0 * sn;
                        bf16_t* p = QKVU + (size_t)rl * 4096 + (4 * pn + 2 * bj + (wc >> 1)) * 64 + 4 * g8;
                        *(u32x2*)p = pack4(o1); *(u32x2*)(p + 32) = pack4(o2); } } }
        } else if (pn >= 12 && pn < 16) {
            const int ucol = (pn - 12) * BM + wc * 32 + 8 * fq;
#pragma unroll
            for (int ai = 0; ai < 2; ++ai)
#pragma unroll
                for (int m = 0; m < 4; ++m) { const int rl = rowl0 + ai * HALF + m * 16;
#pragma unroll
                    for (int bj = 0; bj < 2; ++bj) { const int uc = ucol + bj * HALF;
                        *(u32x4*)(A3 + ((size_t)((uc >> 4) * 512 + (rl >> 5)) * 768 + (rl & 31) * 16 + (uc & 15))) = pack8(acc[ai][bj][m][0], acc[ai][bj][m][1]); } }
        } else if (pn < 12) {
            const int col0 = pn * BM + wc * 32 + 8 * fq;
#pragma unroll
            for (int ai = 0; ai < 2; ++ai)
#pragma unroll
                for (int m = 0; m < 4; ++m) { bf16_t* rowp = QKVU + (size_t)(rowl0 + ai * HALF + m * 16) * 4096 + col0;
#pragma unroll
                    for (int bj = 0; bj < 2; ++bj) *(u32x4*)(rowp + bj * HALF) = pack8(acc[ai][bj][m][0], acc[ai][bj][m][1]); }
        } else {
            const int col0 = (pn - 16) * BM + wc * 32 + 8 * fq;
#pragma unroll
            for (int ai = 0; ai < 2; ++ai)
#pragma unroll
                for (int m = 0; m < 4; ++m) { bf16_t* rowp = GATES + (size_t)(rowl0 + ai * HALF + m * 16) * 4096 + col0;
#pragma unroll
                    for (int bj = 0; bj < 2; ++bj) { f32x4 v0 = acc[ai][bj][m][0], v1 = acc[ai][bj][m][1];
#pragma unroll
                        for (int e = 0; e < 4; ++e) { v0[e] = sigmoidf_(v0[e]); v1[e] = sigmoidf_(v1[e]); }
                        *(u32x4*)(rowp + bj * HALF) = pack8(v0, v1); } }
        }
    }
};
struct EpiAttnProj {
    static constexpr bool PERM = true;
    const bf16_t* GATES; bf16_t* MIX;
    __device__ __forceinline__ void operator()(const f32x4 (&acc)[2][2][4][2], const Unit& u, int wr, int wc, int fr, int fq) const {
        const int row0 = u.pm * BM + wr * 64 + fr, col0 = u.pn * BM + wc * 32 + 8 * fq;
        u32x4 gwv[2][4][2];
#pragma unroll
        for (int ai = 0; ai < 2; ++ai)
#pragma unroll
            for (int m = 0; m < 4; ++m)
#pragma unroll
                for (int bj = 0; bj < 2; ++bj) gwv[ai][m][bj] = *(const u32x4*)(GATES + (size_t)(row0 + ai * HALF + m * 16) * 4096 + col0 + bj * HALF);
#pragma unroll
        for (int ai = 0; ai < 2; ++ai) {
#pragma unroll
            for (int m = 0; m < 4; ++m) { const int r = row0 + ai * HALF + m * 16;
#pragma unroll
                for (int bj = 0; bj < 2; ++bj) { const u32x4 gw = gwv[ai][m][bj];
                    f32x4 v0 = acc[ai][bj][m][0], v1 = acc[ai][bj][m][1];
                    v0[0] *= bf_lo(gw.x); v0[1] *= bf_hi(gw.x); v0[2] *= bf_lo(gw.y); v0[3] *= bf_hi(gw.y);
                    v1[0] *= bf_lo(gw.z); v1[1] *= bf_hi(gw.z); v1[2] *= bf_lo(gw.w); v1[3] *= bf_hi(gw.w);
                    *(u32x4*)(MIX + (size_t)r * DM + col0 + bj * HALF) = pack8(v0, v1); } } }
    }
};
struct EpiGlu {
    static constexpr bool PERM = true;
    const bf16_t* GATES; bf16_t* MIX;
    __device__ __forceinline__ void operator()(const f32x4 (&acc)[2][2][4][2], const Unit& u, int wr, int wc, int fr, int fq) const {
        const int row0 = u.pm * BM + wr * 64 + fr, j0 = u.pn * 128 + wc * 16 + 4 * fq;
        u32x2 gwv[2][4][2], mwv[2][4][2];
#pragma unroll
        for (int ai = 0; ai < 2; ++ai)
#pragma unroll
            for (int m = 0; m < 4; ++m)
#pragma unroll
                for (int bj = 0; bj < 2; ++bj) { const int r = row0 + ai * HALF + m * 16, j = j0 + bj * 64;
                    gwv[ai][m][bj] = *(const u32x2*)(GATES + (size_t)r * 4096 + DM + j); mwv[ai][m][bj] = *(const u32x2*)(MIX + (size_t)r * DM + j); }
#pragma unroll
        for (int ai = 0; ai < 2; ++ai) {
#pragma unroll
            for (int m = 0; m < 4; ++m) { const int r = row0 + ai * HALF + m * 16;
#pragma unroll
                for (int bj = 0; bj < 2; ++bj) { const int j = j0 + bj * 64;
                    const u32x2 gw = gwv[ai][m][bj]; bf16_t* mp = MIX + (size_t)r * DM + j; const u32x2 mw = mwv[ai][m][bj];
                    const f32x4 a = acc[ai][bj][m][0], b = acc[ai][bj][m][1]; f32x4 o;
                    o[0] = a[0] * sigmoidf_(b[0]) * bf_lo(gw.x) + bf_lo(mw.x); o[1] = a[1] * sigmoidf_(b[1]) * bf_hi(gw.x) + bf_hi(mw.x);
                    o[2] = a[2] * sigmoidf_(b[2]) * bf_lo(gw.y) + bf_lo(mw.y); o[3] = a[3] * sigmoidf_(b[3]) * bf_hi(gw.y) + bf_hi(mw.y);
                    *(u32x2*)mp = pack4(o); } } }
    }
};
struct EpiSsmOut {
    static constexpr bool PERM = true;
    bf16_t* Z;
    __device__ __forceinline__ void operator()(const f32x4 (&acc)[2][2][4][2], const Unit& u, int wr, int wc, int fr, int fq) const {
        const int row0 = u.pm * BM + wr * 64 + fr, n00 = u.pn * BM + wc * 32 + 8 * fq;
#pragma unroll
        for (int ai = 0; ai < 2; ++ai)
#pragma unroll
            for (int m = 0; m < 4; ++m) { const int row = row0 + ai * HALF + m * 16, g = row >> 9, chunk = row & 511;
#pragma unroll
                for (int bj = 0; bj < 2; ++bj) { const int n0 = n00 + bj * HALF, j = n0 >> 4, ch0 = n0 & 15;
                    f32x4 v0 = acc[ai][bj][m][0], v1 = acc[ai][bj][m][1];
#pragma unroll
                    for (int e = 0; e < 4; ++e) { v0[e] = gelu_tanh(v0[e]); v1[e] = gelu_tanh(v1[e]); }
                    *(u32x4*)(Z + ((size_t)(chunk * 32 + j) * 1024 + g * 16 + ch0)) = pack8(v0, v1); } }
    }
};
}
namespace attn3 {
constexpr int KVBLK = 64, LDQ = 4096, LDK = 4096, TILE_B = 64 * 128 * 2;
constexpr float THR = 8.f;
typedef short v4i16_t __attribute__((ext_vector_type(4)));
#define SBAR() __builtin_amdgcn_sched_barrier(0)
__device__ __forceinline__ s16x4 vtr(const LAS char* p) { return __builtin_bit_cast(s16x4, __builtin_amdgcn_ds_read_tr16_b64_v4i16((LAS v4i16_t*)p)); }
__device__ __forceinline__ int offK(int row, int ch16) { return 256 * row + 16 * (ch16 ^ (row & 15)); }
__device__ __forceinline__ int offV(int row, int ch16) { return 256 * row + 32 * ((ch16 >> 1) ^ (row & 7)) + 16 * (ch16 & 1); }
__device__ __forceinline__ float xmax4(float v) {
    { auto r = __builtin_amdgcn_permlane16_swap(__float_as_uint(v), __float_as_uint(v), false, false); v = fmaxf(__uint_as_float(r[0]), __uint_as_float(r[1])); }
    { auto r = __builtin_amdgcn_permlane32_swap(__float_as_uint(v), __float_as_uint(v), false, false); v = fmaxf(__uint_as_float(r[0]), __uint_as_float(r[1])); }
    return v; }
__device__ __forceinline__ int xmaxi4(int v) {
    { auto r = __builtin_amdgcn_permlane16_swap((unsigned)v, (unsigned)v, false, false); v = max((int)r[0], (int)r[1]); }
    { auto r = __builtin_amdgcn_permlane32_swap((unsigned)v, (unsigned)v, false, false); v = max((int)r[0], (int)r[1]); }
    return v; }
__device__ __forceinline__ float xsum4(float v) {
    { auto r = __builtin_amdgcn_permlane16_swap(__float_as_uint(v), __float_as_uint(v), false, false); v = __uint_as_float(r[0]) + __uint_as_float(r[1]); }
    { auto r = __builtin_amdgcn_permlane32_swap(__float_as_uint(v), __float_as_uint(v), false, false); v = __uint_as_float(r[0]) + __uint_as_float(r[1]); }
    return v; }

__device__ __forceinline__ void attn_unit3(const bf16_t* __restrict__ Qb, const bf16_t* __restrict__ Kh, const bf16_t* __restrict__ Vh, bf16_t* __restrict__ An, const float* __restrict__ subln, float lam, int seq, LAS char* lds) {
  int tid_ = threadIdx.x; asm volatile("" : "+v"(tid_));
  const int tid = tid_, wid = __builtin_amdgcn_readfirstlane(tid >> 6), lane = tid & 63, i16 = lane & 15, g = lane >> 4, half = wid >> 2;
  LAS char* V_lds = lds; LAS char* K_lds = lds + 2 * TILE_B;
  LAS float* ws = (LAS float*)(lds + 4 * TILE_B) + wid * 64;
  bf16x8 qf[2][2];
  { const bf16_t* Qw = Qb + (long)(wid * 16 + i16) * LDQ + 8 * g;
#pragma unroll
    for (int m = 0; m < 2; ++m)
#pragma unroll
      for (int ks = 0; ks < 2; ++ks) qf[m][ks] = *reinterpret_cast<const bf16x8*>(Qw + 64 * m + 32 * ks); }
  f32x4 o[2][8];
#pragma unroll
  for (int m = 0; m < 2; ++m)
#pragma unroll
    for (int cb = 0; cb < 8; ++cb) o[m][cb] = (f32x4){0.f, 0.f, 0.f, 0.f};
  float l_reg[2] = {0.f, 0.f}, negm[2] = {0.f, 0.f};
  const int sr = tid >> 4, sc16 = tid & 15;
  const int kst0 = offK(sr, sc16), kst1 = offK(32 + sr, sc16), vst0 = offV(sr, sc16), vst1 = offV(32 + sr, sc16);
  const int tq = i16 >> 2, tp = i16 & 3;
  const int NT = seq / KVBLK;
  bf16x8 gk0, gk1, gv0, gv1;
#define LOADK(t) do { gk0 = *reinterpret_cast<const bf16x8*>(&Kh[(long)((t) * KVBLK + sr) * LDK + sc16 * 8]); gk1 = *reinterpret_cast<const bf16x8*>(&Kh[(long)((t) * KVBLK + 32 + sr) * LDK + sc16 * 8]); } while (0)
#define LOADV(t) do { gv0 = *reinterpret_cast<const bf16x8*>(&Vh[(long)((t) * KVBLK + sr) * LDK + sc16 * 8]); gv1 = *reinterpret_cast<const bf16x8*>(&Vh[(long)((t) * KVBLK + 32 + sr) * LDK + sc16 * 8]); } while (0)
#define WRITEK(t) do { LAS char* kb_ = K_lds + ((t) & 1) * TILE_B; *(LAS bf16x8*)(kb_ + kst0) = gk0; *(LAS bf16x8*)(kb_ + kst1) = gk1; } while (0)
#define WRITEV(t) do { LAS char* vb_ = V_lds + ((t) & 1) * TILE_B; *(LAS bf16x8*)(vb_ + vst0) = gv0; *(LAS bf16x8*)(vb_ + vst1) = gv1; } while (0)
  f32x4 s[2][4]; bf16x8 pa[2][2];
#define KRD(KF, kbase, kb0) do { _Pragma("unroll") for (int b = 0; b < 2; ++b) _Pragma("unroll") for (int m = 0; m < 2; ++m) _Pragma("unroll") for (int ks = 0; ks < 2; ++ks) \
      KF[b][m][ks] = *(const LAS bf16x8*)((kbase) + offK(16 * ((kb0) + b) + i16, 8 * m + 4 * ks + g)); } while (0)
#define QKM(KF, kb0) do { _Pragma("unroll") for (int b = 0; b < 2; ++b) _Pragma("unroll") for (int m = 0; m < 2; ++m) { \
      f32x4 c_ = (f32x4){negm[m], negm[m], negm[m], negm[m]}; \
      c_ = __builtin_amdgcn_mfma_f32_16x16x32_bf16(KF[b][m][0], qf[m][0], c_, 0, 0, 0); \
      s[m][(kb0) + b] = __builtin_amdgcn_mfma_f32_16x16x32_bf16(KF[b][m][1], qf[m][1], c_, 0, 0, 0); } } while (0)
#define VRD(VF, vbase, t) do { _Pragma("unroll") for (int cb = 0; cb < 8; ++cb) { \
      const int r0_ = 32 * (t) + 4 * g + tq, r1_ = r0_ + 16; \
      VF[cb][0] = vtr((vbase) + 256 * r0_ + 32 * (cb ^ (r0_ & 7)) + 8 * tp); VF[cb][1] = vtr((vbase) + 256 * r1_ + 32 * (cb ^ (r1_ & 7)) + 8 * tp); } } while (0)
#define PVB(VF, t) do { _Pragma("unroll") for (int cb = 0; cb < 8; ++cb) { const bf16x8 vf_ = (bf16x8){VF[cb][0][0], VF[cb][0][1], VF[cb][0][2], VF[cb][0][3], VF[cb][1][0], VF[cb][1][1], VF[cb][1][2], VF[cb][1][3]}; \
      o[0][cb] = __builtin_amdgcn_mfma_f32_16x16x32_bf16(pa[0][t], vf_, o[0][cb], 0, 0, 0); \
      o[1][cb] = __builtin_amdgcn_mfma_f32_16x16x32_bf16(pa[1][t], vf_, o[1][cb], 0, 0, 0); } } while (0)
#define MSEG(tqi, tv, DO_QK) do { const LAS char* vbp_ = V_lds + ((tv) & 1) * TILE_B; const LAS char* kbp_ = K_lds + ((tqi) & 1) * TILE_B; \
    s16x4 va[8][2], vb[8][2]; bf16x8 ka[2][2][2], kc[2][2][2]; \
    VRD(va, vbp_, 0); SBAR(); \
    VRD(vb, vbp_, 1); PVB(va, 0); SBAR(); \
    if (DO_QK) KRD(ka, kbp_, 0); PVB(vb, 1); SBAR(); \
    if (DO_QK) { KRD(kc, kbp_, 2); QKM(ka, 0); SBAR(); QKM(kc, 2); } } while (0)
#define SMSEG(FIRST) do { \
    _Pragma("unroll") for (int m = 0; m < 2; ++m) { asm volatile("" : "+v"(s[m][0]), "+v"(s[m][1]), "+v"(s[m][2]), "+v"(s[m][3])); \
      bool resc_; float dl; \
      if (FIRST) { float mx = fmaxf(fmaxf(s[m][0][0], s[m][0][1]), fmaxf(s[m][0][2], s[m][0][3])); \
        _Pragma("unroll") for (int kb = 1; kb < 4; ++kb) mx = fmaxf(mx, fmaxf(fmaxf(s[m][kb][0], s[m][kb][1]), fmaxf(s[m][kb][2], s[m][kb][3]))); \
        dl = xmax4(mx); resc_ = true; \
      } else {       \
        int im = max(max(__float_as_int(s[m][0][0]), __float_as_int(s[m][0][1])), max(__float_as_int(s[m][0][2]), __float_as_int(s[m][0][3]))); \
        _Pragma("unroll") for (int kb = 1; kb < 4; ++kb) im = max(im, max(max(__float_as_int(s[m][kb][0]), __float_as_int(s[m][kb][1])), max(__float_as_int(s[m][kb][2]), __float_as_int(s[m][kb][3])))); \
        im = xmaxi4(im); resc_ = __builtin_expect(__any(im > 0x41000000  ), 0); dl = __int_as_float(max(im, 0)); } \
      if (resc_) { \
        _Pragma("unroll") for (int kb = 0; kb < 4; ++kb) s[m][kb] = s[m][kb] - dl; \
        negm[m] -= dl; \
        if (!(FIRST)) { const float al = __builtin_amdgcn_exp2f(-dl); l_reg[m] *= al; if (g == 0) ws[16 * m + i16] = al; \
          const f32x4 a4 = *(const LAS f32x4*)(ws + 16 * m + 4 * g); \
          _Pragma("unroll") for (int cb = 0; cb < 8; ++cb) o[m][cb] = o[m][cb] * a4; } } \
      f32x4 e4_ = {0.f, 0.f, 0.f, 0.f}; \
      _Pragma("unroll") for (int kb = 0; kb < 4; ++kb) { _Pragma("unroll") for (int r = 0; r < 4; ++r) s[m][kb][r] = __builtin_amdgcn_exp2f(s[m][kb][r]); e4_ += s[m][kb]; }        \
      const float ps = (e4_[0] + e4_[1]) + (e4_[2] + e4_[3]); \
      l_reg[m] += xsum4(ps); \
      _Pragma("unroll") for (int t = 0; t < 2; ++t) { u32x4 w_; w_.x = cvt_pk_bf16(s[m][2 * t][0], s[m][2 * t][1]); w_.y = cvt_pk_bf16(s[m][2 * t][2], s[m][2 * t][3]); \
        w_.z = cvt_pk_bf16(s[m][2 * t + 1][0], s[m][2 * t + 1][1]); w_.w = cvt_pk_bf16(s[m][2 * t + 1][2], s[m][2 * t + 1][3]); pa[m][t] = __builtin_bit_cast(bf16x8, w_); } } } while (0)
#define BAR() __syncthreads()
  LOADK(0); LOADV(0); WRITEK(0); WRITEV(0); LOADK(1); WRITEK(1);
  if (2 < NT) LOADK(2); LOADV(1);
  BAR();
  { bf16x8 ka[2][2][2], kc[2][2][2]; KRD(ka, K_lds, 0); KRD(kc, K_lds, 2); QKM(ka, 0); QKM(kc, 2); } SMSEG(true);
  BAR();
  if (half == 0) {
    for (int n = 0; n + 1 < NT; ++n) {
      SBAR(); MSEG(n + 1, n, true); SBAR(); BAR();
      SMSEG(false); if (n + 2 < NT) WRITEK(n + 2); WRITEV(n + 1); if (n + 3 < NT) LOADK(n + 3); if (n + 2 < NT) LOADV(n + 2); SBAR(); BAR();
    }
    MSEG(0, NT - 1, false); BAR(); BAR();
  } else {
    if (2 < NT) WRITEK(2); WRITEV(1); if (3 < NT) LOADK(3); if (2 < NT) LOADV(2); BAR();
    for (int n = 0; n + 1 < NT; ++n) {
      SBAR(); MSEG(n + 1, n, true); SBAR(); BAR();
      SMSEG(false); if (n + 3 < NT) WRITEK(n + 3); if (n + 2 < NT) WRITEV(n + 2); if (n + 4 < NT) LOADK(n + 4); if (n + 3 < NT) LOADV(n + 3); SBAR(); BAR();
    }
    MSEG(0, NT - 1, false); BAR();
  }
  if (g == 0) { ws[i16] = __builtin_amdgcn_rcpf(l_reg[0]); ws[16 + i16] = lam * __builtin_amdgcn_rcpf(l_reg[1]); }
  const f32x4 il0 = *(const LAS f32x4*)(ws + 4 * g), il1 = *(const LAS f32x4*)(ws + 16 + 4 * g);
  f32x4 ss = (f32x4){0.f, 0.f, 0.f, 0.f};
#pragma unroll
  for (int cb = 0; cb < 8; ++cb) { o[0][cb] = o[0][cb] * il0 - o[1][cb] * il1; ss = ss + o[0][cb] * o[0][cb]; }
  f32x4 rs;
#pragma unroll
  for (int r = 0; r < 4; ++r) rs[r] = 0.8f / sqrtf(sum16(ss[r]) * (1.f / 128.f) + EPS);
  bf16_t* Aw = An + (long)(wid * 16 + 4 * g) * 1024 + i16;
#pragma unroll
  for (int cb = 0; cb < 8; ++cb) { const float gn = subln[16 * cb + i16];
#pragma unroll
    for (int r = 0; r < 4; ++r) Aw[(long)r * 1024 + 16 * cb] = (bf16_t)(cvt_pk_bf16(o[0][cb][r] * rs[r] * gn, 0.f) & 0xffffu); }
  BAR();
#undef LOADK
#undef LOADV
#undef WRITEK
#undef WRITEV
#undef KRD
#undef QKM
#undef VRD
#undef PVB
#undef MSEG
#undef SMSEG
#undef BAR
}
#undef SBAR
}
__device__ __forceinline__ void dsincos(double x, double& s, double& c) {
    const double k = __builtin_rint(x * 0.15915494309189535);
    double r = __builtin_fma(-k, 6.283185307179586, x); r = __builtin_fma(-k, 2.4492935982947064e-16, r);
    const double r2 = r * r;
    double ps = 1.1309962886447718e-31;
    ps = ps * r2 - 9.183689863795546e-29;
    ps = ps * r2 + 6.446950284384474e-26;
    ps = ps * r2 - 3.8681701706306835e-23;
    ps = ps * r2 + 1.9572941063391263e-20;
    ps = ps * r2 - 8.22063524662433e-18;
    ps = ps * r2 + 2.8114572543455206e-15;
    ps = ps * r2 - 7.647163731819816e-13;
    ps = ps * r2 + 1.6059043836821613e-10;
    ps = ps * r2 - 2.505210838544172e-08;
    ps = ps * r2 + 2.7557319223985893e-06;
    ps = ps * r2 - 0.0001984126984126984;
    ps = ps * r2 + 0.008333333333333333;
    ps = ps * r2 - 0.16666666666666666;
    s = r + r * r2 * ps;
    double pc = -3.7699876288159054e-33;
    pc = pc * r2 + 3.279889237069838e-30;
    pc = pc * r2 - 2.4795962632247972e-27;
    pc = pc * r2 + 1.6117375710961184e-24;
    pc = pc * r2 - 8.896791392450574e-22;
    pc = pc * r2 + 4.110317623312165e-19;
    pc = pc * r2 - 1.5619206968586225e-16;
    pc = pc * r2 + 4.779477332387385e-14;
    pc = pc * r2 - 1.1470745597729725e-11;
    pc = pc * r2 + 2.08767569878681e-09;
    pc = pc * r2 - 2.755731922398589e-07;
    pc = pc * r2 + 2.48015873015873e-05;
    pc = pc * r2 - 0.001388888888888889;
    pc = pc * r2 + 0.041666666666666664;
    pc = pc * r2 - 0.5;
    c = 1.0 + r2 * pc;
}
__device__ __forceinline__ double dexp(double x) {
    const double k = __builtin_rint(x * 1.4426950408889634);
    double r = __builtin_fma(-k, 0.6931471805599453, x); r = __builtin_fma(-k, 2.3190468138462996e-17, r);
    double p = 1.6059043836821613e-10;
    p = p * r + 2.08767569878681e-09; p = p * r + 2.505210838544172e-08; p = p * r + 2.755731922398589e-07; p = p * r + 2.7557319223985893e-06; p = p * r + 2.48015873015873e-05;
    p = p * r + 0.0001984126984126984; p = p * r + 0.001388888888888889; p = p * r + 0.008333333333333333; p = p * r + 0.041666666666666664; p = p * r + 0.16666666666666666; p = p * r + 0.5; p = p * r + 1.0; p = p * r + 1.0;
    const long long bits = ((long long)k + 1023LL) << 52;
    return p * __builtin_bit_cast(double, bits);
}

__device__ __forceinline__ void rms_row_bf16(const float* xrow, const float* gain, bf16_t* orow, int lane) {
    const f32x4* xr = (const f32x4*)xrow + lane; const f32x4* gr = (const f32x4*)gain + lane;
    f32x4 v[8]; float s = 0.f;
#pragma unroll
    for (int j = 0; j < 8; ++j) { v[j] = xr[64 * j]; s += (v[j].x * v[j].x + v[j].y * v[j].y) + (v[j].z * v[j].z + v[j].w * v[j].w); }
    f32x4 gv[8];
#pragma unroll
    for (int j = 0; j < 8; ++j) gv[j] = gr[64 * j];
    const float rs = 1.0f / sqrtf(wave_sum(s) * (1.f / DM) + EPS);
    u32x2* o8 = (u32x2*)orow + lane;
#pragma unroll
    for (int j = 0; j < 8; ++j) { const f32x4 g = gv[j]; u32x2 w; w.x = cvt_pk_bf16(v[j].x * rs * g.x, v[j].y * rs * g.y); w.y = cvt_pk_bf16(v[j].z * rs * g.z, v[j].w * rs * g.w); o8[64 * j] = w; }
}
__device__ __forceinline__ void rms_row2_bf16(const float* xrow0, const float* xrow1, const float* gain, bf16_t* orow0, bf16_t* orow1, int lane) {
    const f32x4* xa = (const f32x4*)xrow0 + lane; const f32x4* xb = (const f32x4*)xrow1 + lane; const f32x4* gr = (const f32x4*)gain + lane;
    f32x4 va[8], vb[8]; float sa = 0.f, sb = 0.f;
#pragma unroll
    for (int j = 0; j < 8; ++j) { va[j] = xa[64 * j]; vb[j] = xb[64 * j]; }
    f32x4 gv[8];
#pragma unroll
    for (int j = 0; j < 8; ++j) gv[j] = gr[64 * j];
#pragma unroll
    for (int j = 0; j < 8; ++j) { sa += (va[j].x * va[j].x + va[j].y * va[j].y) + (va[j].z * va[j].z + va[j].w * va[j].w); sb += (vb[j].x * vb[j].x + vb[j].y * vb[j].y) + (vb[j].z * vb[j].z + vb[j].w * vb[j].w); }
    const float ra = 1.0f / sqrtf(wave_sum(sa) * (1.f / DM) + EPS), rb = 1.0f / sqrtf(wave_sum(sb) * (1.f / DM) + EPS);
    u32x2* oa = (u32x2*)orow0 + lane; u32x2* ob = (u32x2*)orow1 + lane;
#pragma unroll
    for (int j = 0; j < 8; ++j) { const f32x4 g = gv[j]; u32x2 w;
        w.x = cvt_pk_bf16(va[j].x * ra * g.x, va[j].y * ra * g.y); w.y = cvt_pk_bf16(va[j].z * ra * g.z, va[j].w * ra * g.w); oa[64 * j] = w;
        w.x = cvt_pk_bf16(vb[j].x * rb * g.x, vb[j].y * rb * g.y); w.y = cvt_pk_bf16(vb[j].z * rb * g.z, vb[j].w * rb * g.w); ob[64 * j] = w; }
}
__device__ __forceinline__ void rms_row2_bf16_xr(const float* xrow0, const float* xrow1, const float* gain, bf16_t* orow0, bf16_t* orow1, bf16_t* rrow0, bf16_t* rrow1, int lane) {
    const f32x4* xa = (const f32x4*)xrow0 + lane; const f32x4* xb = (const f32x4*)xrow1 + lane; const f32x4* gr = (const f32x4*)gain + lane;
    f32x4 va[8], vb[8]; float sa = 0.f, sb = 0.f;
#pragma unroll
    for (int j = 0; j < 8; ++j) { va[j] = xa[64 * j]; vb[j] = xb[64 * j]; }
    f32x4 gv[8];
#pragma unroll
    for (int j = 0; j < 8; ++j) gv[j] = gr[64 * j];
#pragma unroll
    for (int j = 0; j < 8; ++j) { sa += (va[j].x * va[j].x + va[j].y * va[j].y) + (va[j].z * va[j].z + va[j].w * va[j].w); sb += (vb[j].x * vb[j].x + vb[j].y * vb[j].y) + (vb[j].z * vb[j].z + vb[j].w * vb[j].w); }
    const float ra = 1.0f / sqrtf(wave_sum(sa) * (1.f / DM) + EPS), rb = 1.0f / sqrtf(wave_sum(sb) * (1.f / DM) + EPS);
    u32x2* oa = (u32x2*)orow0 + lane; u32x2* ob = (u32x2*)orow1 + lane; u32x2* qa = (u32x2*)rrow0 + lane; u32x2* qb = (u32x2*)rrow1 + lane;
#pragma unroll
    for (int j = 0; j < 8; ++j) { const f32x4 g = gv[j]; u32x2 w;
        w.x = cvt_pk_bf16(va[j].x * ra * g.x, va[j].y * ra * g.y); w.y = cvt_pk_bf16(va[j].z * ra * g.z, va[j].w * ra * g.w); oa[64 * j] = w;
        w.x = cvt_pk_bf16(vb[j].x * rb * g.x, vb[j].y * rb * g.y); w.y = cvt_pk_bf16(vb[j].z * rb * g.z, vb[j].w * rb * g.w); ob[64 * j] = w;
        w.x = cvt_pk_bf16(va[j].x, va[j].y); w.y = cvt_pk_bf16(va[j].z, va[j].w); qa[64 * j] = w;
        w.x = cvt_pk_bf16(vb[j].x, vb[j].y); w.y = cvt_pk_bf16(vb[j].z, vb[j].w); qb[64 * j] = w; }
}
__device__ __forceinline__ void rms_row_f32_inplace(float* xrow, const float* gain, int lane) {
    f32x4* xr = (f32x4*)xrow + lane; const f32x4* gr = (const f32x4*)gain + lane;
    f32x4 v[8]; float s = 0.f;
#pragma unroll
    for (int j = 0; j < 8; ++j) { v[j] = xr[64 * j]; s += (v[j].x * v[j].x + v[j].y * v[j].y) + (v[j].z * v[j].z + v[j].w * v[j].w); }
    const float rs = 1.0f / sqrtf(wave_sum(s) * (1.f / DM) + EPS);
#pragma unroll
    for (int j = 0; j < 8; ++j) { const f32x4 g = gr[64 * j]; xr[64 * j] = v[j] * rs * g; }
}
__device__ __forceinline__ void rms_row_f32_ss(float* xrow, const float* gain, float ss, int lane) {
    f32x4* xr = (f32x4*)xrow + lane; const f32x4* gr = (const f32x4*)gain + lane;
    const float rs = 1.0f / sqrtf(ss * (1.f / DM) + EPS);
#pragma unroll
    for (int j = 0; j < 8; ++j) { const f32x4 g = gr[64 * j]; xr[64 * j] = xr[64 * j] * rs * g; }
}
__device__ __forceinline__ void final_norm_rows(float* out, const float* gain, const float* SS, int gp, int Mp, int gw, int NGW, int lane) {
    const f32x4* gr = (const f32x4*)gain + lane; f32x4 gv[8];
#pragma unroll
    for (int j = 0; j < 8; ++j) gv[j] = gr[64 * j];
    for (int m = gw; m < Mp; m += 2 * NGW) { const int m2 = (m + NGW < Mp) ? m + NGW : m;
        f32x4* xa = (f32x4*)(out + (size_t)(gp + m) * DM) + lane; f32x4* xb = (f32x4*)(out + (size_t)(gp + m2) * DM) + lane;
        const u32x2* ba = (const u32x2*)(out + (size_t)(gp + m) * DM) + lane; const u32x2* bb = (const u32x2*)(out + (size_t)(gp + m2) * DM) + lane;
        const float ssa = SS[gp + m], ssb = SS[gp + m2]; u32x2 wa[8], wb[8];
#pragma unroll
        for (int j = 0; j < 8; ++j) { wa[j] = ba[64 * j]; wb[j] = bb[64 * j]; }
        const float ra = 1.0f / sqrtf(ssa * (1.f / DM) + EPS), rb = 1.0f / sqrtf(ssb * (1.f / DM) + EPS);
        f32x4 va[8], vb[8];
#pragma unroll
        for (int j = 0; j < 8; ++j) { va[j][0] = bf_lo(wa[j].x); va[j][1] = bf_hi(wa[j].x); va[j][2] = bf_lo(wa[j].y); va[j][3] = bf_hi(wa[j].y);
            vb[j][0] = bf_lo(wb[j].x); vb[j][1] = bf_hi(wb[j].x); vb[j][2] = bf_lo(wb[j].y); vb[j][3] = bf_hi(wb[j].y); }
        if (m2 != m) {
#pragma unroll
            for (int j = 0; j < 8; ++j) { xa[64 * j] = va[j] * ra * gv[j]; xb[64 * j] = vb[j] * rb * gv[j]; }
        } else {
#pragma unroll
            for (int j = 0; j < 8; ++j) xa[64 * j] = va[j] * ra * gv[j];
        } }
}
__device__ __forceinline__ void attn_combine_row(const bf16_t* od, const float* subln, float lam, bf16_t* an, int lane) {
    const u32x4* p0 = (const u32x4*)(od + lane * 16); const u32x4* p1 = (const u32x4*)(od + 1024 + lane * 16);
    const u32x4 a0 = p0[0], a1 = p0[1], b0 = p1[0], b1 = p1[1];
    float d[16];
    const unsigned aw[8] = {a0.x, a0.y, a0.z, a0.w, a1.x, a1.y, a1.z, a1.w}, bw[8] = {b0.x, b0.y, b0.z, b0.w, b1.x, b1.y, b1.z, b1.w};
    float ss = 0.f;
#pragma unroll
    for (int i = 0; i < 8; ++i) { d[2 * i] = bf_lo(aw[i]) - lam * bf_lo(bw[i]); d[2 * i + 1] = bf_hi(aw[i]) - lam * bf_hi(bw[i]); ss += d[2 * i] * d[2 * i] + d[2 * i + 1] * d[2 * i + 1]; }
    ss = sum8(ss);
    const float rs = 0.8f / sqrtf(ss * (1.f / 128.f) + EPS);
    const float* g = subln + (lane & 7) * 16;
    u32x4 w0, w1;
    w0.x = cvt_pk_bf16(d[0] * rs * g[0], d[1] * rs * g[1]); w0.y = cvt_pk_bf16(d[2] * rs * g[2], d[3] * rs * g[3]); w0.z = cvt_pk_bf16(d[4] * rs * g[4], d[5] * rs * g[5]); w0.w = cvt_pk_bf16(d[6] * rs * g[6], d[7] * rs * g[7]);
    w1.x = cvt_pk_bf16(d[8] * rs * g[8], d[9] * rs * g[9]); w1.y = cvt_pk_bf16(d[10] * rs * g[10], d[11] * rs * g[11]); w1.z = cvt_pk_bf16(d[12] * rs * g[12], d[13] * rs * g[13]); w1.w = cvt_pk_bf16(d[14] * rs * g[14], d[15] * rs * g[15]);
    u32x4* o = (u32x4*)(an + lane * 16); o[0] = w0; o[1] = w1;
}
__device__ __forceinline__ void xsoftmax_head(const float* sc, bf16_t* prow, int l16) {
    const f32x4* sp = (const f32x4*)(sc + l16 * 16); f32x4 v[4]; float mx = -3.0e38f;
#pragma unroll
    for (int q = 0; q < 4; ++q) { v[q] = sp[q]; mx = fmaxf(mx, fmaxf(fmaxf(v[q].x, v[q].y), fmaxf(v[q].z, v[q].w))); }
    mx = max16(mx);
    float s = 0.f;
#pragma unroll
    for (int q = 0; q < 4; ++q) { v[q].x = __expf(v[q].x - mx); v[q].y = __expf(v[q].y - mx); v[q].z = __expf(v[q].z - mx); v[q].w = __expf(v[q].w - mx); s += (v[q].x + v[q].y) + (v[q].z + v[q].w); }
    s = sum16(s);
    const float inv = 1.0f / s;
    u32x4 w0, w1;
    w0.x = cvt_pk_bf16(v[0].x * inv, v[0].y * inv); w0.y = cvt_pk_bf16(v[0].z * inv, v[0].w * inv); w0.z = cvt_pk_bf16(v[1].x * inv, v[1].y * inv); w0.w = cvt_pk_bf16(v[1].z * inv, v[1].w * inv);
    w1.x = cvt_pk_bf16(v[2].x * inv, v[2].y * inv); w1.y = cvt_pk_bf16(v[2].z * inv, v[2].w * inv); w1.z = cvt_pk_bf16(v[3].x * inv, v[3].y * inv); w1.w = cvt_pk_bf16(v[3].z * inv, v[3].w * inv);
    u32x4* o = (u32x4*)(prow + l16 * 16); o[0] = w0; o[1] = w1;
}
__device__ __forceinline__ void xsoftmax_head2_bf16(const bf16_t* sc0, bf16_t* p0, const bf16_t* sc1, bf16_t* p1, int l16) {
    const u32x4* s0 = (const u32x4*)(sc0 + l16 * 16); const u32x4* s1 = (const u32x4*)(sc1 + l16 * 16);
    const u32x4 a0 = s0[0], a1 = s0[1], b0 = s1[0], b1 = s1[1];
    const unsigned aw[8] = {a0.x, a0.y, a0.z, a0.w, a1.x, a1.y, a1.z, a1.w}, bw[8] = {b0.x, b0.y, b0.z, b0.w, b1.x, b1.y, b1.z, b1.w};
    float va[16], vb[16]; float ma = -3.0e38f, mb = -3.0e38f;
#pragma unroll
    for (int i = 0; i < 8; ++i) { va[2 * i] = bf_lo(aw[i]); va[2 * i + 1] = bf_hi(aw[i]); vb[2 * i] = bf_lo(bw[i]); vb[2 * i + 1] = bf_hi(bw[i]);
        ma = fmaxf(ma, fmaxf(va[2 * i], va[2 * i + 1])); mb = fmaxf(mb, fmaxf(vb[2 * i], vb[2 * i + 1])); }
    ma = max16(ma); mb = max16(mb);
    float sa = 0.f, sb = 0.f;
#pragma unroll
    for (int i = 0; i < 16; ++i) { va[i] = __expf(va[i] - ma); vb[i] = __expf(vb[i] - mb); sa += va[i]; sb += vb[i]; }
    sa = sum16(sa); sb = sum16(sb);
    const float ia = 1.0f / sa, ib = 1.0f / sb;
    u32x4 w0, w1;
    w0.x = cvt_pk_bf16(va[0] * ia, va[1] * ia); w0.y = cvt_pk_bf16(va[2] * ia, va[3] * ia); w0.z = cvt_pk_bf16(va[4] * ia, va[5] * ia); w0.w = cvt_pk_bf16(va[6] * ia, va[7] * ia);
    w1.x = cvt_pk_bf16(va[8] * ia, va[9] * ia); w1.y = cvt_pk_bf16(va[10] * ia, va[11] * ia); w1.z = cvt_pk_bf16(va[12] * ia, va[13] * ia); w1.w = cvt_pk_bf16(va[14] * ia, va[15] * ia);
    { u32x4* o = (u32x4*)(p0 + l16 * 16); o[0] = w0; o[1] = w1; }
    w0.x = cvt_pk_bf16(vb[0] * ib, vb[1] * ib); w0.y = cvt_pk_bf16(vb[2] * ib, vb[3] * ib); w0.z = cvt_pk_bf16(vb[4] * ib, vb[5] * ib); w0.w = cvt_pk_bf16(vb[6] * ib, vb[7] * ib);
    w1.x = cvt_pk_bf16(vb[8] * ib, vb[9] * ib); w1.y = cvt_pk_bf16(vb[10] * ib, vb[11] * ib); w1.z = cvt_pk_bf16(vb[12] * ib, vb[13] * ib); w1.w = cvt_pk_bf16(vb[14] * ib, vb[15] * ib);
    { u32x4* o = (u32x4*)(p1 + l16 * 16); o[0] = w0; o[1] = w1; }
}
__device__ __forceinline__ void xsoftmax_row(const float* sc, bf16_t* prow, int lane) {
    const f32x4* sp = (const f32x4*)(sc + lane * 16); f32x4 v[4]; float mx = -3.0e38f;
#pragma unroll
    for (int q = 0; q < 4; ++q) { v[q] = sp[q]; mx = fmaxf(mx, fmaxf(fmaxf(v[q].x, v[q].y), fmaxf(v[q].z, v[q].w))); }
    mx = max16(mx);
    float s = 0.f;
#pragma unroll
    for (int q = 0; q < 4; ++q) { v[q].x = __expf(v[q].x - mx); v[q].y = __expf(v[q].y - mx); v[q].z = __expf(v[q].z - mx); v[q].w = __expf(v[q].w - mx); s += (v[q].x + v[q].y) + (v[q].z + v[q].w); }
    s = sum16(s);
    const float inv = 1.0f / s;
    u32x4 w0, w1;
    w0.x = cvt_pk_bf16(v[0].x * inv, v[0].y * inv); w0.y = cvt_pk_bf16(v[0].z * inv, v[0].w * inv); w0.z = cvt_pk_bf16(v[1].x * inv, v[1].y * inv); w0.w = cvt_pk_bf16(v[1].z * inv, v[1].w * inv);
    w1.x = cvt_pk_bf16(v[2].x * inv, v[2].y * inv); w1.y = cvt_pk_bf16(v[2].z * inv, v[2].w * inv); w1.z = cvt_pk_bf16(v[3].x * inv, v[3].y * inv); w1.w = cvt_pk_bf16(v[3].z * inv, v[3].w * inv);
    u32x4* o = (u32x4*)(prow + lane * 16); o[0] = w0; o[1] = w1;
}

constexpr int SSM_T = 32, NCH = 512;
struct SsmParams { const float *lre, *lim, *ldt, *bre, *bim, *cre, *cim; };
__device__ __forceinline__ void ssm_discretise(const SsmParams& P, int idx, float* SBB, float* APOW) {
    const int dg = idx >> 6;
    const double lr = (double)P.lre[idx], li = (double)P.lim[idx];
    const double dt = dexp((double)P.ldt[dg]);
    const double mag = dexp(lr * dt); double sn, cs; dsincos(li * dt, sn, cs);
    const double abr = mag * cs, abi = mag * sn, den = lr * lr + li * li, nr = abr - 1.0, ni = abi;
    const double kr = (nr * lr + ni * li) / den, ki = (ni * lr - nr * li) / den;
#pragma unroll
    for (int c = 0; c < 16; ++c) { const double br = (double)P.bre[idx * 16 + c], bi = (double)P.bim[idx * 16 + c];
        SBB[(idx * 16 + c) * 2] = (float)(kr * br - ki * bi); SBB[(idx * 16 + c) * 2 + 1] = (float)(kr * bi + ki * br); }
    double pr = 1.0, pi = 0.0;
    for (int t = 0; t <= SSM_T; ++t) { APOW[(idx * 33 + t) * 2] = (float)pr; APOW[(idx * 33 + t) * 2 + 1] = (float)pi; const double nr2 = pr * abr - pi * abi, ni2 = pr * abi + pi * abr; pr = nr2; pi = ni2; }
}
__device__ __forceinline__ void ssm_w1_item(int item, const float* SBB, const float* APOW, bf16_t* W1) {
    const int k8 = item & 63, n = (item >> 6) & 255, g = item >> 14, d = n >> 7, q = n & 127, p = q & 63, isim = q >> 6, j = k8 >> 1, c0 = (k8 & 1) * 8;
    const int idx = (d * 64 + g) * 64 + p, e = d ? j : (SSM_T - 1 - j);
    const float ar = APOW[(idx * 33 + e) * 2], ai = APOW[(idx * 33 + e) * 2 + 1];
    float v[8];
#pragma unroll
    for (int c = 0; c < 8; ++c) { const float br = SBB[(idx * 16 + c0 + c) * 2], bi = SBB[(idx * 16 + c0 + c) * 2 + 1]; v[c] = isim ? (ar * bi + ai * br) : (ar * br - ai * bi); }
    u32x4 w; w.x = cvt_pk_bf16(v[0], v[1]); w.y = cvt_pk_bf16(v[2], v[3]); w.z = cvt_pk_bf16(v[4], v[5]); w.w = cvt_pk_bf16(v[6], v[7]);
    *(u32x4*)(W1 + ((size_t)(g * 256 + n) * 512 + k8 * 8)) = w;
}
__device__ __forceinline__ void ssm_kfb_item(int item, const float* SBB, const float* APOW, const float* cre, const float* cim, float* KFB) {
    const int c = item & 15, ch = (item >> 4) & 15, tau = (item >> 8) & 31, d = (item >> 13) & 1, g = item >> 14;
    float acc = 0.f;
    for (int p = 0; p < 64; ++p) { const int idx = (d * 64 + g) * 64 + p;
        const float ar = APOW[(idx * 33 + tau) * 2], ai = APOW[(idx * 33 + tau) * 2 + 1], br = SBB[(idx * 16 + c) * 2], bi = SBB[(idx * 16 + c) * 2 + 1];
        const float tr = ar * br - ai * bi, ti = ar * bi + ai * br;
        acc += cre[((d * 64 + g) * 16 + ch) * 64 + p] * tr - cim[((d * 64 + g) * 16 + ch) * 64 + p] * ti; }
    KFB[item] = acc;
}
__device__ __forceinline__ void ssm_kfb_wave(int wid, int lane, const float* SBB, const float* APOW, const float* cre, const float* cim, float* KFB) {
    const int qc = wid & 3, to = (wid >> 2) & 3, d = (wid >> 4) & 1, g = wid >> 5, e = qc * 64 + lane, c = e & 15, ch = e >> 4, base = (d * 64 + g) * 64;
    float acc[8];
#pragma unroll
    for (int t = 0; t < 8; ++t) acc[t] = 0.f;
    const float* crp = cre + ((size_t)(d * 64 + g) * 16 + ch) * 64; const float* cip = cim + ((size_t)(d * 64 + g) * 16 + ch) * 64;
#pragma unroll 4
    for (int p = 0; p < 64; ++p) { const int idx = base + p;
        const f32x2 b = *(const f32x2*)(SBB + (size_t)(idx * 16 + c) * 2); const float cr = crp[p], ci = cip[p];
        const float wr = cr * b.x - ci * b.y, wi = cr * b.y + ci * b.x;
        const f32x2* ap = (const f32x2*)(APOW + (size_t)(idx * 33 + to * 8) * 2);
#pragma unroll
        for (int t = 0; t < 8; ++t) { const f32x2 a = ap[t]; acc[t] += a.x * wr - a.y * wi; } }
#pragma unroll
    for (int t = 0; t < 8; ++t) KFB[(size_t)(((g * 2 + d) * 32 + to * 8 + t) * 256) + e] = acc[t];
}
__device__ __forceinline__ void ssm_w3_item(int item, const float* APOW, const float* KFB, const float* cre, const float* cim, const float* dsk, bf16_t* W3) {
    const int k8 = item % 96, n = (item / 96) & 511, g = item / (96 * 512), j = n >> 4, ch = n & 15;
    float v[8];
    if (k8 < 64) { const int i = k8 >> 1, c0 = (k8 & 1) * 8;
#pragma unroll
        for (int c = 0; c < 8; ++c) v[c] = 0.f;
        if (i <= j) { const float* kf = KFB + (((g * 2 + 0) * 32 + (j - i)) * 256 + ch * 16 + c0);
#pragma unroll
            for (int c = 0; c < 8; ++c) v[c] += kf[c]; }
        if (i >= j) { const float* kb = KFB + (((g * 2 + 1) * 32 + (i - j)) * 256 + ch * 16 + c0);
#pragma unroll
            for (int c = 0; c < 8; ++c) v[c] += kb[c]; }
        if (i == j && (ch >> 3) == (c0 >> 3)) {
#pragma unroll
            for (int c = 0; c < 8; ++c) v[c] += (c0 + c == ch) ? dsk[g * 16 + ch] : 0.f; }
    } else { const int kk = (k8 - 64) * 8, d = kk >> 7, q0 = kk & 127, isim = q0 >> 6, p0 = q0 & 63, pw = d ? (SSM_T - j) : (j + 1);
#pragma unroll
        for (int c = 0; c < 8; ++c) { const int p = p0 + c, idx = (d * 64 + g) * 64 + p;
            const float ar = APOW[(idx * 33 + pw) * 2], ai = APOW[(idx * 33 + pw) * 2 + 1], cr = cre[((d * 64 + g) * 16 + ch) * 64 + p], ci = cim[((d * 64 + g) * 16 + ch) * 64 + p];
            v[c] = isim ? -(cr * ai + ci * ar) : (cr * ar - ci * ai); } }
    u32x4 w; w.x = cvt_pk_bf16(v[0], v[1]); w.y = cvt_pk_bf16(v[2], v[3]); w.z = cvt_pk_bf16(v[4], v[5]); w.w = cvt_pk_bf16(v[6], v[7]);
    *(u32x4*)(W3 + ((size_t)(g * 512 + n) * 768 + k8 * 8)) = w;
}
__device__ __forceinline__ void ssm_w3_toep_wave4(int w0, int wstride, int lane, const float* KFB, const float* dsk, bf16_t* W3) {
    f32x4 fa[4], ba[4]; float dv[4];
#pragma unroll
    for (int q = 0; q < 4; ++q) { const int wq = w0 + q * wstride, w = wq < 64 * 32 * 32 ? wq : w0, i = w & 31, j = (w >> 5) & 31, g = w >> 10, tf = i <= j ? j - i : 0, tb = i >= j ? i - j : 0;
        fa[q] = *(const f32x4*)(KFB + (size_t)(((g * 2 + 0) * 32 + tf) * 256) + 4 * lane); ba[q] = *(const f32x4*)(KFB + (size_t)(((g * 2 + 1) * 32 + tb) * 256) + 4 * lane); dv[q] = dsk[g * 16 + (lane >> 2)]; }
#pragma unroll
    for (int q = 0; q < 4; ++q) { const int wq = w0 + q * wstride, w = wq < 64 * 32 * 32 ? wq : w0, i = w & 31, j = (w >> 5) & 31, g = w >> 10, ch = lane >> 2, c0 = 4 * (lane & 3);
        f32x4 v = {0.f, 0.f, 0.f, 0.f};
        if (i <= j) v += fa[q];
        if (i >= j) v += ba[q];
        if (i == j) {
#pragma unroll
            for (int e = 0; e < 4; ++e) v[e] += (c0 + e == ch) ? dv[q] : 0.f; }
        u32x2 o; o.x = cvt_pk_bf16(v[0], v[1]); o.y = cvt_pk_bf16(v[2], v[3]);
        *(u32x2*)(W3 + ((size_t)(g * 512 + j * 16 + ch) * 768 + i * 16 + c0)) = o; }
}
__device__ __forceinline__ void ssm_w3_carry_wave(int w, int lane, const float* APOW, const float* cre, const float* cim, bf16_t* W3) {
    const int j = w & 31, d = (w >> 5) & 1, g = w >> 6, pw = d ? (SSM_T - j) : (j + 1);
    const f32x2 a = *(const f32x2*)(APOW + (size_t)(((d * 64 + g) * 64 + lane) * 33 + pw) * 2);
    float cr[16], ci[16];
#pragma unroll
    for (int ch = 0; ch < 16; ++ch) { cr[ch] = cre[((size_t)(d * 64 + g) * 16 + ch) * 64 + lane]; ci[ch] = cim[((size_t)(d * 64 + g) * 16 + ch) * 64 + lane]; }
#pragma unroll
    for (int ch = 0; ch < 16; ++ch) { bf16_t* o = W3 + ((size_t)(g * 512 + j * 16 + ch) * 768 + 512 + d * 128 + lane);
        o[0] = (bf16_t)(cvt_pk_bf16(cr[ch] * a.x - ci[ch] * a.y, 0.f) & 0xffffu); o[64] = (bf16_t)(cvt_pk_bf16(-(cr[ch] * a.y + ci[ch] * a.x), 0.f) & 0xffffu); }
}
__device__ __forceinline__ void ssm_carry_wave(const float* APOW, const float* CS, bf16_t* A3, int d, int g, int chunk0, int ncs, int lane) {
    const int p = lane, idx = (d * 64 + g) * 64 + p;
    const float atr = APOW[(idx * 33 + SSM_T) * 2], ati = APOW[(idx * 33 + SSM_T) * 2 + 1];
    float xr = 0.f, xi = 0.f;
    const float* cs = CS + ((size_t)(g * NCH + chunk0) * 256 + d * 128 + p);
    bf16_t* a3 = A3 + ((size_t)(g * NCH + chunk0) * 768 + 512 + d * 128 + p);
    for (int cc = 0; cc < ncs; cc += 32) {
        float sr[32], si[32];
#pragma unroll
        for (int e = 0; e < 32; ++e) { const int c = d ? (ncs - 1 - (cc + e)) : (cc + e); sr[e] = cs[(size_t)c * 256]; si[e] = cs[(size_t)c * 256 + 64]; }
#pragma unroll
        for (int e = 0; e < 32; ++e) { const int c = d ? (ncs - 1 - (cc + e)) : (cc + e);
            a3[(size_t)c * 768] = (bf16_t)(cvt_pk_bf16(xr, 0.f) & 0xffffu); a3[(size_t)c * 768 + 64] = (bf16_t)(cvt_pk_bf16(xi, 0.f) & 0xffffu);
            const float nr = atr * xr - ati * xi + sr[e], ni = atr * xi + ati * xr + si[e]; xr = nr; xi = ni; }
    }
}
constexpr int NWAVES = 8;
#ifndef WGM_WIDE
#define WGM_WIDE 4
#endif
#ifndef MK_PER_PHASE
#define MK_PER_PHASE 0
#endif
#ifndef FN_ALL
#define FN_ALL 0
#endif
constexpr int NG = 3;
constexpr int MAXG = 16384;
constexpr int NPH_G = 9, NPH0 = 1, NPH = NPH0 + NG * NPH_G + 1;

constexpr size_t MiB = 1u << 20;
constexpr size_t WS_CTL = 0, CTL_ZERO_BYTES = 1 * MiB;
constexpr size_t WS_ROPE = 1 * MiB;
constexpr size_t WS_SBB = 4 * MiB;
constexpr size_t WS_WIN = 5 * MiB;
constexpr size_t WS_WAP = WS_WIN + 32 * MiB;
constexpr size_t WS_WGLU = WS_WAP + 4 * MiB;
constexpr size_t WS_WMO = WS_WGLU + 8 * MiB;
constexpr size_t WS_WQC = WS_WMO + 8 * MiB;
constexpr size_t WS_WKV = WS_WQC + 8 * MiB;
constexpr size_t WS_WOC = WS_WKV + 16 * MiB;
constexpr size_t WS_WUP = WS_WOC + 8 * MiB;
constexpr size_t WS_WDN = WS_WUP + 32 * MiB;
constexpr size_t WS_MN = WS_WDN + 32 * MiB;
constexpr size_t WS_KVM = WS_MN + 8 * MiB;
constexpr size_t WS_XN = WS_KVM + 16 * MiB;
constexpr size_t WS_QKVU = WS_XN + 64 * MiB;
constexpr size_t WS_GATES = WS_QKVU + 128 * MiB;
constexpr size_t WS_H = WS_QKVU;
constexpr size_t WS_OD = WS_GATES + 128 * MiB;
constexpr size_t WS_OC = WS_OD;
constexpr size_t WS_AN = WS_OD + 64 * MiB;
constexpr size_t WS_Z = WS_AN + 32 * MiB;
constexpr size_t WS_MIX = WS_Z + 32 * MiB;
constexpr size_t WS_TQ = WS_MIX + 64 * MiB;
constexpr size_t WS_TVT = WS_TQ + 32 * MiB;
constexpr size_t WS_QC = WS_TQ;
constexpr size_t WS_SC = WS_QC + 64 * MiB;
constexpr size_t WS_P = WS_SC + 64 * MiB;
constexpr size_t WS_A3 = WS_P + 32 * MiB;
constexpr size_t WS_CS = WS_A3 + 48 * MiB;
constexpr size_t WS_W1 = WS_CS + 32 * MiB;
constexpr size_t WS_W3 = WS_W1 + 16 * MiB;
constexpr size_t WS_KFB = WS_W3 + 48 * MiB;
constexpr size_t WS_APOW = WS_KFB + 4 * MiB;
constexpr size_t WS_END = WS_APOW + 3 * MiB;
static_assert(WS_END <= 1024 * MiB, "workspace map");
constexpr int CW_BAR = 4096;

constexpr int RING_BYTES = 131072, LDSCTL_OFF = RING_BYTES, MISC_OFF = LDSCTL_OFF + 320, LDS_BYTES = 147456;

typedef GAS unsigned gu32;
#define RLX_AGENT __ATOMIC_RELAXED, __HIP_MEMORY_SCOPE_AGENT
#define LDS_WAIT() asm volatile("s_waitcnt lgkmcnt(0)" ::: "memory")

#define XB_TMO      128
#define XB_XCNT(j)  (256  + 64 * (j))
#define XB_XSUB(j)  (1280 + 64 * (j))
#define XB_XGEN(j)  (2304 + 64 * (j))
#define XB_TOP      3328
#define XB_TOPGEN   3392
#define XCD_BAR_WORDS 3456
#define XB_SPIN_CAP (1u << 22)
__device__ __forceinline__ unsigned xb_ld(gu32* p)              { return __hip_atomic_load(p, __ATOMIC_RELAXED, __HIP_MEMORY_SCOPE_AGENT); }
__device__ __forceinline__ unsigned xb_add(gu32* p, unsigned v) { return __hip_atomic_fetch_add(p, v, __ATOMIC_RELAXED, __HIP_MEMORY_SCOPE_AGENT); }
__device__ __forceinline__ unsigned xb_xcc_id() { return (unsigned)__builtin_amdgcn_s_getreg((3 << 11) | 20) & 0xFu; }
#define XB_SPIN(cond, bar) do { unsigned _sp = 0; while (cond) { __builtin_amdgcn_s_sleep(1); \
    if ((++_sp & 255u) == 0u) { if (xb_ld(&(bar)[XB_TMO])) break; if (_sp > XB_SPIN_CAP) { (void)xb_add(&(bar)[XB_TMO], 1u); break; } } } } while (0)
struct XcdBarrier { gu32* bar; unsigned x; volatile LAS unsigned* st; };
__device__ __forceinline__ XcdBarrier xcd_barrier_post(gu32* bar, volatile LAS unsigned* st) {
    XcdBarrier b; b.bar = bar; b.x = xb_xcc_id(); b.st = st;
    if (threadIdx.x == 0) (void)xb_add(&bar[XB_XCNT(b.x)], 1u);
    return b;
}
__device__ __forceinline__ void xcd_barrier_complete(gu32* bar, unsigned x, unsigned& nloc, unsigned& nx) {
    const unsigned G = gridDim.x * gridDim.y * gridDim.z;
    unsigned sum, cnt, mine, sp = 0u;
    for (;;) {
        sum = 0u; cnt = 0u; mine = 0u;
#pragma unroll
        for (unsigned j = 0; j < 16; ++j) { const unsigned c = xb_ld(&bar[XB_XCNT(j)]); sum += c; cnt += (c > 0u) ? 1u : 0u; mine = (j == x) ? c : mine; }
        if (sum == G) break;
        __builtin_amdgcn_s_sleep(1);
        if ((++sp & 255u) == 0u) { if (xb_ld(&bar[XB_TMO])) break; if (sp > XB_SPIN_CAP) { (void)xb_add(&bar[XB_TMO], 1u); break; } }
    }
    nloc = mine > 0u ? mine : 1u; nx = cnt > 0u ? cnt : 1u;
}
__device__ __forceinline__ void xcd_barrier(const XcdBarrier& b) {
    asm volatile("s_waitcnt vmcnt(0)" ::: "memory");
    __syncthreads();
    if (threadIdx.x == 0) {
        gu32* bar = b.bar; unsigned bx_ = b.x; asm volatile("" : "+s"(bar), "+s"(bx_));
        __builtin_amdgcn_s_waitcnt(0);
#ifdef EARLY_WB
        __builtin_amdgcn_fence(__ATOMIC_RELEASE, "agent");
#endif
        unsigned nloc = b.st[0], nx = b.st[1];
        if (nloc == 0u) { xcd_barrier_complete(bar, bx_, nloc, nx); b.st[0] = nloc; b.st[1] = nx; }
        const unsigned old = xb_add(&bar[XB_XSUB(bx_)], 1u);
        const unsigned gen = old / nloc;
        if (old + 1u == (gen + 1u) * nloc) {
            __builtin_amdgcn_fence(__ATOMIC_RELEASE, "agent");
            asm volatile("s_waitcnt vmcnt(0)" ::: "memory");
            const unsigned og = xb_add(&bar[XB_TOP], 1u);
            const unsigned tg = og / nx;
            if (og + 1u == (tg + 1u) * nx) xb_add(&bar[XB_TOPGEN], 1u);
            else XB_SPIN(xb_ld(&bar[XB_TOPGEN]) == tg, bar);
            __builtin_amdgcn_fence(__ATOMIC_ACQUIRE, "agent");
            xb_add(&bar[XB_XGEN(bx_)], 1u);
            asm volatile("s_waitcnt vmcnt(0)" ::: "memory");
        } else {
            XB_SPIN(xb_ld(&bar[XB_XGEN(bx_)]) == gen, bar);
            __builtin_amdgcn_fence(__ATOMIC_ACQUIRE, "agent");
            asm volatile("s_waitcnt vmcnt(0)" ::: "memory");
        }
    }
    __syncthreads();
}

__device__ __forceinline__ unsigned f2bf(float f) { unsigned u = __builtin_bit_cast(unsigned, f); return (u + 0x7fffu + ((u >> 16) & 1u)) >> 16; }
__device__ __forceinline__ unsigned pk2(float lo, float hi) { return f2bf(lo) | (f2bf(hi) << 16); }
template <int MODE>
__device__ __forceinline__ void p0_transpose_tile(const float* W, int K, int N, bf16_t* WT, int which, LAS float* T, int item, int tid, const float* kscale = nullptr) {
    const int nblk = N / 128, kb = item / nblk, nb = item - kb * nblk, k0 = 128 * kb, n0 = 128 * nb;
    { const int r = tid >> 5, c4 = tid & 31; f32x4 v[8];
#pragma unroll
      for (int p = 0; p < 8; ++p) v[p] = *(const f32x4*)(W + (size_t)(k0 + 16 * p + r) * N + n0 + 4 * c4);
#pragma unroll
      for (int p = 0; p < 8; ++p) { LAS float* d = T + (16 * p + r) * 129 + 4 * c4; d[0] = v[p].x; d[1] = v[p].y; d[2] = v[p].z; d[3] = v[p].w; } }
    __syncthreads();
#pragma unroll
    for (int q = 0; q < 4; ++q) { const int cid = q * 512 + tid, n = cid >> 4, ch = cid & 15; const LAS float* sp = T + (8 * ch) * 129 + n;
        float e0 = sp[0 * 129], e1 = sp[1 * 129], e2 = sp[2 * 129], e3 = sp[3 * 129], e4 = sp[4 * 129], e5 = sp[5 * 129], e6 = sp[6 * 129], e7 = sp[7 * 129];
        if (kscale) { const f32x4 ka = *(const f32x4*)(kscale + k0 + 8 * ch), kb2 = *(const f32x4*)(kscale + k0 + 8 * ch + 4); e0 *= ka.x; e1 *= ka.y; e2 *= ka.z; e3 *= ka.w; e4 *= kb2.x; e5 *= kb2.y; e6 *= kb2.z; e7 *= kb2.w; }
        u32x4 o; o.x = pk2(e0, e1); o.y = pk2(e2, e3); o.z = pk2(e4, e5); o.w = pk2(e6, e7);
        const int nl = n0 + n; int prow;
        if (MODE == 0) prow = nl;
        else if (MODE == 1) { if (nl < 2048) { const int o64 = nl & 63; prow = (nl & ~63) + 8 * ((o64 & 31) >> 2) + 4 * (o64 >> 5) + (o64 & 3); } else prow = nl; }
        else prow = 8 * (nl >> 2) + 4 * which + (nl & 3);
        *(GAS u32x4*)(WT + (size_t)prow * K + k0 + 8 * ch) = o; }
    __syncthreads();
}

struct Args { const float* in[29]; float* out; unsigned char* ws; int ph_lo, ph_hi; };

__global__ void __launch_bounds__(NWAVES * 64, 2) fwd_kernel(Args args) {
    extern __shared__ __attribute__((aligned(16))) unsigned char lds[];
    LAS unsigned char* ldsl = (LAS unsigned char*)lds;
    volatile LAS unsigned* MISC = (volatile LAS unsigned*)(ldsl + MISC_OFF);
    const int tid = threadIdx.x, lane = tid & 63, wave = __builtin_amdgcn_readfirstlane(tid >> 6);
    const int G = gridDim.x, bx = blockIdx.x;
    const int vcu = (G % 8 == 0) ? (bx % 8) * (G / 8) + bx / 8 : bx;
    const int gw = vcu * NWAVES + wave, NGW = G * NWAVES;
    unsigned char* ws = args.ws;
    unsigned* ctl = (unsigned*)(ws + WS_CTL);
    for (int u = tid; u < (LDS_BYTES - LDSCTL_OFF) / 4; u += NWAVES * 64) ((LAS unsigned*)(ldsl + LDSCTL_OFF))[u] = 0u;
    __syncthreads();
    XcdBarrier bar; bar.bar = (gu32*)(ctl + CW_BAR); bar.x = 0; bar.st = nullptr;
    if (!MK_PER_PHASE) bar = xcd_barrier_post((gu32*)(ctl + CW_BAR), MISC + 8);
    const int lo = args.ph_lo, hi = args.ph_hi;
#ifndef DBG_ONLY
#define DBG_ONLY -1
#endif
#ifndef DBG_REPEAT_MASK
#define DBG_REPEAT_MASK 0u
#endif
#ifndef DBG_REPEAT_PRO
#define DBG_REPEAT_PRO 0u
#endif
#define IN(k) (lo <= (k) && (k) < hi)
#define PHASE(n) for (int rep_ = 0; rep_ < (((DBG_REPEAT_MASK >> (n)) & 1u) ? 2 : 1); ++rep_) if ((DBG_ONLY < 0 || DBG_ONLY == NPH0 + (n)) && IN(pb + (n)))
#ifdef DBG_WAIT_MASK
#ifndef DBG_WAIT_COND
#define DBG_WAIT_COND true
#endif
    unsigned long long wacc_ = 0ull;
#define SEAM(k) do { if (!MK_PER_PHASE && IN(k) && IN((k) + 1)) { const unsigned long long t0_ = wall_clock64(); xcd_barrier(bar); const int sb_ = (k) == 0 ? 9 : ((k) - NPH0) % NPH_G; if (((DBG_WAIT_MASK >> sb_) & 1u) && DBG_WAIT_COND) wacc_ += wall_clock64() - t0_; } } while (0)
#elif defined(DBG_MINWAIT)
    unsigned long long wacc_ = 0ull;
#define SEAM(k) do { if (!MK_PER_PHASE && IN(k) && IN((k) + 1)) { const unsigned long long t0_ = wall_clock64(); xcd_barrier(bar); const unsigned w_ = (unsigned)(wall_clock64() - t0_); \
        if (threadIdx.x == 0) atomicMax((unsigned*)(ws + WS_CTL + 600064) + (k), 0x40000000u - w_); } } while (0)
#elif defined(DBG_WORK_MASK)
#ifdef DBG_CYCLES
#define DBG_NOW() ((unsigned long long)clock64() / 24ull)
#else
#define DBG_NOW() wall_clock64()
#endif
    unsigned long long wacc_ = 0ull, trel_ = DBG_NOW();
#define SEAM(k) do { if (!MK_PER_PHASE && IN(k) && IN((k) + 1)) { const unsigned long long ta_ = DBG_NOW(); if ((DBG_WORK_MASK >> (k)) & 1ull) wacc_ += ta_ - trel_; xcd_barrier(bar); trel_ = DBG_NOW(); } } while (0)
#else
#define SEAM(k) do { if (!MK_PER_PHASE && IN(k) && IN((k) + 1)) xcd_barrier(bar); } while (0)
#endif

    const float* x_prompt = args.in[0]; const float* x_sample = args.in[1]; const float* mem_prompt = args.in[2]; const float* mem_sample = args.in[3];
    float* out = args.out;
    bf16_t* W_IN = (bf16_t*)(ws + WS_WIN); bf16_t* W_AP = (bf16_t*)(ws + WS_WAP); bf16_t* W_GLU = (bf16_t*)(ws + WS_WGLU); bf16_t* W_MO = (bf16_t*)(ws + WS_WMO);
    bf16_t* W_QC = (bf16_t*)(ws + WS_WQC); bf16_t* W_KV = (bf16_t*)(ws + WS_WKV); bf16_t* W_OC = (bf16_t*)(ws + WS_WOC); bf16_t* W_UP = (bf16_t*)(ws + WS_WUP); bf16_t* W_DN = (bf16_t*)(ws + WS_WDN);
    bf16_t* MN = (bf16_t*)(ws + WS_MN); bf16_t* KVM = (bf16_t*)(ws + WS_KVM); bf16_t* TQ = (bf16_t*)(ws + WS_TQ); bf16_t* TVT = (bf16_t*)(ws + WS_TVT);
    bf16_t* XN0 = (bf16_t*)(ws + WS_XN); bf16_t* XN1 = (bf16_t*)(ws + WS_OD); bf16_t* QKVU = (bf16_t*)(ws + WS_QKVU); bf16_t* GATES = (bf16_t*)(ws + WS_GATES); bf16_t* HB = (bf16_t*)(ws + WS_H);
    bf16_t* OD = (bf16_t*)(ws + WS_OD); bf16_t* OC = (bf16_t*)(ws + WS_OC); bf16_t* AN = (bf16_t*)(ws + WS_AN); bf16_t* ZB = (bf16_t*)(ws + WS_Z); bf16_t* MIX = (bf16_t*)(ws + WS_MIX);
    bf16_t* A3 = (bf16_t*)(ws + WS_A3); float* CS = (float*)(ws + WS_CS); bf16_t* W1 = (bf16_t*)(ws + WS_W1); bf16_t* W3 = (bf16_t*)(ws + WS_W3); float* KFB = (float*)(ws + WS_KFB); float* APOW = (float*)(ws + WS_APOW);
    float* SC = (float*)(ws + WS_SC); bf16_t* PB = (bf16_t*)(ws + WS_P);
    float* SS1 = (float*)(ws + WS_CTL + 65536); float* SS2 = SS1 + NTOK; float* SS3 = SS2 + NTOK;
    float* ROPE = (float*)(ws + WS_ROPE); float* SBB = (float*)(ws + WS_SBB);

    for (int rep_ = 0; rep_ < ((DBG_REPEAT_PRO & 1u) ? 2 : 1); ++rep_) if ((DBG_ONLY < 0 || DBG_ONLY == 0) && IN(0)) {
        { LAS float* T = (LAS float*)ldsl;
          constexpr int I_WIN = (DM / 128) * (INC / 128), I_AP = (AW / 128) * (DM / 128), I_GL = (SW / 128) * (DM / 128), I_SQ = (DM / 128) * (DM / 128), I_KV = (DM / 128) * (4096 / 128), I_UP = (DM / 128) * (DFF / 128), I_DN = (DFF / 128) * (DM / 128);
          constexpr int NITEMS = I_WIN + I_AP + 2 * I_GL + 2 * I_SQ + I_KV + I_UP + I_DN;
          for (int it = vcu; it < NITEMS; it += G) {
            int r = it;
            if (r < I_WIN) { p0_transpose_tile<1>(args.in[5], DM, INC, W_IN, 0, T, r, tid); continue; } r -= I_WIN;
            if (r < I_AP) { p0_transpose_tile<0>(args.in[8], AW, DM, W_AP, 0, T, r, tid); continue; } r -= I_AP;
            if (r < I_GL) { p0_transpose_tile<2>(args.in[17], SW, DM, W_GLU, 0, T, r, tid); continue; } r -= I_GL;
            if (r < I_GL) { p0_transpose_tile<2>(args.in[18], SW, DM, W_GLU, 1, T, r, tid); continue; } r -= I_GL;
            if (r < I_SQ) { p0_transpose_tile<0>(args.in[19], DM, DM, W_MO, 0, T, r, tid); continue; } r -= I_SQ;
            if (r < I_SQ) { p0_transpose_tile<0>(args.in[24], DM, DM, W_OC, 0, T, r, tid); continue; } r -= I_SQ;
            if (r < I_KV) { p0_transpose_tile<0>(args.in[23], DM, 4096, W_KV, 0, T, r, tid); continue; } r -= I_KV;
            if (r < I_UP) { p0_transpose_tile<0>(args.in[26], DM, DFF, W_UP, 0, T, r, tid, args.in[25]); continue; } r -= I_UP;
            p0_transpose_tile<0>(args.in[27], DFF, DM, W_DN, 0, T, r, tid);
          } }
        for (int i = gw * 64 + lane; i < DM * DM / 8; i += NGW * 64) { const f32x4* p = (const f32x4*)(args.in[22] + (size_t)i * 8); const f32x4 a = p[0], b = p[1];
            u32x4 w; w.x = pk2(a.x, a.y); w.y = pk2(a.z, a.w); w.z = pk2(b.x, b.y); w.w = pk2(b.z, b.w); *(u32x4*)(W_QC + (size_t)i * 8) = w; }
        for (int i = gw * 64 + lane; i < LPR * 32; i += NGW * 64) { const int pos = i >> 5, f = i & 31;
            const float inv = (float)dexp(-(double)f * (9.210340371976184 / 32.0));
            const float ang = (float)pos * inv; double s, c; dsincos((double)ang, s, c);
            ROPE[pos * 64 + f] = (float)c; ROPE[pos * 64 + 32 + f] = (float)s; }
        { const SsmParams P{args.in[9], args.in[10], args.in[11], args.in[12], args.in[13], args.in[14], args.in[15]};
          for (int i = gw * 64 + lane; i < 8192; i += NGW * 64) ssm_discretise(P, i, SBB, APOW); }
        for (int m = gw; m < 16384; m += 2 * NGW) { const int m2 = m + NGW;
            const int mb = m2 < 16384 ? m2 : m;
            rms_row2_bf16_xr(x_prompt + (size_t)m * DM, x_prompt + (size_t)mb * DM, args.in[4], XN0 + (size_t)m * DM, XN0 + (size_t)mb * DM, (bf16_t*)out + (size_t)m * pg8::XRS, (bf16_t*)out + (size_t)mb * pg8::XRS, lane); }
        for (int m = gw; m < NMEMROWS; m += NGW) { const float* src = m < 1024 ? mem_prompt + (size_t)m * DM : mem_sample + (size_t)(m - 1024) * DM; rms_row_bf16(src, args.in[21], MN + (size_t)m * DM, lane); }
    }
    SEAM(0);

    for (int gi = 0; gi < NG; ++gi) {
        const int pb = NPH0 + gi * NPH_G; if (pb >= hi || pb + NPH_G <= lo) continue;
        const int grow0 = gi * 16384, M = gi < 2 ? 16384 : 8192;
        const int L = grow0 < NPROMPT ? LPR : LSA, nseq = M / L, seq0 = grow0 < NPROMPT ? grow0 / LPR : 4 + (grow0 - NPROMPT) / LSA;
        bf16_t* XN = (gi & 1) ? XN1 : XN0; bf16_t* XNnext = (gi & 1) ? XN0 : XN1;
        PHASE(0) {
            { pg8::Gemm g{DM, DM, DM}; pg8::TileOrder S; S.init(XN, DM, W_IN, DM, M, INC, G, bx, WGM_WIDE); pg8::EpiWin E{QKVU, GATES, ROPE, grow0, A3}; pg8::gemm_phase(ldsl, g, S, E); }
            if (gi == 0) {
                struct MemOrder { const bf16_t* MN; const bf16_t* WKV; int G, c;
                    __device__ bool next(int i, pg8::Unit& u) const { const int id = i * G + c; if (id >= 128) return false; u.pm = id >> 4; u.pn = id & 15;
                        u.a = (const char*)(MN + (size_t)u.pm * 256 * DM); u.b = (const char*)(WKV + (size_t)u.pn * 256 * DM); return true; } };
                pg8::Gemm g{DM, DM, DM}; MemOrder S{MN, W_KV, G, G == 256 ? ((bx + 128) & 255) : bx}  ; pg8::EpiBf16<0> E{KVM, 4096, 1.0f}; pg8::gemm_phase(ldsl, g, S, E);
                int tl_ = threadIdx.x; asm volatile("" : "+v"(tl_)); const int lane = tl_ & 63;
                const int tb = (G == 256) ? 128 : G;
                if (bx < tb) { for (int it = (bx * NWAVES + wave) * 64 + lane; it < 64 * 256 * 64; it += tb * NWAVES * 64) ssm_w1_item(it, SBB, APOW, W1);
                    for (int wid = bx * NWAVES + wave; wid < 64 * 2 * 4 * 4; wid += tb * NWAVES) ssm_kfb_wave(wid, lane, SBB, APOW, args.in[14], args.in[15], KFB); }
            }
        }
        SEAM(pb + 0);
#ifdef DBG_IDLE_BEFORE_C
        if (gi == 1) { const unsigned long long ti_ = wall_clock64(); while (wall_clock64() - ti_ < DBG_IDLE_BEFORE_C) __builtin_amdgcn_s_sleep(32);
#ifdef DBG_WORK_MASK
            trel_ = wall_clock64();
#endif
        }
#endif
        PHASE(1) {
            int tl_ = threadIdx.x; asm volatile("" : "+v"(tl_)); const int lane = tl_ & 63;
            float lam; { const float* dl = args.in[6]; float t0 = dl[lane] * dl[64 + lane], t1 = dl[128 + lane] * dl[192 + lane]; t0 = wave_sum(t0); t1 = wave_sum(t1); lam = __expf(t0) - __expf(t1) + 0.2f; }
            const int nqb = L / 128, NU = nseq * 8 * nqb;
            const int h0 = (G == 256 && gi + 1 < NG) ? 128 : 0  , nh = G - h0, nupc = (G == 256 && NU % 256 == 0) ? NU / 256 : 1, cohort = (bx >> 3) & (nupc - 1);
            for (int i = 0;; ++i) {
                if (i == cohort && (bx >= h0 || FN_ALL)) {
                    int tlr_ = threadIdx.x; asm volatile("" : "+v"(tlr_)); const int lane = tlr_ & 63;
                    const float* gmix = args.in[4]; const float* gfin = args.in[28]; asm volatile("" : "+s"(gmix), "+s"(gfin));
                    if (gi + 1 < NG && bx >= h0) { const int g1 = (gi + 1) * 16384, M1 = gi + 1 < 2 ? 16384 : 8192;
                        for (int m = (bx - h0) * NWAVES + wave; m < M1; m += 2 * nh * NWAVES) { const int m2 = (m + nh * NWAVES < M1) ? m + nh * NWAVES : m, gr = g1 + m, gr2 = g1 + m2;
                            const float* src = gr < NPROMPT ? x_prompt + (size_t)gr * DM : x_sample + (size_t)(gr - NPROMPT) * DM; const float* src2 = gr2 < NPROMPT ? x_prompt + (size_t)gr2 * DM : x_sample + (size_t)(gr2 - NPROMPT) * DM;
                            rms_row2_bf16_xr(src, src2, gmix, XNnext + (size_t)m * DM, XNnext + (size_t)m2 * DM, (bf16_t*)out + (size_t)gr * pg8::XRS, (bf16_t*)out + (size_t)gr2 * pg8::XRS, lane); } }
                    if (gi > 0) { const int hf = FN_ALL ? 0 : h0; if (bx >= hf) final_norm_rows(out, gfin, SS3, (gi - 1) * 16384, 16384, (bx - hf) * NWAVES + wave, (G - hf) * NWAVES, lane); }
                }
                int un; if (G == 256 && NU % 256 == 0) { const int per = NU / 8; un = (vcu >> 5) * per + (vcu & 31) + 32 * i; if (32 * i + (vcu & 31) >= per) break; } else { un = bx + i * G; if (un >= NU) break; }
                const int qb = un % nqb, sh = un / nqb, h = sh & 7, s = sh >> 3; const size_t srow = (size_t)s * L;
                attn3::attn_unit3(QKVU + (srow + (size_t)qb * 128) * 4096 + h * 128, QKVU + srow * 4096 + 1024 + h * 128, QKVU + srow * 4096 + 2048 + h * 128, AN + (srow + (size_t)qb * 128) * 1024 + h * 128, args.in[7], lam, L, (LAS char*)ldsl);
            }
            struct S1Order { const bf16_t* A3; const bf16_t* W1; int nmb, G, c;
                __device__ bool next(int i, pg8::Unit& u) const { const int id = i * G + c; if (id >= 64 * nmb) return false; const int g = id / nmb, mb = id - g * nmb;
                    u.pm = g * (NCH / 256) + mb; u.pn = 0; u.a = (const char*)(A3 + (size_t)(g * NCH + mb * 256) * 768); u.b = (const char*)(W1 + (size_t)g * 256 * 512); return true; } };
            { pg8::Gemm g{768, 512, 512}; S1Order S{A3, W1, M / (32 * 256), G, bx}; pg8::EpiF32 E{CS, 256}; pg8::gemm_phase(ldsl, g, S, E); }
            { int tl2_ = threadIdx.x; asm volatile("" : "+v"(tl2_)); const int lane = tl2_ & 63; const int nmb = M / (32 * 256), ncs = L / 32, nsb = 256 / ncs;
              for (int id = bx; id < 64 * nmb; id += G) { const int g = id / nmb, mb = id - g * nmb, sb = wave >> 1, d = wave & 1;
                  if (sb < nsb) ssm_carry_wave(APOW, CS, A3, d, g, mb * 256 + sb * ncs, ncs, lane); } }
            if (gi == 0) {
                struct TqOrder { const bf16_t* KVM; const bf16_t* WQ; int G, c;
                    __device__ bool next(int i, pg8::Unit& u) const { const int id = i * G + c; if (id >= 256) return false; const int sq = id >> 5, hx = (id >> 3) & 3, nb = id & 7;
                        u.pm = sq * 4 + hx; u.pn = nb; u.a = (const char*)(KVM + (size_t)sq * 256 * 4096 + hx * 512); u.b = (const char*)(WQ + (size_t)nb * 256 * DM + hx * 512); return true; } };
                struct TvOrder { const bf16_t* WO; const bf16_t* KVM; int G, c;
                    __device__ bool next(int i, pg8::Unit& u) const { const int id = i * G + c; if (id >= 256) return false; const int sq = id >> 5, hx = (id >> 3) & 3, mb = id & 7;
                        u.pm = sq * 8 + mb; u.pn = hx; u.a = (const char*)(WO + (size_t)mb * 256 * DM + hx * 512); u.b = (const char*)(KVM + (size_t)sq * 256 * 4096 + 2048 + hx * 512); return true; } };
                { pg8::Gemm g{4096, DM, 512}; TqOrder S{KVM, W_QC, G, bx}; pg8::EpiBf16Col E{TQ, DM, 0.044194173824159216f, args.in[20]}; pg8::gemm_phase(ldsl, g, S, E); }
                { pg8::Gemm g{DM, 4096, 512}; TvOrder S{W_OC, KVM, G, bx}; pg8::EpiBf16<0> E{TVT, 1024, 1.0f}; pg8::gemm_phase(ldsl, g, S, E); }
                int tl3_ = threadIdx.x; asm volatile("" : "+v"(tl3_)); const int lane = tl3_ & 63;
#ifndef DBG_W3_REP
#define DBG_W3_REP 1
#endif
                for (int rep3_ = 0; rep3_ < DBG_W3_REP; ++rep3_) {
                for (int w0 = gw; w0 < 64 * 32 * 32; w0 += 4 * NGW) ssm_w3_toep_wave4(w0, NGW, lane, KFB, args.in[16], W3);
                for (int w = gw; w < 64 * 2 * 32; w += NGW) ssm_w3_carry_wave(w, lane, APOW, args.in[14], args.in[15], W3); }
            }
        }
        SEAM(pb + 1);
        PHASE(2) {
            { pg8::Gemm g{AW, AW, AW}; pg8::TileOrder S; S.init(AN, AW, W_AP, AW, M, DM, G, bx); pg8::EpiAttnProj E{GATES, MIX}; pg8::gemm_phase(ldsl, g, S, E); }
            struct S3Order { const bf16_t* A3; const bf16_t* W3; int nmb, G, c;
                __device__ bool next(int i, pg8::Unit& u) const { const int id = i * G + c; if (id >= 128 * nmb) return false; const int nb = id & 1, gm = id >> 1, g = gm / nmb, mb = gm - g * nmb;
                    u.pm = g * (NCH / 256) + mb; u.pn = nb; u.a = (const char*)(A3 + (size_t)(g * NCH + mb * 256) * 768); u.b = (const char*)(W3 + (size_t)(g * 512 + nb * 256) * 768); return true; } };
            pg8::Gemm g{768, 768, 768}; S3Order S{A3, W3, M / (32 * 256), G, bx}; pg8::EpiSsmOut E{ZB}; pg8::gemm_phase(ldsl, g, S, E);
        }
        SEAM(pb + 2);
        PHASE(3) { pg8::Gemm g{SW, SW, SW}; pg8::TileOrder S; S.init(ZB, SW, W_GLU, SW, M, 4096, G, bx); pg8::EpiGlu E{GATES, MIX}; pg8::gemm_phase(ldsl, g, S, E); }
        SEAM(pb + 3);
        PHASE(4) { pg8::Gemm g{DM, DM, DM}; pg8::TileOrder S; S.init(MIX, DM, W_MO, DM, M, DM, G, bx); pg8::EpiResidSS E{(bf16_t*)out, grow0, SS1, nullptr, nullptr}; pg8::gemm_phase(ldsl, g, S, E); }
        SEAM(pb + 4);
        PHASE(5) {
            struct OneScore { const char* a; const char* b; int pm, pn;
                __device__ bool next(int i, pg8::Unit& u) const { if (i > 0) return false; u.a = a; u.b = b; u.pm = pm; u.pn = pn; return true; } };
            const int nrb = M / 256, rbsh = (L == LPR) ? 5 : 3;
            for (int id = vcu; id < nrb * 4; id += G) { const int hx = id & 3, rb = id >> 2, sq = seq0 + (rb >> rbsh);
                { pg8::Gemm g{pg8::XRS, DM, DM}; OneScore S{(const char*)((const bf16_t*)out + (size_t)(grow0 + rb * 256) * pg8::XRS), (const char*)(TQ + ((size_t)sq * 1024 + hx * 256) * DM), rb, hx};
                  pg8::EpiBf16Rs<0> E{(bf16_t*)SC, 1024, 1.0f, SS1, grow0}; pg8::gemm_phase(ldsl, g, S, E); }
                for (int r4 = wave; r4 < 64; r4 += 2 * NWAVES) { const size_t row = (size_t)rb * 256 + r4 * 4 + (lane >> 4), row2 = row + 4 * NWAVES;
                    xsoftmax_head2_bf16((const bf16_t*)SC + row * 1024 + hx * 256, PB + row * 1024 + hx * 256, (const bf16_t*)SC + row2 * 1024 + hx * 256, PB + row2 * 1024 + hx * 256, lane & 15); }
            }
        }
        SEAM(pb + 5);
        PHASE(6) {
            struct XoOrder { pg8::TileOrder T; const bf16_t* TVT; int rbsh, seq0;
                __device__ bool next(int i, pg8::Unit& u) const { if (!T.next(i, u)) return false; u.b = (const char*)(TVT + ((size_t)(seq0 + (u.pm >> rbsh)) * 2048 + u.pn * 256) * 1024); return true; } };
            pg8::Gemm g{1024, 1024, 1024}; XoOrder S; S.T.init(PB, 1024, TVT, 1024, M, DM, G, bx); S.TVT = TVT; S.rbsh = (L == LPR) ? 5 : 3; S.seq0 = seq0;
            pg8::EpiResidSS E{(bf16_t*)out, grow0, SS2, nullptr, nullptr}; pg8::gemm_phase(ldsl, g, S, E);
        }
        SEAM(pb + 6);
        PHASE(7) { pg8::Gemm g{pg8::XRS, DM, DM}; pg8::TileOrder S; S.init((const bf16_t*)out + (size_t)grow0 * pg8::XRS, pg8::XRS, W_UP, DM, M, DFF, G, bx, WGM_WIDE); pg8::EpiBf16Rs<2> E{HB, DFF, 1.0f, SS2, grow0}; pg8::gemm_phase(ldsl, g, S, E); }
        SEAM(pb + 7);
        PHASE(8) { pg8::Gemm g{DFF, DFF, DFF}; pg8::TileOrder S; S.init(HB, DFF, W_DN, DFF, M, DM, G, bx); pg8::EpiResidSS E{(bf16_t*)out, grow0, SS3, nullptr, nullptr}; pg8::gemm_phase(ldsl, g, S, E); }
        SEAM(pb + 8);
    }
    if ((DBG_ONLY < 0 || DBG_ONLY == NPH - 1) && IN(NPH - 1)) { int tl_ = threadIdx.x; asm volatile("" : "+v"(tl_)); const int lane = tl_ & 63; const int gp = (NG - 1) * 16384, Mp = 8192; final_norm_rows(out, args.in[28], SS3, gp, Mp, gw, NGW, lane); }
#if defined(DBG_WAIT_MASK) || defined(DBG_WORK_MASK) || defined(DBG_MINWAIT)
    { unsigned long long* wtot = (unsigned long long*)(ws + WS_CTL + 600000);
      if (threadIdx.x == 0) atomicAdd(wtot, wacc_);
      xcd_barrier(bar);
#ifdef DBG_MINWAIT
      if (bx == 0 && threadIdx.x == 0) { unsigned long long sm = 0; for (int k = 0; k < NPH - 1; ++k) { const unsigned v = __hip_atomic_load((unsigned*)(ws + WS_CTL + 600064) + k, __ATOMIC_RELAXED, __HIP_MEMORY_SCOPE_AGENT); sm += (unsigned long long)(0x40000000u - v); } *wtot = sm * (unsigned long long)G; }
      __syncthreads();
#endif
      if (bx == 0 && threadIdx.x == 0) { unsigned long long tot = __hip_atomic_load(wtot, __ATOMIC_RELAXED, __HIP_MEMORY_SCOPE_AGENT) / (unsigned long long)G;
#ifdef DBG_SPIN_TICKS
        tot = DBG_SPIN_TICKS;
#endif
 const unsigned long long t0_ = wall_clock64(); while (wall_clock64() - t0_ < tot) __builtin_amdgcn_s_sleep(8); } }
#endif
#undef IN
#undef PHASE
#undef SEAM
}

#ifdef DBG_STOP
__global__ void dump_kernel(const unsigned char* ws, size_t off, size_t nelem, int is_f32, float* out, size_t nout) {
    for (size_t i = (size_t)blockIdx.x * blockDim.x + threadIdx.x; i < nout; i += (size_t)gridDim.x * blockDim.x) { const size_t idx = i % nelem;
        float v = is_f32 ? ((const float*)(ws + off))[idx] : __uint_as_float((unsigned)((const bf16_t*)(ws + off))[idx] << 16);
        if (!(v == v) || fabsf(v) > 1e30f) v = 12345.f; out[i] = v; }
}
#endif
extern "C" void kernel_launch(void* const* d_in, const int* in_sizes, int n_in, void* d_out, int out_size, void* d_ws, size_t ws_size, hipStream_t stream) {
    static int grid = 0;
    if (grid == 0) {
        if (n_in != 29 || out_size != NTOK * DM || ws_size < WS_END) { fprintf(stderr, "kernel_launch: unexpected shapes: n_in %d out %d ws %zu (need %zu)\n", n_in, out_size, ws_size, (size_t)WS_END); grid = -1; return; }
        int dev = 0, cus = 0, per_cu = 0;
        if (hipGetDevice(&dev) != hipSuccess || hipDeviceGetAttribute(&cus, hipDeviceAttributeMultiprocessorCount, dev) != hipSuccess) { grid = -1; return; }
        if (hipFuncSetAttribute((const void*)fwd_kernel, hipFuncAttributeMaxDynamicSharedMemorySize, LDS_BYTES) != hipSuccess) { fprintf(stderr, "kernel_launch: hipFuncSetAttribute failed\n"); grid = -1; return; }
        if (hipOccupancyMaxActiveBlocksPerMultiprocessor(&per_cu, (const void*)fwd_kernel, NWAVES * 64, LDS_BYTES) != hipSuccess || per_cu < 1) { fprintf(stderr, "kernel_launch: occupancy query says %d\n", per_cu); }
        (void)hipGetLastError();
        grid = cus;
    }
    if (grid < 0) return;
    (void)hipMemsetAsync((char*)d_ws + WS_CTL, 0, CTL_ZERO_BYTES, stream);
    Args a{};
    for (int i = 0; i < 29; ++i) a.in[i] = (const float*)d_in[i];
    a.out = (float*)d_out; a.ws = (unsigned char*)d_ws;
#if MK_PER_PHASE
#ifdef DBG_STOP
    for (int p = 0; p < DBG_STOP; ++p) { a.ph_lo = p; a.ph_hi = p + 1; hipLaunchKernelGGL(fwd_kernel, dim3(grid), dim3(NWAVES * 64), LDS_BYTES, stream, a); }
    hipLaunchKernelGGL(dump_kernel, dim3(2048), dim3(256), 0, stream, (const unsigned char*)d_ws, (size_t)DBG_OFF, (size_t)DBG_NELEM, (int)DBG_F32, (float*)d_out, (size_t)NTOK * DM);
#else
    for (int p = 0; p < NPH; ++p) { a.ph_lo = p; a.ph_hi = p + 1; hipLaunchKernelGGL(fwd_kernel, dim3(grid), dim3(NWAVES * 64), LDS_BYTES, stream, a); }
#endif
#else
    a.ph_lo = 0; a.ph_hi = NPH; hipLaunchKernelGGL(fwd_kernel, dim3(grid), dim3(NWAVES * 64), LDS_BYTES, stream, a);
#endif
}
```
